# Optimizing an MI355X kernel written in HIP

```python
import math
import jax, jax.numpy as jnp
from jax import lax
import numpy as np

D_MODEL = 2048
BATCH = 16
SEQ = 2048
DEPTH = 2

N_MIXERS = 2
POOL_WINDOWS = (2, 4, 8, 16)
N_POOL_GROUPS = 4
POOL_GROUP_DIM = D_MODEL // N_POOL_GROUPS
ATTN_PATTERNS = ((128, 1), (512, 4), (2048, 16))
N_ATTN_GROUPS = 3
HEAD_DIM = 128
N_SLOTS = 8
GROUP_WIDTH = N_SLOTS * HEAD_DIM
QKV_WIDTH = 3 * N_ATTN_GROUPS * GROUP_WIDTH
BLOCK = 128
N_TOTAL_HEADS = N_ATTN_GROUPS * N_SLOTS
D_FF = 4 * D_MODEL
LN_EPS = 1e-5
DEEPNORM_ALPHA = (2 * DEPTH) ** 0.25
DEEPNORM_BETA = (8 * DEPTH) ** -0.25
N_POOL_LAYERS = (DEPTH + 1) // 2
N_ATTN_LAYERS = DEPTH // 2

kernel_name = "hybrid_pool_dilated_attn_deepnorm"


def layer_norm(x, g, b):
    xf = x.astype(jnp.float32)
    mu = jnp.mean(xf, axis=-1, keepdims=True)
    xc = xf - mu
    var = jnp.mean(xc * xc, axis=-1, keepdims=True)
    y = xc * lax.rsqrt(var + LN_EPS) * g.astype(jnp.float32) + b.astype(jnp.float32)
    return y.astype(x.dtype)


def alibi_slopes():
    n = N_TOTAL_HEADS
    return jnp.exp2(-8.0 * jnp.arange(1, n + 1, dtype=jnp.float32) / n).reshape(N_ATTN_GROUPS, N_SLOTS)


def pool_mixer(x, w_in, w_group, scale, w_out):
    B, S, D = x.shape
    u = (x @ w_in).reshape(B, S, N_POOL_GROUPS, POOL_GROUP_DIM)
    uf = u.astype(jnp.float32)
    cs = jnp.cumsum(uf, axis=1)
    t = jnp.arange(S)
    outs = []
    for g, w in enumerate(POOL_WINDOWS):
        c = cs[:, :, g]
        lagged = jnp.pad(c, ((0, 0), (w, 0), (0, 0)))[:, :S]
        cnt = jnp.minimum(t + 1, w).astype(jnp.float32)[:, None]
        outs.append((c - lagged) / cnt - uf[:, :, g])
    p = jnp.stack(outs, axis=2).astype(x.dtype)
    y = jnp.einsum('bsgc,gcd->bsgd', p, w_group).reshape(B, S, D) * scale
    return y @ w_out


def strided_window_attention(q, k, v, dil, n_back, slopes):
    B, S, H, E = q.shape
    L = S // dil
    nb = -(-L // BLOCK)
    Lp = nb * BLOCK
    N = B * dil

    def to_blocks(a):
        a = a.reshape(B, L, dil, H, E).transpose(0, 2, 1, 3, 4).reshape(N, L, H, E)
        a = jnp.pad(a, ((0, 0), (0, Lp - L), (0, 0), (0, 0)))
        return a.reshape(N, nb, BLOCK, H, E)

    def with_prev(a):
        prev = jnp.pad(a, ((0, 0), (1, 0), (0, 0), (0, 0), (0, 0)))[:, :nb]
        return jnp.concatenate([prev, a], axis=2)

    def from_blocks(a):
        rest = a.shape[3:]
        a = a.reshape((B, dil, Lp) + rest)[:, :, :L]
        a = jnp.moveaxis(a, 1, 2)
        return a.reshape((B, S) + rest)

    qb = to_blocks(q)
    kw = with_prev(to_blocks(k))
    vw = with_prev(to_blocks(v))
    s = jnp.einsum('nbqhe,nbkhe->nbhqk', qb, kw, preferred_element_type=jnp.float32)
    s = s * (1.0 / math.sqrt(E))
    qi = jnp.arange(BLOCK)[:, None]
    ki = jnp.arange(2 * BLOCK)[None, :]
    dist = qi + BLOCK - ki
    blk = jnp.arange(nb)[:, None, None]
    valid = ((dist >= 0) & (dist <= n_back))[None] & ((blk > 0) | (ki[None] >= BLOCK))
    bias = -slopes[:, None, None] * (dist * dil).astype(jnp.float32)[None]
    s = s + bias[None, None]
    s = jnp.where(valid[None, :, None], s, -jnp.inf)
    m = jnp.max(s, axis=-1, keepdims=True)
    e = jnp.exp(s - m)
    den = jnp.sum(e, axis=-1, keepdims=True)
    p = e / den
    lse = (m + jnp.log(den))[..., 0]
    o = jnp.einsum('nbhqk,nbkhe->nbqhe', p.astype(v.dtype), vw,
                   preferred_element_type=jnp.float32)
    return from_blocks(o), from_blocks(jnp.swapaxes(lse, 2, 3))


def dilated_attention(x, w_qkv, w_out):
    B, S, D = x.shape
    qkv = (x @ w_qkv).reshape(B, S, 3, N_ATTN_GROUPS, N_SLOTS, HEAD_DIM)
    slopes = alibi_slopes()
    outs, lses = [], []
    for g, (w, d) in enumerate(ATTN_PATTERNS):
        o, lse = strided_window_attention(qkv[:, :, 0, g], qkv[:, :, 1, g], qkv[:, :, 2, g],
                                          d, w // d, slopes[g])
        outs.append(o)
        lses.append(lse)
    wts = jax.nn.softmax(jnp.stack(lses, axis=0), axis=0)
    merged = jnp.einsum('gbsh,gbshe->bshe', wts, jnp.stack(outs, axis=0)).astype(x.dtype)
    return merged.reshape(B, S, GROUP_WIDTH) @ w_out


def sqrelu_mlp(x, w_up, w_down):
    h = jax.nn.relu(x @ w_up)
    return (h * h) @ w_down


def setup_inputs(seed: int = 0) -> dict:
    key = jax.random.key(seed)
    ks = jax.random.split(key, 14)
    f32 = jnp.float32
    nrm = lambda k, shape, s: jax.random.normal(k, shape, f32) * s
    x = jax.random.normal(ks[0], (BATCH, SEQ, D_MODEL), f32)
    pool_w_in = nrm(ks[1], (N_POOL_LAYERS, D_MODEL, D_MODEL), D_MODEL ** -0.5)
    pool_w_group = nrm(ks[2], (N_POOL_LAYERS, N_POOL_GROUPS, POOL_GROUP_DIM, POOL_GROUP_DIM), POOL_GROUP_DIM ** -0.5)
    pool_scale = 1.0 + nrm(ks[3], (N_POOL_LAYERS, D_MODEL), 0.1)
    pool_w_out = nrm(ks[4], (N_POOL_LAYERS, D_MODEL, D_MODEL), DEEPNORM_BETA * D_MODEL ** -0.5)
    attn_w_qkv = nrm(ks[5], (N_ATTN_LAYERS, D_MODEL, QKV_WIDTH), D_MODEL ** -0.5)
    attn_w_out = nrm(ks[6], (N_ATTN_LAYERS, GROUP_WIDTH, D_MODEL), DEEPNORM_BETA * GROUP_WIDTH ** -0.5)
    mlp_w_up = nrm(ks[7], (DEPTH, D_MODEL, D_FF), D_MODEL ** -0.5)
    mlp_w_down = nrm(ks[8], (DEPTH, D_FF, D_MODEL), DEEPNORM_BETA * D_FF ** -0.5)
    ln_mix_g = 1.0 + nrm(ks[9], (DEPTH, D_MODEL), 0.05)
    ln_mix_b = nrm(ks[10], (DEPTH, D_MODEL), 0.02)
    ln_mlp_g = 1.0 + nrm(ks[11], (DEPTH, D_MODEL), 0.05)
    ln_mlp_b = nrm(ks[12], (DEPTH, D_MODEL), 0.02)
    return {"x": x, "pool_w_in": pool_w_in, "pool_w_group": pool_w_group, "pool_scale": pool_scale,
            "pool_w_out": pool_w_out, "attn_w_qkv": attn_w_qkv, "attn_w_out": attn_w_out,
            "mlp_w_up": mlp_w_up, "mlp_w_down": mlp_w_down, "ln_mix_g": ln_mix_g, "ln_mix_b": ln_mix_b,
            "ln_mlp_g": ln_mlp_g, "ln_mlp_b": ln_mlp_b}


def reference(x, pool_w_in, pool_w_group, pool_scale, pool_w_out, attn_w_qkv, attn_w_out,
              mlp_w_up, mlp_w_down, ln_mix_g, ln_mix_b, ln_mlp_g, ln_mlp_b):
    for i in range(DEPTH):
        j = i // N_MIXERS
        if i % N_MIXERS == 0:
            h = pool_mixer(x, pool_w_in[j], pool_w_group[j], pool_scale[j], pool_w_out[j])
        else:
            h = dilated_attention(x, attn_w_qkv[j], attn_w_out[j])
        x = layer_norm(DEEPNORM_ALPHA * x + h, ln_mix_g[i], ln_mix_b[i])
        x = layer_norm(DEEPNORM_ALPHA * x + sqrelu_mlp(x, mlp_w_up[i], mlp_w_down[i]),
                       ln_mlp_g[i], ln_mlp_b[i])
    return x
```

```cpp
#include <hip/hip_runtime.h>
#include <hip/hip_cooperative_groups.h>
#include <cstdio>
#include <cstdint>
namespace cg = cooperative_groups;

#define LAS __attribute__((address_space(3)))
typedef unsigned short bf16_t;
typedef short bf16x8 __attribute__((ext_vector_type(8)));
typedef short s16x4 __attribute__((ext_vector_type(4)));
typedef float f32x4 __attribute__((ext_vector_type(4)));
typedef float f32x2 __attribute__((ext_vector_type(2)));
typedef unsigned u32x4 __attribute__((ext_vector_type(4)));
typedef unsigned u32x2 __attribute__((ext_vector_type(2)));

constexpr int DM = 2048, BATCH = 16, SEQ = 2048, MTOK = BATCH * SEQ, FF = 8192, QKVW = 9216, GWID = 1024, HD = 128, NSLOT = 8;
constexpr float LN_EPS = 1e-5f;
constexpr float ALPHA = 1.4142135623730951f;
constexpr size_t MiB = 1u << 20;
constexpr size_t WS_WIN = 1 * MiB, WS_WG = 9 * MiB, WS_WOUT = 11 * MiB, WS_WQKV = 19 * MiB, WS_WAO = 55 * MiB, WS_WUP0 = 59 * MiB, WS_WUP1 = 91 * MiB,
                 WS_WDN0 = 123 * MiB, WS_WDN1 = 155 * MiB, WS_LSE = 188 * MiB, WS_XA = 192 * MiB, WS_XB = 320 * MiB, WS_BIG = 448 * MiB, WS_END = 1024 * MiB;

__device__ __forceinline__ unsigned f2bf(float f) { unsigned u = __builtin_bit_cast(unsigned, f); return (u + 0x7fffu + ((u >> 16) & 1u)) >> 16; }
__device__ __forceinline__ unsigned pk2(float lo, float hi) { return f2bf(lo) | (f2bf(hi) << 16); }
__device__ __forceinline__ float bf_lo(unsigned w) { return __builtin_bit_cast(float, w << 16); }
__device__ __forceinline__ float bf_hi(unsigned w) { return __builtin_bit_cast(float, w & 0xffff0000u); }

namespace pg8 {
constexpr int BM = 256, BK = 64, HALF = 128, HTB = HALF * BK * 2, STAGE_BYTES = 8 * HTB, NXCD = 8, WGM = 8;
__host__ __device__ __forceinline__ int lds_byte(int r, int c) { const int st = (r >> 4) * 2 + (c >> 5), rr = r & 15, cc = c & 31, ob = rr * 64 + cc * 2; return st * 1024 + (ob ^ (((ob >> 9) & 1) << 5)); }
__host__ __device__ __forceinline__ void stage_rc(int b, int& R, int& C) { const int st = b / 1024, sb = b % 1024, swz = sb ^ (((sb >> 9) & 1) << 5); R = (st >> 1) * 16 + swz / 64; C = (st & 1) * 32 + (swz % 64) / 2; }
__host__ __device__ __forceinline__ int perm32(int rho) { const int n = rho >> 4, i = rho & 15; return 8 * (i >> 2) + 4 * n + (i & 3); }

struct Unit { int pm, pn; };
struct Gemm { const bf16_t* A; const bf16_t* Bt; int M, N, K, lda, agdiv, agk; };

struct StaticOrder {
    int nM, nN, nwg, G, c;
    __host__ __device__ void init(int M, int N, int G_, int c_) { nM = M / BM; nN = N / BM; nwg = nM * nN; G = G_; c = c_; }
    __host__ __device__ bool next(int i, Unit& u) const {
        const long L = (long)i * G + c; if (L >= nwg) return false;
        int wgid = (int)L; { const int q = nwg / NXCD, r = nwg % NXCD, xcd = wgid % NXCD, off = wgid / NXCD; wgid = (xcd < r ? xcd * (q + 1) : r * (q + 1) + (xcd - r) * q) + off; }
        const int nig = WGM * nN, gid = wgid / nig, fm = gid * WGM, gsz = (nM - fm) < WGM ? (nM - fm) : WGM;
        u.pm = fm + ((wgid % nig) % gsz); u.pn = (wgid % nig) / gsz; return true;
    }
};

__device__ __forceinline__ unsigned cvt_pk_bf16(float lo, float hi) { unsigned r; asm volatile("v_cvt_pk_bf16_f32 %0, %1, %2" : "=v"(r) : "v"(lo), "v"(hi)); return r; }

template <int ACT, bool SCALE> struct EpiBf16 {
    bf16_t* O; int ldc; const float* colscale;
    __device__ __forceinline__ void operator()(const f32x4 (&acc)[2][2][4][2], const Unit& u, int wr, int wc, int fr, int fq) const {
        const int row0 = u.pm * BM + wr * 64 + fr; const int col0 = u.pn * BM + wc * 32 + 8 * fq;
        f32x4 cs[2][2];
#pragma unroll
        for (int bj = 0; bj < 2; ++bj)
#pragma unroll
            for (int n = 0; n < 2; ++n) cs[bj][n] = SCALE ? *(const f32x4*)(colscale + col0 + bj * HALF + 4 * n) : (f32x4){1.f, 1.f, 1.f, 1.f};
#pragma unroll
        for (int ai = 0; ai < 2; ++ai)
#pragma unroll
            for (int m = 0; m < 4; ++m) { bf16_t* rowp = O + (size_t)(row0 + ai * HALF + m * 16) * ldc + col0;
#pragma unroll
                for (int bj = 0; bj < 2; ++bj) { f32x4 v0 = acc[ai][bj][m][0], v1 = acc[ai][bj][m][1];
                    if (SCALE) { v0 = v0 * cs[bj][0]; v1 = v1 * cs[bj][1]; }
                    if (ACT == 1) {
#pragma unroll
                        for (int j = 0; j < 4; ++j) { const float a = fmaxf(v0[j], 0.f), b = fmaxf(v1[j], 0.f); v0[j] = a * a; v1[j] = b * b; } }
                    u32x4 w; w.x = cvt_pk_bf16(v0[0], v0[1]); w.y = cvt_pk_bf16(v0[2], v0[3]); w.z = cvt_pk_bf16(v1[0], v1[1]); w.w = cvt_pk_bf16(v1[2], v1[3]);
                    *(u32x4*)(rowp + bj * HALF) = w; } }
    }
};
struct EpiRes {
    const bf16_t* X; bf16_t* R; int ldc; float alpha;
    __device__ __forceinline__ void operator()(const f32x4 (&acc)[2][2][4][2], const Unit& u, int wr, int wc, int fr, int fq) const {
        const int row0 = u.pm * BM + wr * 64 + fr; const int col0 = u.pn * BM + wc * 32 + 8 * fq;
#pragma unroll
        for (int ai = 0; ai < 2; ++ai)
#pragma unroll
            for (int m = 0; m < 4; ++m) { const size_t off = (size_t)(row0 + ai * HALF + m * 16) * ldc + col0;
#pragma unroll
                for (int bj = 0; bj < 2; ++bj) { const u32x4 xw = *(const u32x4*)(X + off + bj * HALF);
                    const f32x4 x0 = {bf_lo(xw.x), bf_hi(xw.x), bf_lo(xw.y), bf_hi(xw.y)}, x1 = {bf_lo(xw.z), bf_hi(xw.z), bf_lo(xw.w), bf_hi(xw.w)};
                    const f32x4 v0 = x0 * alpha + acc[ai][bj][m][0], v1 = x1 * alpha + acc[ai][bj][m][1];
                    u32x4 w; w.x = cvt_pk_bf16(v0[0], v0[1]); w.y = cvt_pk_bf16(v0[2], v0[3]); w.z = cvt_pk_bf16(v1[0], v1[1]); w.w = cvt_pk_bf16(v1[2], v1[3]);
                    *(u32x4*)(R + off + bj * HALF) = w; } }
    }
};

template <class Epi, class Sched>
__device__ __forceinline__ void gemm_phase(LAS unsigned char* lds, const Gemm g, const Sched& S, const Epi& E) {
    int tid_o = threadIdx.x; asm volatile("" : "+v"(tid_o));
    const int tid = tid_o, wid = __builtin_amdgcn_readfirstlane(tid >> 6), lane = tid & 63, wr = wid >> 2, wc = wid & 3, fr = lane & 15, fq = lane >> 4;
    const int K = g.K, nt = K / BK, lda = g.lda;
    unsigned voffA[2], voffB[2];
#pragma unroll
    for (int i = 0; i < 2; ++i) { int R, C; stage_rc(tid * 16 + i * 8192, R, C); const int Rb = (R & ~31) + perm32(R & 31);
        voffA[i] = (unsigned)(R * lda + C) * 2u; voffB[i] = (unsigned)(Rb * K + C) * 2u; }
    const size_t kstep = (size_t)(BK * 2);
    const size_t hstepA = (size_t)HALF * lda * 2, hstepB = (size_t)HALF * K * 2;
    const size_t tstepA = 2 * hstepA, tstepB = 2 * hstepB;
    const unsigned ldsw = (unsigned)wid * 1024u;
    const int aoff = lds_byte(wr * 64 + fr, fq * 8), boff = lds_byte(wc * 32 + fr, fq * 8);
#define PG8_SA(b, h) (((b) * 2 + (h)) * HTB)
#define PG8_SB(b, h) ((4 + (b) * 2 + (h)) * HTB)
#define PG8_STAGE(bufoff, gbase, voff) do { _Pragma("unroll") for (int _i = 0; _i < 2; ++_i) \
        __builtin_amdgcn_global_load_lds((const unsigned*)((const char*)(gbase) + (voff)[_i]), (LAS unsigned*)(lds + (bufoff) + ldsw + _i * 8192), 16, 0, 0); } while (0)
#define PG8_LDA(dst, b, h) do { _Pragma("unroll") for (int m = 0; m < 4; ++m) _Pragma("unroll") for (int k = 0; k < 2; ++k) dst[m][k] = *(const LAS bf16x8*)(lds + PG8_SA(b, h) + aoff + m * 2048 + k * 1024); } while (0)
#define PG8_LDB(dst, b, h) do { _Pragma("unroll") for (int n = 0; n < 2; ++n) _Pragma("unroll") for (int k = 0; k < 2; ++k) dst[n][k] = *(const LAS bf16x8*)(lds + PG8_SB(b, h) + boff + n * 2048 + k * 1024); } while (0)
#define PG8_MMA(ai, bj, At, Bt) do { __builtin_amdgcn_s_setprio(1); _Pragma("unroll") for (int m = 0; m < 4; ++m) _Pragma("unroll") for (int n = 0; n < 2; ++n) _Pragma("unroll") for (int k = 0; k < 2; ++k) \
        acc[ai][bj][m][n] = __builtin_amdgcn_mfma_f32_16x16x32_bf16(Bt[n][k], At[m][k], acc[ai][bj][m][n], 0, 0, 0); __builtin_amdgcn_s_setprio(0); } while (0)
#define PG8_WAIT_V(n) asm volatile("s_waitcnt vmcnt(" #n ")" ::: "memory")
#define PG8_WAIT_L(n) asm volatile("s_waitcnt lgkmcnt(" #n ")" ::: "memory")
#define PG8_BAR __builtin_amdgcn_s_barrier()
#define PG8_SCHED __builtin_amdgcn_sched_barrier(0)
#define PG8_AOFF(u) ((size_t)(((u).pn / g.agdiv) * g.agk) * 2)
    Unit cur, nxt; int ui = 0;
    if (!S.next(0, cur)) return;
    f32x4 acc[2][2][4][2];
#pragma unroll
    for (int a = 0; a < 2; ++a)
#pragma unroll
        for (int b = 0; b < 2; ++b)
#pragma unroll
            for (int m = 0; m < 4; ++m)
#pragma unroll
                for (int n = 0; n < 2; ++n) acc[a][b][m][n] = (f32x4){0.f, 0.f, 0.f, 0.f};
    bf16x8 At[4][2], B0[2][2], B1[2][2];
    const char* cA = (const char*)g.A + (size_t)cur.pm * tstepA + PG8_AOFF(cur); const char* cB = (const char*)g.Bt + (size_t)cur.pn * tstepB;
    PG8_STAGE(PG8_SB(0, 0), cB, voffB); PG8_STAGE(PG8_SB(0, 1), cB + hstepB, voffB); PG8_STAGE(PG8_SA(0, 0), cA, voffA); PG8_STAGE(PG8_SA(0, 1), cA + hstepA, voffA);
    if (wr == 1) PG8_BAR;
    PG8_WAIT_V(2); PG8_BAR;
    PG8_STAGE(PG8_SB(1, 0), cB + kstep, voffB); PG8_STAGE(PG8_SA(1, 0), cA + kstep, voffA); PG8_STAGE(PG8_SB(1, 1), cB + hstepB + kstep, voffB);
    PG8_WAIT_V(6); PG8_BAR;
    for (;;) {
        const bool has_next = S.next(ui + 1, nxt);
        const char* nA = has_next ? (const char*)g.A + (size_t)nxt.pm * tstepA + PG8_AOFF(nxt) : cA; const char* nB = has_next ? (const char*)g.Bt + (size_t)nxt.pn * tstepB : cB;
        for (int t = 0; t < nt; t += 2) {
            const bool last = (t == nt - 2);
            const char* a1 = cA + (size_t)(t + 1) * kstep;
            const char* a2 = last ? nA : cA + (size_t)(t + 2) * kstep; const char* b2 = last ? nB : cB + (size_t)(t + 2) * kstep;
            const char* a3 = a2 + kstep; const char* b3 = b2 + kstep;
            PG8_LDB(B0, 0, 0); PG8_LDB(B1, 0, 1); PG8_SCHED; PG8_LDA(At, 0, 0); PG8_STAGE(PG8_SA(1, 1), a1 + hstepA, voffA);
            PG8_WAIT_V(8); PG8_WAIT_L(0); PG8_BAR; PG8_MMA(0, 0, At, B0); PG8_MMA(0, 1, At, B1); PG8_BAR; PG8_SCHED;
            PG8_LDA(At, 0, 1); PG8_STAGE(PG8_SB(0, 0), b2, voffB); PG8_STAGE(PG8_SB(0, 1), b2 + hstepB, voffB); PG8_STAGE(PG8_SA(0, 0), a2, voffA);
            PG8_WAIT_V(8); PG8_WAIT_L(0); PG8_BAR; PG8_MMA(1, 0, At, B0); PG8_MMA(1, 1, At, B1); PG8_BAR; PG8_SCHED;
            PG8_LDB(B0, 1, 0); PG8_LDB(B1, 1, 1); PG8_SCHED; PG8_LDA(At, 1, 0); PG8_STAGE(PG8_SA(0, 1), a2 + hstepA, voffA);
            PG8_WAIT_V(8); PG8_WAIT_L(0); PG8_BAR; PG8_MMA(0, 0, At, B0); PG8_MMA(0, 1, At, B1); PG8_BAR; PG8_SCHED;
            PG8_LDA(At, 1, 1); PG8_STAGE(PG8_SB(1, 0), b3, voffB); PG8_STAGE(PG8_SB(1, 1), b3 + hstepB, voffB); PG8_STAGE(PG8_SA(1, 0), a3, voffA);
            PG8_WAIT_V(8); PG8_WAIT_L(0); PG8_BAR; PG8_MMA(1, 0, At, B0); PG8_MMA(1, 1, At, B1); PG8_BAR; PG8_SCHED;
        }
        if (wr == 0) PG8_BAR;
        E(acc, cur, wr, wc, fr, fq);
        if (!has_next) break;
#pragma unroll
        for (int a = 0; a < 2; ++a)
#pragma unroll
            for (int b = 0; b < 2; ++b)
#pragma unroll
                for (int m = 0; m < 4; ++m)
#pragma unroll
                    for (int n = 0; n < 2; ++n) acc[a][b][m][n] = (f32x4){0.f, 0.f, 0.f, 0.f};
        cur = nxt; cA = nA; cB = nB; ++ui;
        if (wr == 1) PG8_BAR;
    }
    PG8_WAIT_V(0);
    PG8_BAR;
#undef PG8_SA
#undef PG8_SB
#undef PG8_STAGE
#undef PG8_LDA
#undef PG8_LDB
#undef PG8_MMA
#undef PG8_WAIT_V
#undef PG8_WAIT_L
#undef PG8_BAR
#undef PG8_SCHED
#undef PG8_AOFF
}
}

constexpr int NWAVES = 8, NTHR = 512;
constexpr int ATT_KSTR = 272, ATT_VSTR = 288, ATT_K_OFF = 0, ATT_V_OFF = 256 * ATT_KSTR, ATT_BYTES = ATT_V_OFF + 272 * ATT_VSTR;
constexpr int MISC_OFF = ATT_BYTES;
constexpr int LDS_BYTES = 148480;
static_assert(ATT_BYTES <= LDS_BYTES && pg8::STAGE_BYTES <= LDS_BYTES, "LDS map");

struct Params {
    const float* x; const float* w_in; const float* w_group; const float* pool_scale; const float* w_out; const float* w_qkv; const float* w_ao;
    const float* w_up; const float* w_dn; const float* ln_mix_g; const float* ln_mix_b; const float* ln_mlp_g; const float* ln_mlp_b;
    float* out; unsigned char* ws;
};

__device__ __forceinline__ float wave_sum(float v) {
#pragma unroll
    for (int o = 1; o < 64; o <<= 1) v += __shfl_xor(v, o);
    return v;
}

__device__ __forceinline__ void p0_transpose_item(const float* W, int K, int N, bf16_t* WT, int row_off, LAS float* scr, int item, int lane) {
    const int nblk = N / 32, kb = item / nblk, nb = item % nblk, k0 = 64 * kb, n0 = 32 * nb;
#pragma unroll 8
    for (int i = 0; i < 32; ++i) { const int kk = 2 * i + (lane >> 5); scr[kk * 33 + (lane & 31)] = W[(size_t)(k0 + kk) * N + n0 + (lane & 31)]; }
    asm volatile("s_waitcnt lgkmcnt(0)" ::: "memory");
    const int c = lane & 7;
#pragma unroll
    for (int j = 0; j < 4; ++j) { const int n = (lane >> 3) + 8 * j; const LAS float* s = scr + (8 * c) * 33 + n;
        u32x4 o; o.x = pk2(s[0 * 33], s[1 * 33]); o.y = pk2(s[2 * 33], s[3 * 33]); o.z = pk2(s[4 * 33], s[5 * 33]); o.w = pk2(s[6 * 33], s[7 * 33]);
        *(u32x4*)(WT + (size_t)(row_off + n0 + n) * K + k0 + 8 * c) = o; }
    asm volatile("s_waitcnt lgkmcnt(0)" ::: "memory");
}

__device__ __forceinline__ void phase_prologue(const Params& p, LAS unsigned char* lds) {
    const int tid = threadIdx.x, lane = tid & 63, wave = __builtin_amdgcn_readfirstlane(tid >> 6);
    LAS float* scr = (LAS float*)(lds + wave * 16384);
    const int gw = blockIdx.x * NWAVES + wave, NGW = gridDim.x * NWAVES;
    unsigned char* ws = p.ws;
    constexpr int I_IN = (DM / 64) * (DM / 32), I_G = (512 / 64) * (512 / 32), I_OUT = I_IN, I_QKV = (DM / 64) * (QKVW / 32), I_AO = (GWID / 64) * (DM / 32),
                  I_UP = (DM / 64) * (FF / 32), I_DN = (FF / 64) * (DM / 32);
    constexpr int NITEMS = I_IN + 4 * I_G + I_OUT + I_QKV + I_AO + 2 * I_UP + 2 * I_DN;
    for (int it = gw; it < NITEMS; it += NGW) {
        int r = it;
        if (r < I_IN) { p0_transpose_item(p.w_in, DM, DM, (bf16_t*)(ws + WS_WIN), 0, scr, r, lane); continue; } r -= I_IN;
        if (r < 4 * I_G) { const int g = r / I_G; p0_transpose_item(p.w_group + (size_t)g * 512 * 512, 512, 512, (bf16_t*)(ws + WS_WG), g * 512, scr, r % I_G, lane); continue; } r -= 4 * I_G;
        if (r < I_OUT) { p0_transpose_item(p.w_out, DM, DM, (bf16_t*)(ws + WS_WOUT), 0, scr, r, lane); continue; } r -= I_OUT;
        if (r < I_QKV) { p0_transpose_item(p.w_qkv, DM, QKVW, (bf16_t*)(ws + WS_WQKV), 0, scr, r, lane); continue; } r -= I_QKV;
        if (r < I_AO) { p0_transpose_item(p.w_ao, GWID, DM, (bf16_t*)(ws + WS_WAO), 0, scr, r, lane); continue; } r -= I_AO;
        if (r < 2 * I_UP) { const int l = r / I_UP; p0_transpose_item(p.w_up + (size_t)l * DM * FF, DM, FF, (bf16_t*)(ws + (l ? WS_WUP1 : WS_WUP0)), 0, scr, r % I_UP, lane); continue; } r -= 2 * I_UP;
        { const int l = r / I_DN; p0_transpose_item(p.w_dn + (size_t)l * FF * DM, FF, DM, (bf16_t*)(ws + (l ? WS_WDN1 : WS_WDN0)), 0, scr, r % I_DN, lane); }
    }
    const size_t n8 = (size_t)MTOK * DM / 8; bf16_t* xa = (bf16_t*)(ws + WS_XA);
    for (size_t i = (size_t)blockIdx.x * NTHR + tid; i < n8; i += (size_t)gridDim.x * NTHR) {
        const f32x4 a = *(const f32x4*)(p.x + i * 8), b = *(const f32x4*)(p.x + i * 8 + 4);
        u32x4 o; o.x = pk2(a.x, a.y); o.y = pk2(a.z, a.w); o.z = pk2(b.x, b.y); o.w = pk2(b.z, b.w);
        *(u32x4*)(xa + i * 8) = o;
    }
}

__device__ __forceinline__ void phase_pool(const bf16_t* U, bf16_t* P) {
    constexpr int TB = 32, NITEMS = (MTOK / TB) * (DM / 8);
    for (int id = blockIdx.x * NTHR + threadIdx.x; id < NITEMS; id += gridDim.x * NTHR) {
        const int c8 = id & 255, tb = id >> 8, t0 = tb * TB, pos0 = t0 & (SEQ - 1), g = c8 >> 6, w = 2 << g;
        const bf16_t* up = U + (size_t)t0 * DM + c8 * 8; bf16_t* pp = P + (size_t)t0 * DM + c8 * 8;
        float s[8];
#pragma unroll
        for (int j = 0; j < 8; ++j) s[j] = 0.f;
        for (int k = 1; k <= w; ++k) { if (pos0 - k >= 0) { const u32x4 v = *(const u32x4*)(up - (ptrdiff_t)k * DM);
            s[0] += bf_lo(v.x); s[1] += bf_hi(v.x); s[2] += bf_lo(v.y); s[3] += bf_hi(v.y); s[4] += bf_lo(v.z); s[5] += bf_hi(v.z); s[6] += bf_lo(v.w); s[7] += bf_hi(v.w); } }
        for (int t = 0; t < TB; ++t) {
            const int pos = pos0 + t;
            const u32x4 v = *(const u32x4*)(up + (size_t)t * DM);
            float c[8] = {bf_lo(v.x), bf_hi(v.x), bf_lo(v.y), bf_hi(v.y), bf_lo(v.z), bf_hi(v.z), bf_lo(v.w), bf_hi(v.w)};
#pragma unroll
            for (int j = 0; j < 8; ++j) s[j] += c[j];
            if (pos >= w) { const u32x4 o = *(const u32x4*)(up + (ptrdiff_t)(t - w) * DM);
                s[0] -= bf_lo(o.x); s[1] -= bf_hi(o.x); s[2] -= bf_lo(o.y); s[3] -= bf_hi(o.y); s[4] -= bf_lo(o.z); s[5] -= bf_hi(o.z); s[6] -= bf_lo(o.w); s[7] -= bf_hi(o.w); }
            const float inv = 1.f / (float)(pos + 1 < w ? pos + 1 : w);
            u32x4 r; r.x = pk2(s[0] * inv - c[0], s[1] * inv - c[1]); r.y = pk2(s[2] * inv - c[2], s[3] * inv - c[3]);
            r.z = pk2(s[4] * inv - c[4], s[5] * inv - c[5]); r.w = pk2(s[6] * inv - c[6], s[7] * inv - c[7]);
            *(u32x4*)(pp + (size_t)t * DM) = r;
        }
    }
}

template <bool F32OUT>
__device__ __forceinline__ void phase_ln(const bf16_t* R, const float* gam, const float* bet, bf16_t* XO, float* FO) {
    const int tid = threadIdx.x, lane = tid & 63, wave = tid >> 6;
    const int gw = blockIdx.x * NWAVES + wave, NGW = gridDim.x * NWAVES;
    for (int m = gw; m < MTOK; m += NGW) {
        const u32x4* xr = (const u32x4*)(R + (size_t)m * DM) + lane;
        float v[4][8]; float s = 0.f;
#pragma unroll
        for (int j = 0; j < 4; ++j) { const u32x4 w = xr[64 * j];
            v[j][0] = bf_lo(w.x); v[j][1] = bf_hi(w.x); v[j][2] = bf_lo(w.y); v[j][3] = bf_hi(w.y); v[j][4] = bf_lo(w.z); v[j][5] = bf_hi(w.z); v[j][6] = bf_lo(w.w); v[j][7] = bf_hi(w.w);
#pragma unroll
            for (int e = 0; e < 8; ++e) s += v[j][e]; }
        const float mean = wave_sum(s) * (1.f / DM); float s2 = 0.f;
#pragma unroll
        for (int j = 0; j < 4; ++j)
#pragma unroll
            for (int e = 0; e < 8; ++e) { v[j][e] -= mean; s2 += v[j][e] * v[j][e]; }
        const float rstd = 1.f / sqrtf(wave_sum(s2) * (1.f / DM) + LN_EPS);
#pragma unroll
        for (int j = 0; j < 4; ++j) {
            const int c0 = (lane + 64 * j) * 8;
            const f32x4 g0 = *(const f32x4*)(gam + c0), g1 = *(const f32x4*)(gam + c0 + 4), b0 = *(const f32x4*)(bet + c0), b1 = *(const f32x4*)(bet + c0 + 4);
            const f32x4 y0 = (f32x4){v[j][0], v[j][1], v[j][2], v[j][3]} * rstd * g0 + b0, y1 = (f32x4){v[j][4], v[j][5], v[j][6], v[j][7]} * rstd * g1 + b1;
            if (F32OUT) { *(f32x4*)(FO + (size_t)m * DM + c0) = y0; *(f32x4*)(FO + (size_t)m * DM + c0 + 4) = y1; }
            else { u32x4 o; o.x = pk2(y0.x, y0.y); o.y = pk2(y0.z, y0.w); o.z = pk2(y1.x, y1.y); o.w = pk2(y1.z, y1.w); *((u32x4*)(XO + (size_t)m * DM) + lane + 64 * j) = o; }
        }
    }
}

__device__ __forceinline__ s16x4 vtr(const LAS unsigned char* p) { return __builtin_bit_cast(s16x4, __builtin_amdgcn_ds_read_tr16_b64_v4i16((LAS s16x4*)p)); }

struct AttnId { int g, b, r, qb, j, ldprev; };
__device__ __forceinline__ AttnId attn_decode(int pass, int c, int i) {
    AttnId a; a.ldprev = 0;
    if (pass == 0) {
        if (i < 8) { a.g = 0; a.j = c & 7; a.b = (c >> 3) & 15; const int half = c >> 7; a.r = 0; a.qb = half * 8 + i; a.ldprev = (half == 1 && i == 0) ? 1 : 0; }
        else { const int ch = 2 * c + ((i - 8) >> 2); a.g = 1; a.j = ch & 7; a.r = (ch >> 3) & 3; a.b = ch >> 5; a.qb = (i - 8) & 3; }
    } else { const int id = 8 * c + i; a.g = 2; a.j = id & 7; a.r = (id >> 3) & 15; a.b = id >> 7; a.qb = 0; }
    return a;
}
__device__ __forceinline__ void attn_fetch(const bf16_t* qkv, const AttnId& a, int blk, u32x4 (&kv)[4], u32x4 (&vv)[4], int tid) {
    const int dsh = (a.g == 0) ? 0 : (a.g == 1 ? 2 : 4);
    const size_t rowbase = (size_t)a.b * SEQ; const int colq = a.g * GWID + a.j * HD;
    const int chunk = tid & 15, rb = tid >> 4;
    const bf16_t* kbase = qkv + 3072 + colq + chunk * 8;
#pragma unroll
    for (int it = 0; it < 4; ++it) { const int sub = blk * 128 + it * 32 + rb;
        const bf16_t* pk = kbase + (rowbase + (size_t)(sub << dsh) + a.r) * QKVW; kv[it] = *(const u32x4*)pk; vv[it] = *(const u32x4*)(pk + 3072); }
}
__device__ __forceinline__ void attn_fetch_q(const bf16_t* qkv, const AttnId& a, bf16x8 (&qf)[4], int w, int fr, int fq) {
    const int dsh = (a.g == 0) ? 0 : (a.g == 1 ? 2 : 4);
    const size_t qrow = (size_t)a.b * SEQ + (size_t)((a.qb * 128 + 16 * w + fr) << dsh) + a.r; const int colq = a.g * GWID + a.j * HD;
#pragma unroll
    for (int kk = 0; kk < 4; ++kk) qf[kk] = *(const bf16x8*)(qkv + qrow * QKVW + colq + 32 * kk + 8 * fq);
}
__device__ __forceinline__ void attn_put(LAS unsigned char* lds, int half, const u32x4 (&kv)[4], const u32x4 (&vv)[4], int tid) {
    const int chunk = tid & 15, rb = tid >> 4;
#pragma unroll
    for (int it = 0; it < 4; ++it) { const int row = half * 128 + it * 32 + rb;
        *(LAS u32x4*)(lds + ATT_K_OFF + row * ATT_KSTR + chunk * 16) = kv[it]; *(LAS u32x4*)(lds + ATT_V_OFF + row * ATT_VSTR + chunk * 16) = vv[it]; }
}
__device__ __forceinline__ int attn_trow(int T, int ch) { return T >= 16 ? 256 : ((((T >> 3) ^ 1) ^ ch) << 7) + ((T & 7) << 4); }

__device__ __forceinline__ void attn_scores(LAS unsigned char* lds, int ch, const bf16x8 (&qf)[4], f32x4 (&s)[9], int w, int fr, int fq) {
    LAS unsigned char* Kl = lds + ATT_K_OFF;
#pragma unroll
    for (int tt = 0; tt < 9; ++tt) { s[tt] = (f32x4){0.f, 0.f, 0.f, 0.f}; const int rowb = attn_trow(w + tt, ch);
#pragma unroll
        for (int kk = 0; kk < 4; ++kk) { const bf16x8 av = *(const LAS bf16x8*)(Kl + (rowb + fr) * ATT_KSTR + (32 * kk + 8 * fq) * 2);
            s[tt] = __builtin_amdgcn_mfma_f32_16x16x32_bf16(av, qf[kk], s[tt], 0, 0, 0); } }
}
__device__ __forceinline__ void attn_finish(LAS unsigned char* lds, int ch, const AttnId& a, f32x4 (&s)[9], bf16_t* obuf, float* lsebuf, bf16_t* merged, int w, int fr, int fq) {
    const int g = a.g, j = a.j, qb = a.qb;
    const int dsh = (g == 0) ? 0 : (g == 1 ? 2 : 4), d = 1 << dsh;
    const size_t qrow = (size_t)a.b * SEQ + (size_t)((qb * 128 + 16 * w + fr) << dsh) + a.r;
    LAS unsigned char* Vl = lds + ATT_V_OFF;
    constexpr float LOG2E = 1.4426950408889634f;
    const float sc = 0.08838834764831845f * LOG2E;
    const float slope = exp2f(-8.0f * (float)(g * NSLOT + j + 1) / 24.0f);
    const float sl = slope * (float)d * LOG2E;
    float mx = -INFINITY;
#pragma unroll
    for (int tt = 0; tt < 9; ++tt)
#pragma unroll
        for (int jj = 0; jj < 4; ++jj) {
            const int dist = 128 + fr - 16 * tt - 4 * fq - jj, kidx = 16 * (w + tt) + 4 * fq + jj;
            const bool valid = (dist >= 0) && (dist <= 128) && (qb > 0 || kidx >= 128);
            const float v = valid ? (s[tt][jj] * sc - sl * (float)dist) : -INFINITY;
            s[tt][jj] = v; mx = fmaxf(mx, v);
        }
    mx = fmaxf(mx, __shfl_xor(mx, 16)); mx = fmaxf(mx, __shfl_xor(mx, 32));
    float sum = 0.f;
#pragma unroll
    for (int tt = 0; tt < 9; ++tt)
#pragma unroll
        for (int jj = 0; jj < 4; ++jj) { const float e = exp2f(s[tt][jj] - mx); s[tt][jj] = e; sum += e; }
    sum += __shfl_xor(sum, 16); sum += __shfl_xor(sum, 32);
    bf16x8 pf[5];
#pragma unroll
    for (int c = 0; c < 5; ++c) {
        u32x4 pw; pw.x = pk2(s[2 * c][0], s[2 * c][1]); pw.y = pk2(s[2 * c][2], s[2 * c][3]);
        if (c < 4) { pw.z = pk2(s[2 * c + 1][0], s[2 * c + 1][1]); pw.w = pk2(s[2 * c + 1][2], s[2 * c + 1][3]); } else { pw.z = 0u; pw.w = 0u; }
        pf[c] = __builtin_bit_cast(bf16x8, pw);
    }
    f32x4 o[8];
#pragma unroll
    for (int dt = 0; dt < 8; ++dt) o[dt] = (f32x4){0.f, 0.f, 0.f, 0.f};
    const int lofs = (4 * fq + (fr >> 2)) * ATT_VSTR + (4 * (fr & 3)) * 2;
#pragma unroll
    for (int c = 0; c < 5; ++c) {
        __builtin_amdgcn_sched_barrier(0);
        const LAS unsigned char* v0 = Vl + attn_trow(w + 2 * c, ch) * ATT_VSTR + lofs; const LAS unsigned char* v1 = Vl + attn_trow(w + 2 * c + 1, ch) * ATT_VSTR + lofs;
#pragma unroll
        for (int dt = 0; dt < 8; ++dt) {
            const s16x4 lo = vtr(v0 + dt * 32), hi = vtr(v1 + dt * 32);
            const bf16x8 av = {lo[0], lo[1], lo[2], lo[3], hi[0], hi[1], hi[2], hi[3]};
            o[dt] = __builtin_amdgcn_mfma_f32_16x16x32_bf16(av, pf[c], o[dt], 0, 0, 0);
        }
    }
    const float inv = 1.f / sum;
    const float lse = (mx + log2f(sum)) * 0.6931471805599453f;
    if (g < 2) {
        bf16_t* orow = obuf + ((size_t)g * MTOK + qrow) * GWID + j * HD + 4 * fq;
#pragma unroll
        for (int dt = 0; dt < 8; ++dt) { u32x2 ow; ow.x = pk2(o[dt][0] * inv, o[dt][1] * inv); ow.y = pk2(o[dt][2] * inv, o[dt][3] * inv); *(u32x2*)(orow + 16 * dt) = ow; }
        if (fq == 0) lsebuf[((size_t)g * MTOK + qrow) * NSLOT + j] = lse;
    } else {
        const float l0 = lsebuf[qrow * NSLOT + j], l1 = lsebuf[((size_t)MTOK + qrow) * NSLOT + j];
        const float lm = fmaxf(lse, fmaxf(l0, l1));
        float e0 = __expf(l0 - lm), e1 = __expf(l1 - lm), e2 = __expf(lse - lm); const float wi = 1.f / (e0 + e1 + e2); e0 *= wi; e1 *= wi; e2 *= wi * inv;
        const bf16_t* o0p = obuf + qrow * GWID + j * HD + 4 * fq; const bf16_t* o1p = o0p + (size_t)MTOK * GWID;
        bf16_t* mrow = merged + qrow * GWID + j * HD + 4 * fq;
#pragma unroll
        for (int dt = 0; dt < 8; ++dt) { const u32x2 a0 = *(const u32x2*)(o0p + 16 * dt), a1 = *(const u32x2*)(o1p + 16 * dt);
            u32x2 ow; ow.x = pk2(e0 * bf_lo(a0.x) + e1 * bf_lo(a1.x) + e2 * o[dt][0], e0 * bf_hi(a0.x) + e1 * bf_hi(a1.x) + e2 * o[dt][1]);
            ow.y = pk2(e0 * bf_lo(a0.y) + e1 * bf_lo(a1.y) + e2 * o[dt][2], e0 * bf_hi(a0.y) + e1 * bf_hi(a1.y) + e2 * o[dt][3]);
            *(u32x2*)(mrow + 16 * dt) = ow; }
    }
}

#define ATT_LBAR() do { asm volatile("s_waitcnt lgkmcnt(0)" ::: "memory"); __builtin_amdgcn_s_barrier(); asm volatile("" ::: "memory"); } while (0)
__device__ __forceinline__ void phase_attn(LAS unsigned char* lds, const bf16_t* qkv, bf16_t* obuf, float* lsebuf, bf16_t* merged, int pass) {
    int tid_o = threadIdx.x; asm volatile("" : "+v"(tid_o));
    const int tid = tid_o, lane = tid & 63, w = __builtin_amdgcn_readfirstlane(tid >> 6), fr = lane & 15, fq = lane >> 4;
    const int c = blockIdx.x, n = pass == 0 ? 16 : 8;
    for (int i = tid; i < ATT_BYTES / 16; i += NTHR) ((LAS u32x4*)lds)[i] = (u32x4){0u, 0u, 0u, 0u};
    ATT_LBAR();
    u32x4 kv[4], vv[4]; bf16x8 qn[4];
    AttnId cur = attn_decode(pass, c, 0);
    attn_fetch(qkv, cur, cur.qb, kv, vv, tid); attn_fetch_q(qkv, cur, qn, w, fr, fq);
    for (int i = 0; i < n; ++i) {
        const int ch = cur.qb & 1;
        attn_put(lds, ch, kv, vv, tid);
        if (cur.ldprev) { attn_fetch(qkv, cur, cur.qb - 1, kv, vv, tid); attn_put(lds, ch ^ 1, kv, vv, tid); }
        ATT_LBAR();
        f32x4 sacc[9];
        attn_scores(lds, ch, qn, sacc, w, fr, fq);
        __builtin_amdgcn_sched_barrier(0);
        AttnId nxt = cur;
        if (i + 1 < n) { nxt = attn_decode(pass, c, i + 1); attn_fetch(qkv, nxt, nxt.qb, kv, vv, tid); attn_fetch_q(qkv, nxt, qn, w, fr, fq); }
        attn_finish(lds, ch, cur, sacc, obuf, lsebuf, merged, w, fr, fq);
        ATT_LBAR();
        cur = nxt;
    }
}

#define XB_TMO      128
#define XB_XCNT(j)  (256  + 64 * (j))
#define XB_XSUB(j)  (1280 + 64 * (j))
#define XB_XGEN(j)  (2304 + 64 * (j))
#define XB_TOP      3328
#define XB_TOPGEN   3392
#define XCD_BAR_WORDS 3456
#define XB_SPIN_CAP (1u << 22)
__device__ __forceinline__ unsigned xb_ld(unsigned* p)              { return __hip_atomic_load(p, __ATOMIC_RELAXED, __HIP_MEMORY_SCOPE_AGENT); }
__device__ __forceinline__ unsigned xb_add(unsigned* p, unsigned v) { return __hip_atomic_fetch_add(p, v, __ATOMIC_RELAXED, __HIP_MEMORY_SCOPE_AGENT); }
__device__ __forceinline__ unsigned xb_xcc_id() { return (unsigned)__builtin_amdgcn_s_getreg((3 << 11) | 20) & 0xFu; }
#define XB_SPIN(cond, bar) do { unsigned _sp = 0; while (cond) { __builtin_amdgcn_s_sleep(1); \
    if ((++_sp & 255u) == 0u) { if (xb_ld(&(bar)[XB_TMO])) break; if (_sp > XB_SPIN_CAP) { atomicAdd(&(bar)[XB_TMO], 1u); break; } } } } while (0)
struct XcdBarrier { unsigned* bar; unsigned x; volatile LAS unsigned* st; };
__device__ __forceinline__ XcdBarrier xcd_barrier_post(unsigned* bar, volatile LAS unsigned* st) {
    XcdBarrier b; b.bar = bar; b.x = xb_xcc_id(); b.st = st;
    if (threadIdx.x == 0) (void)xb_add(&bar[XB_XCNT(b.x)], 1u);
    return b;
}
__device__ __forceinline__ void xcd_barrier_complete(unsigned* bar, unsigned x, unsigned& nloc, unsigned& nx) {
    const unsigned G = gridDim.x * gridDim.y * gridDim.z;
    unsigned sum, cnt, mine, sp = 0u;
    for (;;) {
        sum = 0u; cnt = 0u; mine = 0u;
#pragma unroll
        for (unsigned j = 0; j < 16; ++j) { const unsigned c = xb_ld(&bar[XB_XCNT(j)]); sum += c; cnt += (c > 0u) ? 1u : 0u; mine = (j == x) ? c : mine; }
        if (sum == G) break;
        __builtin_amdgcn_s_sleep(1);
        if ((++sp & 255u) == 0u) { if (xb_ld(&bar[XB_TMO])) break; if (sp > XB_SPIN_CAP) { atomicAdd(&bar[XB_TMO], 1u); break; } }
    }
    nloc = mine > 0u ? mine : 1u; nx = cnt > 0u ? cnt : 1u;
}
__device__ __forceinline__ void xcd_barrier(const XcdBarrier& b) {
    asm volatile("s_waitcnt vmcnt(0)" ::: "memory");
    __syncthreads();
    if (threadIdx.x == 0) {
        unsigned* bar = b.bar;
        __builtin_amdgcn_s_waitcnt(0);
        unsigned nloc = b.st[0], nx = b.st[1];
        if (nloc == 0u) { xcd_barrier_complete(bar, b.x, nloc, nx); b.st[0] = nloc; b.st[1] = nx; }
        const unsigned old = xb_add(&bar[XB_XSUB(b.x)], 1u);
        const unsigned gen = old / nloc;
        if (old + 1u == (gen + 1u) * nloc) {
            __builtin_amdgcn_fence(__ATOMIC_RELEASE, "agent");
            asm volatile("s_waitcnt vmcnt(0)" ::: "memory");
            const unsigned og = xb_add(&bar[XB_TOP], 1u);
            const unsigned tg = og / nx;
            if (og + 1u == (tg + 1u) * nx) xb_add(&bar[XB_TOPGEN], 1u);
            else XB_SPIN(xb_ld(&bar[XB_TOPGEN]) == tg, bar);
            __builtin_amdgcn_fence(__ATOMIC_ACQUIRE, "agent");
            xb_add(&bar[XB_XGEN(b.x)], 1u);
            asm volatile("s_waitcnt vmcnt(0)" ::: "memory");
        } else {
            XB_SPIN(xb_ld(&bar[XB_XGEN(b.x)]) == gen, bar);
            __builtin_amdgcn_fence(__ATOMIC_ACQUIRE, "agent");
            asm volatile("s_waitcnt vmcnt(0)" ::: "memory");
        }
    }
    __syncthreads();
}

__global__ void __launch_bounds__(NTHR, 2) fwd_megakernel(Params p) {
    extern __shared__ __attribute__((aligned(16))) unsigned char lds_raw[];
    LAS unsigned char* lds = (LAS unsigned char*)lds_raw;
    cg::grid_group grid = cg::this_grid();
    unsigned char* ws = p.ws;
    bf16_t* XA = (bf16_t*)(ws + WS_XA); bf16_t* XB = (bf16_t*)(ws + WS_XB);
    bf16_t* BIG = (bf16_t*)(ws + WS_BIG);
    bf16_t* U = BIG; bf16_t* PB = BIG + (size_t)MTOK * DM; bf16_t* Y = BIG + 2 * (size_t)MTOK * DM;
    bf16_t* R = (bf16_t*)p.out;
    volatile LAS unsigned* MISC = (volatile LAS unsigned*)(lds + MISC_OFF);
    unsigned* barw = (unsigned*)ws;
    const int G = gridDim.x, c = blockIdx.x;
    constexpr int NOG = 1 << 30;

    if (blockIdx.x == 0) for (int i = threadIdx.x; i < XCD_BAR_WORDS; i += NTHR) barw[i] = 0u;
    if (threadIdx.x < 2) MISC[threadIdx.x] = 0u;
    phase_prologue(p, lds);
    grid.sync();
    const XcdBarrier xbar = xcd_barrier_post(barw, MISC);
    {
        pg8::Gemm g{XA, (const bf16_t*)(ws + WS_WIN), MTOK, DM, DM, DM, NOG, 0}; pg8::StaticOrder S; S.init(MTOK, DM, G, c);
        pg8::EpiBf16<0, false> E{U, DM, nullptr};
        pg8::gemm_phase(lds, g, S, E);
    }
    xcd_barrier(xbar);
    phase_pool(U, PB);
    xcd_barrier(xbar);
    {
        pg8::Gemm g{PB, (const bf16_t*)(ws + WS_WG), MTOK, DM, 512, DM, 2, 512}; pg8::StaticOrder S; S.init(MTOK, DM, G, c);
        pg8::EpiBf16<0, true> E{Y, DM, p.pool_scale};
        pg8::gemm_phase(lds, g, S, E);
    }
    xcd_barrier(xbar);
    {
        pg8::Gemm g{Y, (const bf16_t*)(ws + WS_WOUT), MTOK, DM, DM, DM, NOG, 0}; pg8::StaticOrder S; S.init(MTOK, DM, G, c);
        pg8::EpiRes E{XA, R, DM, ALPHA};
        pg8::gemm_phase(lds, g, S, E);
    }
    xcd_barrier(xbar);
    phase_ln<false>(R, p.ln_mix_g, p.ln_mix_b, XB, nullptr);
    xcd_barrier(xbar);
    {
        pg8::Gemm g{XB, (const bf16_t*)(ws + WS_WUP0), MTOK, FF, DM, DM, NOG, 0}; pg8::StaticOrder S; S.init(MTOK, FF, G, c);
        pg8::EpiBf16<1, false> E{BIG, FF, nullptr};
        pg8::gemm_phase(lds, g, S, E);
    }
    xcd_barrier(xbar);
    {
        pg8::Gemm g{BIG, (const bf16_t*)(ws + WS_WDN0), MTOK, DM, FF, FF, NOG, 0}; pg8::StaticOrder S; S.init(MTOK, DM, G, c);
        pg8::EpiRes E{XB, R, DM, ALPHA};
        pg8::gemm_phase(lds, g, S, E);
    }
    xcd_barrier(xbar);
    phase_ln<false>(R, p.ln_mlp_g, p.ln_mlp_b, XA, nullptr);
    xcd_barrier(xbar);
    {
        pg8::Gemm g{XA, (const bf16_t*)(ws + WS_WQKV), MTOK, QKVW, DM, DM, NOG, 0}; pg8::StaticOrder S; S.init(MTOK, QKVW, G, c);
        pg8::EpiBf16<0, false> E{BIG, QKVW, nullptr};
        pg8::gemm_phase(lds, g, S, E);
    }
    xcd_barrier(xbar);
    phase_attn(lds, BIG, (bf16_t*)p.out, (float*)(ws + WS_LSE), XB, 0);
    xcd_barrier(xbar);
    phase_attn(lds, BIG, (bf16_t*)p.out, (float*)(ws + WS_LSE), XB, 1);
    xcd_barrier(xbar);
    {
        pg8::Gemm g{XB, (const bf16_t*)(ws + WS_WAO), MTOK, DM, GWID, GWID, NOG, 0}; pg8::StaticOrder S; S.init(MTOK, DM, G, c);
        pg8::EpiRes E{XA, R, DM, ALPHA};
        pg8::gemm_phase(lds, g, S, E);
    }
    xcd_barrier(xbar);
    phase_ln<false>(R, p.ln_mix_g + DM, p.ln_mix_b + DM, XB, nullptr);
    xcd_barrier(xbar);
    {
        pg8::Gemm g{XB, (const bf16_t*)(ws + WS_WUP1), MTOK, FF, DM, DM, NOG, 0}; pg8::StaticOrder S; S.init(MTOK, FF, G, c);
        pg8::EpiBf16<1, false> E{BIG, FF, nullptr};
        pg8::gemm_phase(lds, g, S, E);
    }
    xcd_barrier(xbar);
    {
        pg8::Gemm g{BIG, (const bf16_t*)(ws + WS_WDN1), MTOK, DM, FF, FF, NOG, 0}; pg8::StaticOrder S; S.init(MTOK, DM, G, c);
        pg8::EpiRes E{XB, XA, DM, ALPHA};
        pg8::gemm_phase(lds, g, S, E);
    }
    xcd_barrier(xbar);
    phase_ln<true>(XA, p.ln_mlp_g + DM, p.ln_mlp_b + DM, nullptr, p.out);
}

extern "C" void kernel_launch(void* const* d_in, const int* in_sizes, int n_in, void* d_out, int out_size, void* d_ws, size_t ws_size, hipStream_t stream) {
    static int grid = 0;
    if (grid == 0) {
        if (n_in != 13 || in_sizes[0] != MTOK * DM || out_size != MTOK * DM || ws_size < WS_END) {
            fprintf(stderr, "kernel_launch: unexpected shapes: n_in %d in0 %d out %d ws %zu (need %zu); nothing launched\n", n_in, n_in > 0 ? in_sizes[0] : -1, out_size, ws_size, (size_t)WS_END); grid = -1; return; }
        int dev = 0, cus = 0, per_cu = 0;
        hipGetDevice(&dev);
        hipDeviceGetAttribute(&cus, hipDeviceAttributeMultiprocessorCount, dev);
        if (hipFuncSetAttribute((const void*)fwd_megakernel, hipFuncAttributeMaxDynamicSharedMemorySize, LDS_BYTES) != hipSuccess) { fprintf(stderr, "kernel_launch: hipFuncSetAttribute failed\n"); grid = -1; return; }
        if (hipOccupancyMaxActiveBlocksPerMultiprocessor(&per_cu, (const void*)fwd_megakernel, NTHR, LDS_BYTES) != hipSuccess || per_cu < 1) { fprintf(stderr, "kernel_launch: occupancy query gave %d\n", per_cu); per_cu = 1; }
        (void)hipGetLastError();
        grid = cus * per_cu;
        if (grid != 256) { fprintf(stderr, "kernel_launch: this kernel needs exactly 256 co-resident workgroups, got %d\n", grid); if (grid > 256) grid = 256; }
        fprintf(stderr, "kernel_launch: grid %d (cus %d x %d)\n", grid, cus, per_cu);
    }
    if (grid < 0) return;
    Params p{};
    p.x = (const float*)d_in[0]; p.w_in = (const float*)d_in[1]; p.w_group = (const float*)d_in[2]; p.pool_scale = (const float*)d_in[3]; p.w_out = (const float*)d_in[4];
    p.w_qkv = (const float*)d_in[5]; p.w_ao = (const float*)d_in[6]; p.w_up = (const float*)d_in[7]; p.w_dn = (const float*)d_in[8];
    p.ln_mix_g = (const float*)d_in[9]; p.ln_mix_b = (const float*)d_in[10]; p.ln_mlp_g = (const float*)d_in[11]; p.ln_mlp_b = (const float*)d_in[12];
    p.out = (float*)d_out; p.ws = (unsigned char*)d_ws;
    void* args[] = {&p};
    hipError_t e = hipLaunchCooperativeKernel((const void*)fwd_megakernel, dim3(grid), dim3(NTHR), args, LDS_BYTES, stream);
    if (e != hipSuccess) fprintf(stderr, "kernel_launch: cooperative launch failed: %s (grid %d)\n", hipGetErrorString(e), grid);
}
```

```cpp
#include <hip/hip_runtime.h>
#include <hip/hip_cooperative_groups.h>
#include <cstdio>
#include <cstdint>
namespace cg = cooperative_groups;

#define LAS __attribute__((address_space(3)))
typedef unsigned short bf16_t;
typedef short bf16x8 __attribute__((ext_vector_type(8)));
typedef short s16x4 __attribute__((ext_vector_type(4)));
typedef float f32x4 __attribute__((ext_vector_type(4)));
typedef float f32x2 __attribute__((ext_vector_type(2)));
typedef unsigned u32x4 __attribute__((ext_vector_type(4)));
typedef unsigned u32x2 __attribute__((ext_vector_type(2)));

constexpr int DM = 2048, BATCH = 16, SEQ = 2048, MTOK = BATCH * SEQ, FF = 8192, QKVW = 9216, GWID = 1024, HD = 128, NSLOT = 8;
constexpr float LN_EPS = 1e-5f;
constexpr float ALPHA = 1.4142135623730951f;
constexpr size_t MiB = 1u << 20;
constexpr size_t WS_WIN = 1 * MiB, WS_WG = 9 * MiB, WS_WOUT = 11 * MiB, WS_WQKV = 19 * MiB, WS_WAO = 55 * MiB, WS_WUP0 = 59 * MiB, WS_WUP1 = 91 * MiB,
                 WS_WDN0 = 123 * MiB, WS_WDN1 = 155 * MiB, WS_LSE = 188 * MiB, WS_XA = 192 * MiB, WS_XB = 320 * MiB, WS_BIG = 448 * MiB, WS_END = 1024 * MiB;

__device__ __forceinline__ unsigned f2bf(float f) { unsigned u = __builtin_bit_cast(unsigned, f); return (u + 0x7fffu + ((u >> 16) & 1u)) >> 16; }
typedef __bf16 bf16x2_t __attribute__((ext_vector_type(2)));
__device__ __forceinline__ unsigned pk2(float lo, float hi) { const f32x2 v = {lo, hi}; const bf16x2_t b = __builtin_convertvector(v, bf16x2_t); return __builtin_bit_cast(unsigned, b); }
__device__ __forceinline__ float bf_lo(unsigned w) { return __builtin_bit_cast(float, w << 16); }
__device__ __forceinline__ float bf_hi(unsigned w) { return __builtin_bit_cast(float, w & 0xffff0000u); }

namespace pg8 {
constexpr int BM = 256, BK = 64, HALF = 128, HTB = HALF * BK * 2, STAGE_BYTES = 8 * HTB, NXCD = 8, WGM = 8;
__host__ __device__ __forceinline__ int lds_byte(int r, int c) { const int st = (r >> 4) * 2 + (c >> 5), rr = r & 15, cc = c & 31, ob = rr * 64 + cc * 2; return st * 1024 + (ob ^ (((ob >> 9) & 1) << 5)); }
__host__ __device__ __forceinline__ void stage_rc(int b, int& R, int& C) { const int st = b / 1024, sb = b % 1024, swz = sb ^ (((sb >> 9) & 1) << 5); R = (st >> 1) * 16 + swz / 64; C = (st & 1) * 32 + (swz % 64) / 2; }
__host__ __device__ __forceinline__ int perm32(int rho) { const int n = rho >> 4, i = rho & 15; return 8 * (i >> 2) + 4 * n + (i & 3); }

struct Unit { int pm, pn; };
struct Gemm { const bf16_t* A; const bf16_t* Bt; int M, N, K, lda, agdiv, agk; };

struct StaticOrder {
    int nM, nN, nwg, G, c;
    __host__ __device__ void init(int M, int N, int G_, int c_) { nM = M / BM; nN = N / BM; nwg = nM * nN; G = G_; c = c_; }
    __host__ __device__ bool next(int i, Unit& u) const {
        const long L = (long)i * G + c; if (L >= nwg) return false;
        int wgid = (int)L; { const int q = nwg / NXCD, r = nwg % NXCD, xcd = wgid % NXCD, off = wgid / NXCD; wgid = (xcd < r ? xcd * (q + 1) : r * (q + 1) + (xcd - r) * q) + off; }
        const int nig = WGM * nN, gid = wgid / nig, fm = gid * WGM, gsz = (nM - fm) < WGM ? (nM - fm) : WGM;
        u.pm = fm + ((wgid % nig) % gsz); u.pn = (wgid % nig) / gsz; return true;
    }
};

__device__ __forceinline__ unsigned cvt_pk_bf16(float lo, float hi) { unsigned r; asm volatile("v_cvt_pk_bf16_f32 %0, %1, %2" : "=v"(r) : "v"(lo), "v"(hi)); return r; }

template <int ACT, bool SCALE> struct EpiBf16 {
    bf16_t* O; int ldc; const float* colscale;
    __device__ __forceinline__ void operator()(const f32x4 (&acc)[2][2][4][2], const Unit& u, int wr, int wc, int fr, int fq) const {
        const int row0 = u.pm * BM + wr * 64 + fr; const int col0 = u.pn * BM + wc * 32 + 8 * fq;
        f32x4 cs[2][2];
#pragma unroll
        for (int bj = 0; bj < 2; ++bj)
#pragma unroll
            for (int n = 0; n < 2; ++n) cs[bj][n] = SCALE ? *(const f32x4*)(colscale + col0 + bj * HALF + 4 * n) : (f32x4){1.f, 1.f, 1.f, 1.f};
#pragma unroll
        for (int ai = 0; ai < 2; ++ai)
#pragma unroll
            for (int m = 0; m < 4; ++m) { bf16_t* rowp = O + (size_t)(row0 + ai * HALF + m * 16) * ldc + col0;
#pragma unroll
                for (int bj = 0; bj < 2; ++bj) { f32x4 v0 = acc[ai][bj][m][0], v1 = acc[ai][bj][m][1];
                    if (SCALE) { v0 = v0 * cs[bj][0]; v1 = v1 * cs[bj][1]; }
                    if (ACT == 1) {
#pragma unroll
                        for (int j = 0; j < 4; ++j) { const float a = fmaxf(v0[j], 0.f), b = fmaxf(v1[j], 0.f); v0[j] = a * a; v1[j] = b * b; } }
                    u32x4 w; w.x = cvt_pk_bf16(v0[0], v0[1]); w.y = cvt_pk_bf16(v0[2], v0[3]); w.z = cvt_pk_bf16(v1[0], v1[1]); w.w = cvt_pk_bf16(v1[2], v1[3]);
                    *(u32x4*)(rowp + bj * HALF) = w; } }
    }
};
struct EpiRes {
    const bf16_t* X; bf16_t* R; int ldc; float alpha;
    __device__ __forceinline__ void operator()(const f32x4 (&acc)[2][2][4][2], const Unit& u, int wr, int wc, int fr, int fq) const {
        const int row0 = u.pm * BM + wr * 64 + fr; const int col0 = u.pn * BM + wc * 32 + 8 * fq;
#pragma unroll
        for (int ai = 0; ai < 2; ++ai)
#pragma unroll
            for (int m = 0; m < 4; ++m) { const size_t off = (size_t)(row0 + ai * HALF + m * 16) * ldc + col0;
#pragma unroll
                for (int bj = 0; bj < 2; ++bj) { const u32x4 xw = *(const u32x4*)(X + off + bj * HALF);
                    const f32x4 x0 = {bf_lo(xw.x), bf_hi(xw.x), bf_lo(xw.y), bf_hi(xw.y)}, x1 = {bf_lo(xw.z), bf_hi(xw.z), bf_lo(xw.w), bf_hi(xw.w)};
                    const f32x4 v0 = x0 * alpha + acc[ai][bj][m][0], v1 = x1 * alpha + acc[ai][bj][m][1];
                    u32x4 w; w.x = cvt_pk_bf16(v0[0], v0[1]); w.y = cvt_pk_bf16(v0[2], v0[3]); w.z = cvt_pk_bf16(v1[0], v1[1]); w.w = cvt_pk_bf16(v1[2], v1[3]);
                    *(u32x4*)(R + off + bj * HALF) = w; } }
    }
};

template <class Epi, class Sched>
__device__ __forceinline__ void gemm_phase(LAS unsigned char* lds, const Gemm g, const Sched& S, const Epi& E) {
    int tid_o = threadIdx.x; asm volatile("" : "+v"(tid_o));
    const int tid = tid_o, wid = __builtin_amdgcn_readfirstlane(tid >> 6), lane = tid & 63, wr = wid >> 2, wc = wid & 3, fr = lane & 15, fq = lane >> 4;
    const int K = g.K, nt = K / BK, lda = g.lda;
    unsigned voffA[2], voffB[2];
#pragma unroll
    for (int i = 0; i < 2; ++i) { int R, C; stage_rc(tid * 16 + i * 8192, R, C); const int Rb = (R & ~31) + perm32(R & 31);
        voffA[i] = (unsigned)(R * lda + C) * 2u; voffB[i] = (unsigned)(Rb * K + C) * 2u; }
    const size_t kstep = (size_t)(BK * 2);
    const size_t hstepA = (size_t)HALF * lda * 2, hstepB = (size_t)HALF * K * 2;
    const size_t tstepA = 2 * hstepA, tstepB = 2 * hstepB;
    const unsigned ldsw = (unsigned)wid * 1024u;
    const int aoff = lds_byte(wr * 64 + fr, fq * 8), boff = lds_byte(wc * 32 + fr, fq * 8);
#define PG8_SA(b, h) (((b) * 2 + (h)) * HTB)
#define PG8_SB(b, h) ((4 + (b) * 2 + (h)) * HTB)
#define PG8_STAGE(bufoff, gbase, voff) do { _Pragma("unroll") for (int _i = 0; _i < 2; ++_i) \
        __builtin_amdgcn_global_load_lds((const unsigned*)((const char*)(gbase) + (voff)[_i]), (LAS unsigned*)(lds + (bufoff) + ldsw + _i * 8192), 16, 0, 0); } while (0)
#define PG8_LDA(dst, b, h) do { _Pragma("unroll") for (int m = 0; m < 4; ++m) _Pragma("unroll") for (int k = 0; k < 2; ++k) dst[m][k] = *(const LAS bf16x8*)(lds + PG8_SA(b, h) + aoff + m * 2048 + k * 1024); } while (0)
#define PG8_LDB(dst, b, h) do { _Pragma("unroll") for (int n = 0; n < 2; ++n) _Pragma("unroll") for (int k = 0; k < 2; ++k) dst[n][k] = *(const LAS bf16x8*)(lds + PG8_SB(b, h) + boff + n * 2048 + k * 1024); } while (0)
#define PG8_MMA(ai, bj, At, Bt) do { __builtin_amdgcn_s_setprio(1); _Pragma("unroll") for (int m = 0; m < 4; ++m) _Pragma("unroll") for (int n = 0; n < 2; ++n) _Pragma("unroll") for (int k = 0; k < 2; ++k) \
        acc[ai][bj][m][n] = __builtin_amdgcn_mfma_f32_16x16x32_bf16(Bt[n][k], At[m][k], acc[ai][bj][m][n], 0, 0, 0); __builtin_amdgcn_s_setprio(0); } while (0)
#define PG8_WAIT_V(n) asm volatile("s_waitcnt vmcnt(" #n ")" ::: "memory")
#define PG8_WAIT_L(n) asm volatile("s_waitcnt lgkmcnt(" #n ")" ::: "memory")
#define PG8_BAR __builtin_amdgcn_s_barrier()
#define PG8_SCHED __builtin_amdgcn_sched_barrier(0)
#define PG8_AOFF(u) ((size_t)(((u).pn / g.agdiv) * g.agk) * 2)
    Unit cur, nxt; int ui = 0;
    if (!S.next(0, cur)) return;
    f32x4 acc[2][2][4][2];
#pragma unroll
    for (int a = 0; a < 2; ++a)
#pragma unroll
        for (int b = 0; b < 2; ++b)
#pragma unroll
            for (int m = 0; m < 4; ++m)
#pragma unroll
                for (int n = 0; n < 2; ++n) acc[a][b][m][n] = (f32x4){0.f, 0.f, 0.f, 0.f};
    bf16x8 At[4][2], B0[2][2], B1[2][2];
    const char* cA = (const char*)g.A + (size_t)cur.pm * tstepA + PG8_AOFF(cur); const char* cB = (const char*)g.Bt + (size_t)cur.pn * tstepB;
    PG8_STAGE(PG8_SB(0, 0), cB, voffB); PG8_STAGE(PG8_SB(0, 1), cB + hstepB, voffB); PG8_STAGE(PG8_SA(0, 0), cA, voffA); PG8_STAGE(PG8_SA(0, 1), cA + hstepA, voffA);
    if (wr == 1) PG8_BAR;
    PG8_WAIT_V(2); PG8_BAR;
    PG8_STAGE(PG8_SB(1, 0), cB + kstep, voffB); PG8_STAGE(PG8_SA(1, 0), cA + kstep, voffA); PG8_STAGE(PG8_SB(1, 1), cB + hstepB + kstep, voffB);
    PG8_WAIT_V(6); PG8_BAR;
    for (;;) {
        const bool has_next = S.next(ui + 1, nxt);
        const char* nA = has_next ? (const char*)g.A + (size_t)nxt.pm * tstepA + PG8_AOFF(nxt) : cA; const char* nB = has_next ? (const char*)g.Bt + (size_t)nxt.pn * tstepB : cB;
        for (int t = 0; t < nt; t += 2) {
            const bool last = (t == nt - 2);
            const char* a1 = cA + (size_t)(t + 1) * kstep;
            const char* a2 = last ? nA : cA + (size_t)(t + 2) * kstep; const char* b2 = last ? nB : cB + (size_t)(t + 2) * kstep;
            const char* a3 = a2 + kstep; const char* b3 = b2 + kstep;
            PG8_LDB(B0, 0, 0); PG8_LDB(B1, 0, 1); PG8_SCHED; PG8_LDA(At, 0, 0); PG8_STAGE(PG8_SA(1, 1), a1 + hstepA, voffA);
            PG8_WAIT_V(8); PG8_WAIT_L(0); PG8_BAR; PG8_MMA(0, 0, At, B0); PG8_MMA(0, 1, At, B1); PG8_BAR; PG8_SCHED;
            PG8_LDA(At, 0, 1); PG8_STAGE(PG8_SB(0, 0), b2, voffB); PG8_STAGE(PG8_SB(0, 1), b2 + hstepB, voffB); PG8_STAGE(PG8_SA(0, 0), a2, voffA);
            PG8_WAIT_V(8); PG8_WAIT_L(0); PG8_BAR; PG8_MMA(1, 0, At, B0); PG8_MMA(1, 1, At, B1); PG8_BAR; PG8_SCHED;
            PG8_LDB(B0, 1, 0); PG8_LDB(B1, 1, 1); PG8_SCHED; PG8_LDA(At, 1, 0); PG8_STAGE(PG8_SA(0, 1), a2 + hstepA, voffA);
            PG8_WAIT_V(8); PG8_WAIT_L(0); PG8_BAR; PG8_MMA(0, 0, At, B0); PG8_MMA(0, 1, At, B1); PG8_BAR; PG8_SCHED;
            PG8_LDA(At, 1, 1); PG8_STAGE(PG8_SB(1, 0), b3, voffB); PG8_STAGE(PG8_SB(1, 1), b3 + hstepB, voffB); PG8_STAGE(PG8_SA(1, 0), a3, voffA);
            PG8_WAIT_V(8); PG8_WAIT_L(0); PG8_BAR; PG8_MMA(1, 0, At, B0); PG8_MMA(1, 1, At, B1); PG8_BAR; PG8_SCHED;
        }
        if (wr == 0) PG8_BAR;
        E(acc, cur, wr, wc, fr, fq);
        if (!has_next) break;
#pragma unroll
        for (int a = 0; a < 2; ++a)
#pragma unroll
            for (int b = 0; b < 2; ++b)
#pragma unroll
                for (int m = 0; m < 4; ++m)
#pragma unroll
                    for (int n = 0; n < 2; ++n) acc[a][b][m][n] = (f32x4){0.f, 0.f, 0.f, 0.f};
        cur = nxt; cA = nA; cB = nB; ++ui;
        if (wr == 1) PG8_BAR;
    }
    PG8_WAIT_V(0);
    PG8_BAR;
#undef PG8_SA
#undef PG8_SB
#undef PG8_STAGE
#undef PG8_LDA
#undef PG8_LDB
#undef PG8_MMA
#undef PG8_WAIT_V
#undef PG8_WAIT_L
#undef PG8_BAR
#undef PG8_SCHED
#undef PG8_AOFF
}
}

constexpr int NWAVES = 8, NTHR = 512;
constexpr int ATT_KSTR = 272, ATT_VSTR = 288, ATT_K_OFF = 0, ATT_V_OFF = 256 * ATT_KSTR, ATT_BYTES = ATT_V_OFF + 272 * ATT_VSTR;
constexpr int MISC_OFF = ATT_BYTES;
constexpr int LDS_BYTES = 148480;
static_assert(ATT_BYTES <= LDS_BYTES && pg8::STAGE_BYTES <= LDS_BYTES, "LDS map");

struct Params {
    const float* x; const float* w_in; const float* w_group; const float* pool_scale; const float* w_out; const float* w_qkv; const float* w_ao;
    const float* w_up; const float* w_dn; const float* ln_mix_g; const float* ln_mix_b; const float* ln_mlp_g; const float* ln_mlp_b;
    float* out; unsigned char* ws;
};

__device__ __forceinline__ float wave_sum(float v) {
#pragma unroll
    for (int o = 1; o < 64; o <<= 1) v += __shfl_xor(v, o);
    return v;
}

__device__ __forceinline__ void p0_transpose_item(const float* W, int K, int N, bf16_t* WT, int row_off, LAS float* scr, int item, int lane) {
    const int nblk = N / 32, kb = item / nblk, nb = item % nblk, k0 = 64 * kb, n0 = 32 * nb;
#pragma unroll 8
    for (int i = 0; i < 32; ++i) { const int kk = 2 * i + (lane >> 5); scr[kk * 33 + (lane & 31)] = W[(size_t)(k0 + kk) * N + n0 + (lane & 31)]; }
    asm volatile("s_waitcnt lgkmcnt(0)" ::: "memory");
    const int c = lane & 7;
#pragma unroll
    for (int j = 0; j < 4; ++j) { const int n = (lane >> 3) + 8 * j; const LAS float* s = scr + (8 * c) * 33 + n;
        u32x4 o; o.x = pk2(s[0 * 33], s[1 * 33]); o.y = pk2(s[2 * 33], s[3 * 33]); o.z = pk2(s[4 * 33], s[5 * 33]); o.w = pk2(s[6 * 33], s[7 * 33]);
        *(u32x4*)(WT + (size_t)(row_off + n0 + n) * K + k0 + 8 * c) = o; }
    asm volatile("s_waitcnt lgkmcnt(0)" ::: "memory");
}

__device__ __forceinline__ void phase_prologue(const Params& p, LAS unsigned char* lds) {
    const int tid = threadIdx.x, lane = tid & 63, wave = __builtin_amdgcn_readfirstlane(tid >> 6);
    LAS float* scr = (LAS float*)(lds + wave * 16384);
    const int gw = blockIdx.x * NWAVES + wave, NGW = gridDim.x * NWAVES;
    unsigned char* ws = p.ws;
    constexpr int I_IN = (DM / 64) * (DM / 32), I_G = (512 / 64) * (512 / 32), I_OUT = I_IN, I_QKV = (DM / 64) * (QKVW / 32), I_AO = (GWID / 64) * (DM / 32),
                  I_UP = (DM / 64) * (FF / 32), I_DN = (FF / 64) * (DM / 32);
    constexpr int NITEMS = I_IN + 4 * I_G + I_OUT + I_QKV + I_AO + 2 * I_UP + 2 * I_DN;
    for (int it = gw; it < NITEMS; it += NGW) {
        int r = it;
        if (r < I_IN) { p0_transpose_item(p.w_in, DM, DM, (bf16_t*)(ws + WS_WIN), 0, scr, r, lane); continue; } r -= I_IN;
        if (r < 4 * I_G) { const int g = r / I_G; p0_transpose_item(p.w_group + (size_t)g * 512 * 512, 512, 512, (bf16_t*)(ws + WS_WG), g * 512, scr, r % I_G, lane); continue; } r -= 4 * I_G;
        if (r < I_OUT) { p0_transpose_item(p.w_out, DM, DM, (bf16_t*)(ws + WS_WOUT), 0, scr, r, lane); continue; } r -= I_OUT;
        if (r < I_QKV) { p0_transpose_item(p.w_qkv, DM, QKVW, (bf16_t*)(ws + WS_WQKV), 0, scr, r, lane); continue; } r -= I_QKV;
        if (r < I_AO) { p0_transpose_item(p.w_ao, GWID, DM, (bf16_t*)(ws + WS_WAO), 0, scr, r, lane); continue; } r -= I_AO;
        if (r < 2 * I_UP) { const int l = r / I_UP; p0_transpose_item(p.w_up + (size_t)l * DM * FF, DM, FF, (bf16_t*)(ws + (l ? WS_WUP1 : WS_WUP0)), 0, scr, r % I_UP, lane); continue; } r -= 2 * I_UP;
        { const int l = r / I_DN; p0_transpose_item(p.w_dn + (size_t)l * FF * DM, FF, DM, (bf16_t*)(ws + (l ? WS_WDN1 : WS_WDN0)), 0, scr, r % I_DN, lane); }
    }
    const size_t n8 = (size_t)MTOK * DM / 8; bf16_t* xa = (bf16_t*)(ws + WS_XA);
    for (size_t i = (size_t)blockIdx.x * NTHR + tid; i < n8; i += (size_t)gridDim.x * NTHR) {
        const f32x4 a = *(const f32x4*)(p.x + i * 8), b = *(const f32x4*)(p.x + i * 8 + 4);
        u32x4 o; o.x = pk2(a.x, a.y); o.y = pk2(a.z, a.w); o.z = pk2(b.x, b.y); o.w = pk2(b.z, b.w);
        *(u32x4*)(xa + i * 8) = o;
    }
}

__device__ __forceinline__ void phase_pool(const bf16_t* U, bf16_t* P) {
    constexpr int TB = 32, NITEMS = (MTOK / TB) * (DM / 8);
    for (int id = blockIdx.x * NTHR + threadIdx.x; id < NITEMS; id += gridDim.x * NTHR) {
        const int c8 = id & 255, tb = id >> 8, t0 = tb * TB, pos0 = t0 & (SEQ - 1), g = c8 >> 6, w = 2 << g;
        const bf16_t* up = U + (size_t)t0 * DM + c8 * 8; bf16_t* pp = P + (size_t)t0 * DM + c8 * 8;
        float s[8];
#pragma unroll
        for (int j = 0; j < 8; ++j) s[j] = 0.f;
        for (int k = 1; k <= w; ++k) { if (pos0 - k >= 0) { const u32x4 v = *(const u32x4*)(up - (ptrdiff_t)k * DM);
            s[0] += bf_lo(v.x); s[1] += bf_hi(v.x); s[2] += bf_lo(v.y); s[3] += bf_hi(v.y); s[4] += bf_lo(v.z); s[5] += bf_hi(v.z); s[6] += bf_lo(v.w); s[7] += bf_hi(v.w); } }
        for (int t = 0; t < TB; ++t) {
            const int pos = pos0 + t;
            const u32x4 v = *(const u32x4*)(up + (size_t)t * DM);
            float c[8] = {bf_lo(v.x), bf_hi(v.x), bf_lo(v.y), bf_hi(v.y), bf_lo(v.z), bf_hi(v.z), bf_lo(v.w), bf_hi(v.w)};
#pragma unroll
            for (int j = 0; j < 8; ++j) s[j] += c[j];
            if (pos >= w) { const u32x4 o = *(const u32x4*)(up + (ptrdiff_t)(t - w) * DM);
                s[0] -= bf_lo(o.x); s[1] -= bf_hi(o.x); s[2] -= bf_lo(o.y); s[3] -= bf_hi(o.y); s[4] -= bf_lo(o.z); s[5] -= bf_hi(o.z); s[6] -= bf_lo(o.w); s[7] -= bf_hi(o.w); }
            const float inv = 1.f / (float)(pos + 1 < w ? pos + 1 : w);
            u32x4 r; r.x = pk2(s[0] * inv - c[0], s[1] * inv - c[1]); r.y = pk2(s[2] * inv - c[2], s[3] * inv - c[3]);
            r.z = pk2(s[4] * inv - c[4], s[5] * inv - c[5]); r.w = pk2(s[6] * inv - c[6], s[7] * inv - c[7]);
            *(u32x4*)(pp + (size_t)t * DM) = r;
        }
    }
}

template <bool F32OUT>
__device__ __forceinline__ void phase_ln(const bf16_t* R, const float* gam, const float* bet, bf16_t* XO, float* FO) {
    const int tid = threadIdx.x, lane = tid & 63, wave = tid >> 6;
    const int gw = blockIdx.x * NWAVES + wave, NGW = gridDim.x * NWAVES;
    for (int m0 = gw; m0 < MTOK; m0 += 2 * NGW) {
        const int m1 = m0 + NGW; const bool two = m1 < MTOK; const int m1c = two ? m1 : m0;
        u32x4 wa[4], wb[4];
#pragma unroll
        for (int j = 0; j < 4; ++j) { wa[j] = *((const u32x4*)(R + (size_t)m0 * DM) + lane + 64 * j); wb[j] = *((const u32x4*)(R + (size_t)m1c * DM) + lane + 64 * j); }
#pragma unroll
        for (int rr = 0; rr < 2; ++rr) {
            if (rr == 1 && !two) break;
            const int m = rr ? m1 : m0;
            float v[4][8]; float s = 0.f;
#pragma unroll
            for (int j = 0; j < 4; ++j) { const u32x4 w = rr ? wb[j] : wa[j];
                v[j][0] = bf_lo(w.x); v[j][1] = bf_hi(w.x); v[j][2] = bf_lo(w.y); v[j][3] = bf_hi(w.y); v[j][4] = bf_lo(w.z); v[j][5] = bf_hi(w.z); v[j][6] = bf_lo(w.w); v[j][7] = bf_hi(w.w);
#pragma unroll
                for (int e = 0; e < 8; ++e) s += v[j][e]; }
            const float mean = wave_sum(s) * (1.f / DM); float s2 = 0.f;
#pragma unroll
            for (int j = 0; j < 4; ++j)
#pragma unroll
                for (int e = 0; e < 8; ++e) { v[j][e] -= mean; s2 += v[j][e] * v[j][e]; }
            const float rstd = 1.f / sqrtf(wave_sum(s2) * (1.f / DM) + LN_EPS);
#pragma unroll
            for (int j = 0; j < 4; ++j) {
                const int c0 = (lane + 64 * j) * 8;
                const f32x4 g0 = *(const f32x4*)(gam + c0), g1 = *(const f32x4*)(gam + c0 + 4), b0 = *(const f32x4*)(bet + c0), b1 = *(const f32x4*)(bet + c0 + 4);
                const f32x4 y0 = (f32x4){v[j][0], v[j][1], v[j][2], v[j][3]} * rstd * g0 + b0, y1 = (f32x4){v[j][4], v[j][5], v[j][6], v[j][7]} * rstd * g1 + b1;
                if (F32OUT) { *(f32x4*)(FO + (size_t)m * DM + c0) = y0; *(f32x4*)(FO + (size_t)m * DM + c0 + 4) = y1; }
                else { u32x4 o; o.x = pk2(y0.x, y0.y); o.y = pk2(y0.z, y0.w); o.z = pk2(y1.x, y1.y); o.w = pk2(y1.z, y1.w); *((u32x4*)(XO + (size_t)m * DM) + lane + 64 * j) = o; }
            }
        }
    }
}

__device__ __forceinline__ s16x4 vtr(const LAS unsigned char* p) { return __builtin_bit_cast(s16x4, __builtin_amdgcn_ds_read_tr16_b64_v4i16((LAS s16x4*)p)); }

struct AttnId { int g, b, r, qb, j, ldprev; };
__device__ __forceinline__ AttnId attn_decode(int pass, int c, int i) {
    AttnId a; a.ldprev = 0;
    if (pass == 0) {
        if (i < 8) { a.g = 0; a.j = c & 7; a.b = (c >> 3) & 15; const int half = c >> 7; a.r = 0; a.qb = half * 8 + i; a.ldprev = (half == 1 && i == 0) ? 1 : 0; }
        else { const int ch = 2 * c + ((i - 8) >> 2); a.g = 1; a.j = ch & 7; a.r = (ch >> 3) & 3; a.b = ch >> 5; a.qb = (i - 8) & 3; }
    } else { const int id = 8 * c + i; a.g = 2; a.j = id & 7; a.r = (id >> 3) & 15; a.b = id >> 7; a.qb = 0; }
    return a;
}
__device__ __forceinline__ void attn_fetch(const bf16_t* qkv, const AttnId& a, int blk, u32x4 (&kv)[4], u32x4 (&vv)[4], int tid) {
    const int dsh = (a.g == 0) ? 0 : (a.g == 1 ? 2 : 4);
    const size_t rowbase = (size_t)a.b * SEQ; const int colq = a.g * GWID + a.j * HD;
    const int chunk = tid & 15, rb = tid >> 4;
    const bf16_t* kbase = qkv + 3072 + colq + chunk * 8;
#pragma unroll
    for (int it = 0; it < 4; ++it) { const int sub = blk * 128 + it * 32 + rb;
        const bf16_t* pk = kbase + (rowbase + (size_t)(sub << dsh) + a.r) * QKVW; kv[it] = *(const u32x4*)pk; vv[it] = *(const u32x4*)(pk + 3072); }
}
__device__ __forceinline__ void attn_fetch_q(const bf16_t* qkv, const AttnId& a, bf16x8 (&qf)[4], int w, int fr, int fq) {
    const int dsh = (a.g == 0) ? 0 : (a.g == 1 ? 2 : 4);
    const size_t qrow = (size_t)a.b * SEQ + (size_t)((a.qb * 128 + 16 * w + fr) << dsh) + a.r; const int colq = a.g * GWID + a.j * HD;
#pragma unroll
    for (int kk = 0; kk < 4; ++kk) qf[kk] = *(const bf16x8*)(qkv + qrow * QKVW + colq + 32 * kk + 8 * fq);
}
__device__ __forceinline__ void attn_put(LAS unsigned char* lds, int half, const u32x4 (&kv)[4], const u32x4 (&vv)[4], int tid) {
    const int chunk = tid & 15, rb = tid >> 4;
#pragma unroll
    for (int it = 0; it < 4; ++it) { const int row = half * 128 + it * 32 + rb;
        *(LAS u32x4*)(lds + ATT_K_OFF + row * ATT_KSTR + chunk * 16) = kv[it]; *(LAS u32x4*)(lds + ATT_V_OFF + row * ATT_VSTR + chunk * 16) = vv[it]; }
}
__device__ __forceinline__ int attn_trow(int T, int ch) { return T >= 16 ? 256 : ((((T >> 3) ^ 1) ^ ch) << 7) + ((T & 7) << 4); }

__device__ __forceinline__ void attn_scores(LAS unsigned char* lds, int ch, const bf16x8 (&qf)[4], f32x4 (&s)[9], int w, int fr, int fq) {
    LAS unsigned char* Kl = lds + ATT_K_OFF;
#pragma unroll
    for (int tt = 0; tt < 9; ++tt) { s[tt] = (f32x4){0.f, 0.f, 0.f, 0.f}; const int rowb = attn_trow(w + tt, ch);
#pragma unroll
        for (int kk = 0; kk < 4; ++kk) { const bf16x8 av = *(const LAS bf16x8*)(Kl + (rowb + fr) * ATT_KSTR + (32 * kk + 8 * fq) * 2);
            s[tt] = __builtin_amdgcn_mfma_f32_16x16x32_bf16(av, qf[kk], s[tt], 0, 0, 0); } }
}
__device__ __forceinline__ void attn_finish(LAS unsigned char* lds, int ch, const AttnId& a, f32x4 (&s)[9], bf16_t* obuf, float* lsebuf, bf16_t* merged, int w, int fr, int fq) {
    const int g = a.g, j = a.j, qb = a.qb;
    const int dsh = (g == 0) ? 0 : (g == 1 ? 2 : 4), d = 1 << dsh;
    const size_t qrow = (size_t)a.b * SEQ + (size_t)((qb * 128 + 16 * w + fr) << dsh) + a.r;
    LAS unsigned char* Vl = lds + ATT_V_OFF;
    constexpr float LOG2E = 1.4426950408889634f;
    const float sc = 0.08838834764831845f * LOG2E;
    const float slope = exp2f(-8.0f * (float)(g * NSLOT + j + 1) / 24.0f);
    const float sl = slope * (float)d * LOG2E;
    float mx = -INFINITY;
    const float fb = (float)(128 + fr - 4 * fq);
#pragma unroll
    for (int tt = 0; tt < 9; ++tt) {
        const bool tile_ok = (qb > 0) || (w + tt >= 8);
#pragma unroll
        for (int jj = 0; jj < 4; ++jj) {
            const float dist = fb - (float)(16 * tt + jj);
            bool valid = tile_ok;
            if (tt == 0) valid = valid && (dist <= 128.f);
            if (tt == 8) valid = valid && (dist >= 0.f);
            const float v = valid ? (s[tt][jj] * sc - sl * dist) : -INFINITY;
            s[tt][jj] = v; mx = fmaxf(mx, v);
        }
    }
    mx = fmaxf(mx, __shfl_xor(mx, 16)); mx = fmaxf(mx, __shfl_xor(mx, 32));
    float sum = 0.f;
#pragma unroll
    for (int tt = 0; tt < 9; ++tt)
#pragma unroll
        for (int jj = 0; jj < 4; ++jj) { const float e = __builtin_amdgcn_exp2f(s[tt][jj] - mx); s[tt][jj] = e; sum += e; }
    sum += __shfl_xor(sum, 16); sum += __shfl_xor(sum, 32);
    bf16x8 pf[5];
#pragma unroll
    for (int c = 0; c < 5; ++c) {
        u32x4 pw; pw.x = pk2(s[2 * c][0], s[2 * c][1]); pw.y = pk2(s[2 * c][2], s[2 * c][3]);
        if (c < 4) { pw.z = pk2(s[2 * c + 1][0], s[2 * c + 1][1]); pw.w = pk2(s[2 * c + 1][2], s[2 * c + 1][3]); } else { pw.z = 0u; pw.w = 0u; }
        pf[c] = __builtin_bit_cast(bf16x8, pw);
    }
    f32x4 o[8];
#pragma unroll
    for (int dt = 0; dt < 8; ++dt) o[dt] = (f32x4){0.f, 0.f, 0.f, 0.f};
    const int lofs = (4 * fq + (fr >> 2)) * ATT_VSTR + (4 * (fr & 3)) * 2;
#pragma unroll
    for (int c = 0; c < 5; ++c) {
        __builtin_amdgcn_sched_barrier(0);
        const LAS unsigned char* v0 = Vl + attn_trow(w + 2 * c, ch) * ATT_VSTR + lofs; const LAS unsigned char* v1 = Vl + attn_trow(w + 2 * c + 1, ch) * ATT_VSTR + lofs;
#pragma unroll
        for (int dt = 0; dt < 8; ++dt) {
            const s16x4 lo = vtr(v0 + dt * 32), hi = vtr(v1 + dt * 32);
            const bf16x8 av = {lo[0], lo[1], lo[2], lo[3], hi[0], hi[1], hi[2], hi[3]};
            o[dt] = __builtin_amdgcn_mfma_f32_16x16x32_bf16(av, pf[c], o[dt], 0, 0, 0);
        }
    }
    const float inv = 1.f / sum;
    const float lse = (mx + log2f(sum)) * 0.6931471805599453f;
    if (g < 2) {
        bf16_t* orow = obuf + ((size_t)g * MTOK + qrow) * GWID + j * HD + 4 * fq;
#pragma unroll
        for (int dt = 0; dt < 8; ++dt) { u32x2 ow; ow.x = pk2(o[dt][0] * inv, o[dt][1] * inv); ow.y = pk2(o[dt][2] * inv, o[dt][3] * inv); *(u32x2*)(orow + 16 * dt) = ow; }
        if (fq == 0) lsebuf[((size_t)g * MTOK + qrow) * NSLOT + j] = lse;
    } else {
        const float l0 = lsebuf[qrow * NSLOT + j], l1 = lsebuf[((size_t)MTOK + qrow) * NSLOT + j];
        const float lm = fmaxf(lse, fmaxf(l0, l1));
        float e0 = __expf(l0 - lm), e1 = __expf(l1 - lm), e2 = __expf(lse - lm); const float wi = 1.f / (e0 + e1 + e2); e0 *= wi; e1 *= wi; e2 *= wi * inv;
        const bf16_t* o0p = obuf + qrow * GWID + j * HD + 4 * fq; const bf16_t* o1p = o0p + (size_t)MTOK * GWID;
        bf16_t* mrow = merged + qrow * GWID + j * HD + 4 * fq;
#pragma unroll
        for (int dt = 0; dt < 8; ++dt) { const u32x2 a0 = *(const u32x2*)(o0p + 16 * dt), a1 = *(const u32x2*)(o1p + 16 * dt);
            u32x2 ow; ow.x = pk2(e0 * bf_lo(a0.x) + e1 * bf_lo(a1.x) + e2 * o[dt][0], e0 * bf_hi(a0.x) + e1 * bf_hi(a1.x) + e2 * o[dt][1]);
            ow.y = pk2(e0 * bf_lo(a0.y) + e1 * bf_lo(a1.y) + e2 * o[dt][2], e0 * bf_hi(a0.y) + e1 * bf_hi(a1.y) + e2 * o[dt][3]);
            *(u32x2*)(mrow + 16 * dt) = ow; }
    }
}

#define ATT_LBAR() do { asm volatile("s_waitcnt lgkmcnt(0)" ::: "memory"); __builtin_amdgcn_s_barrier(); asm volatile("" ::: "memory"); } while (0)
__device__ __forceinline__ void phase_attn(LAS unsigned char* lds, const bf16_t* qkv, bf16_t* obuf, float* lsebuf, bf16_t* merged, int pass) {
    int tid_o = threadIdx.x; asm volatile("" : "+v"(tid_o));
    const int tid = tid_o, lane = tid & 63, w = __builtin_amdgcn_readfirstlane(tid >> 6), fr = lane & 15, fq = lane >> 4;
    const int c = blockIdx.x, n = pass == 0 ? 16 : 8;
    for (int i = tid; i < ATT_BYTES / 16; i += NTHR) ((LAS u32x4*)lds)[i] = (u32x4){0u, 0u, 0u, 0u};
    ATT_LBAR();
    u32x4 kv[4], vv[4]; bf16x8 qn[4];
    AttnId cur = attn_decode(pass, c, 0);
    attn_fetch(qkv, cur, cur.qb, kv, vv, tid); attn_fetch_q(qkv, cur, qn, w, fr, fq);
    for (int i = 0; i < n; ++i) {
        const int ch = cur.qb & 1;
        attn_put(lds, ch, kv, vv, tid);
        if (cur.ldprev) { attn_fetch(qkv, cur, cur.qb - 1, kv, vv, tid); attn_put(lds, ch ^ 1, kv, vv, tid); }
        ATT_LBAR();
        f32x4 sacc[9];
        attn_scores(lds, ch, qn, sacc, w, fr, fq);
        __builtin_amdgcn_sched_barrier(0);
        AttnId nxt = cur;
        if (i + 1 < n) { nxt = attn_decode(pass, c, i + 1); attn_fetch(qkv, nxt, nxt.qb, kv, vv, tid); attn_fetch_q(qkv, nxt, qn, w, fr, fq); }
        attn_finish(lds, ch, cur, sacc, obuf, lsebuf, merged, w, fr, fq);
        ATT_LBAR();
        cur = nxt;
    }
}

#define XB_TMO      128
#define XB_XCNT(j)  (256  + 64 * (j))
#define XB_XSUB(j)  (1280 + 64 * (j))
#define XB_XGEN(j)  (2304 + 64 * (j))
#define XB_TOP      3328
#define XB_TOPGEN   3392
#define XCD_BAR_WORDS 3456
#define XB_SPIN_CAP (1u << 22)
__device__ __forceinline__ unsigned xb_ld(unsigned* p)              { return __hip_atomic_load(p, __ATOMIC_RELAXED, __HIP_MEMORY_SCOPE_AGENT); }
__device__ __forceinline__ unsigned xb_add(unsigned* p, unsigned v) { return __hip_atomic_fetch_add(p, v, __ATOMIC_RELAXED, __HIP_MEMORY_SCOPE_AGENT); }
__device__ __forceinline__ unsigned xb_xcc_id() { return (unsigned)__builtin_amdgcn_s_getreg((3 << 11) | 20) & 0xFu; }
#define XB_SPIN(cond, bar) do { unsigned _sp = 0; while (cond) { __builtin_amdgcn_s_sleep(1); \
    if ((++_sp & 255u) == 0u) { if (xb_ld(&(bar)[XB_TMO])) break; if (_sp > XB_SPIN_CAP) { atomicAdd(&(bar)[XB_TMO], 1u); break; } } } } while (0)
struct XcdBarrier { unsigned* bar; unsigned x; volatile LAS unsigned* st; };
__device__ __forceinline__ XcdBarrier xcd_barrier_post(unsigned* bar, volatile LAS unsigned* st) {
    XcdBarrier b; b.bar = bar; b.x = xb_xcc_id(); b.st = st;
    if (threadIdx.x == 0) (void)xb_add(&bar[XB_XCNT(b.x)], 1u);
    return b;
}
__device__ __forceinline__ void xcd_barrier_complete(unsigned* bar, unsigned x, unsigned& nloc, unsigned& nx) {
    const unsigned G = gridDim.x * gridDim.y * gridDim.z;
    unsigned sum, cnt, mine, sp = 0u;
    for (;;) {
        sum = 0u; cnt = 0u; mine = 0u;
#pragma unroll
        for (unsigned j = 0; j < 16; ++j) { const unsigned c = xb_ld(&bar[XB_XCNT(j)]); sum += c; cnt += (c > 0u) ? 1u : 0u; mine = (j == x) ? c : mine; }
        if (sum == G) break;
        __builtin_amdgcn_s_sleep(1);
        if ((++sp & 255u) == 0u) { if (xb_ld(&bar[XB_TMO])) break; if (sp > XB_SPIN_CAP) { atomicAdd(&bar[XB_TMO], 1u); break; } }
    }
    nloc = mine > 0u ? mine : 1u; nx = cnt > 0u ? cnt : 1u;
}
__device__ __forceinline__ void xcd_barrier(const XcdBarrier& b) {
    asm volatile("s_waitcnt vmcnt(0)" ::: "memory");
    __syncthreads();
    if (threadIdx.x == 0) {
        unsigned* bar = b.bar;
        __builtin_amdgcn_s_waitcnt(0);
        unsigned nloc = b.st[0], nx = b.st[1];
        if (nloc == 0u) { xcd_barrier_complete(bar, b.x, nloc, nx); b.st[0] = nloc; b.st[1] = nx; }
        const unsigned old = xb_add(&bar[XB_XSUB(b.x)], 1u);
        const unsigned gen = old / nloc;
        if (old + 1u == (gen + 1u) * nloc) {
            __builtin_amdgcn_fence(__ATOMIC_RELEASE, "agent");
            asm volatile("s_waitcnt vmcnt(0)" ::: "memory");
            const unsigned og = xb_add(&bar[XB_TOP], 1u);
            const unsigned tg = og / nx;
            if (og + 1u == (tg + 1u) * nx) xb_add(&bar[XB_TOPGEN], 1u);
            else XB_SPIN(xb_ld(&bar[XB_TOPGEN]) == tg, bar);
            __builtin_amdgcn_fence(__ATOMIC_ACQUIRE, "agent");
            xb_add(&bar[XB_XGEN(b.x)], 1u);
            asm volatile("s_waitcnt vmcnt(0)" ::: "memory");
        } else {
            XB_SPIN(xb_ld(&bar[XB_XGEN(b.x)]) == gen, bar);
            __builtin_amdgcn_fence(__ATOMIC_ACQUIRE, "agent");
            asm volatile("s_waitcnt vmcnt(0)" ::: "memory");
        }
    }
    __syncthreads();
}

__global__ void __launch_bounds__(NTHR, 2) fwd_megakernel(Params p) {
    extern __shared__ __attribute__((aligned(16))) unsigned char lds_raw[];
    LAS unsigned char* lds = (LAS unsigned char*)lds_raw;
    cg::grid_group grid = cg::this_grid();
    unsigned char* ws = p.ws;
    bf16_t* XA = (bf16_t*)(ws + WS_XA); bf16_t* XB = (bf16_t*)(ws + WS_XB);
    bf16_t* BIG = (bf16_t*)(ws + WS_BIG);
    bf16_t* U = BIG; bf16_t* PB = BIG + (size_t)MTOK * DM; bf16_t* Y = BIG + 2 * (size_t)MTOK * DM;
    bf16_t* R = (bf16_t*)p.out;
    volatile LAS unsigned* MISC = (volatile LAS unsigned*)(lds + MISC_OFF);
    unsigned* barw = (unsigned*)ws;
    const int G = gridDim.x, c = blockIdx.x;
    constexpr int NOG = 1 << 30;

    if (blockIdx.x == 0) for (int i = threadIdx.x; i < XCD_BAR_WORDS; i += NTHR) barw[i] = 0u;
    if (threadIdx.x < 2) MISC[threadIdx.x] = 0u;
    phase_prologue(p, lds);
    grid.sync();
    const XcdBarrier xbar = xcd_barrier_post(barw, MISC);
    {
        pg8::Gemm g{XA, (const bf16_t*)(ws + WS_WIN), MTOK, DM, DM, DM, NOG, 0}; pg8::StaticOrder S; S.init(MTOK, DM, G, c);
        pg8::EpiBf16<0, false> E{U, DM, nullptr};
        pg8::gemm_phase(lds, g, S, E);
    }
    xcd_barrier(xbar);
    phase_pool(U, PB);
    xcd_barrier(xbar);
    {
        pg8::Gemm g{PB, (const bf16_t*)(ws + WS_WG), MTOK, DM, 512, DM, 2, 512}; pg8::StaticOrder S; S.init(MTOK, DM, G, c);
        pg8::EpiBf16<0, true> E{Y, DM, p.pool_scale};
        pg8::gemm_phase(lds, g, S, E);
    }
    xcd_barrier(xbar);
    {
        pg8::Gemm g{Y, (const bf16_t*)(ws + WS_WOUT), MTOK, DM, DM, DM, NOG, 0}; pg8::StaticOrder S; S.init(MTOK, DM, G, c);
        pg8::EpiRes E{XA, R, DM, ALPHA};
        pg8::gemm_phase(lds, g, S, E);
    }
    xcd_barrier(xbar);
    phase_ln<false>(R, p.ln_mix_g, p.ln_mix_b, XB, nullptr);
    xcd_barrier(xbar);
    {
        pg8::Gemm g{XB, (const bf16_t*)(ws + WS_WUP0), MTOK, FF, DM, DM, NOG, 0}; pg8::StaticOrder S; S.init(MTOK, FF, G, c);
        pg8::EpiBf16<1, false> E{BIG, FF, nullptr};
        pg8::gemm_phase(lds, g, S, E);
    }
    xcd_barrier(xbar);
    {
        pg8::Gemm g{BIG, (const bf16_t*)(ws + WS_WDN0), MTOK, DM, FF, FF, NOG, 0}; pg8::StaticOrder S; S.init(MTOK, DM, G, c);
        pg8::EpiRes E{XB, R, DM, ALPHA};
        pg8::gemm_phase(lds, g, S, E);
    }
    xcd_barrier(xbar);
    phase_ln<false>(R, p.ln_mlp_g, p.ln_mlp_b, XA, nullptr);
    xcd_barrier(xbar);
    {
        pg8::Gemm g{XA, (const bf16_t*)(ws + WS_WQKV), MTOK, QKVW, DM, DM, NOG, 0}; pg8::StaticOrder S; S.init(MTOK, QKVW, G, c);
        pg8::EpiBf16<0, false> E{BIG, QKVW, nullptr};
        pg8::gemm_phase(lds, g, S, E);
    }
    xcd_barrier(xbar);
    phase_attn(lds, BIG, (bf16_t*)p.out, (float*)(ws + WS_LSE), XB, 0);
    xcd_barrier(xbar);
    phase_attn(lds, BIG, (bf16_t*)p.out, (float*)(ws + WS_LSE), XB, 1);
    xcd_barrier(xbar);
    {
        pg8::Gemm g{XB, (const bf16_t*)(ws + WS_WAO), MTOK, DM, GWID, GWID, NOG, 0}; pg8::StaticOrder S; S.init(MTOK, DM, G, c);
        pg8::EpiRes E{XA, R, DM, ALPHA};
        pg8::gemm_phase(lds, g, S, E);
    }
    xcd_barrier(xbar);
    phase_ln<false>(R, p.ln_mix_g + DM, p.ln_mix_b + DM, XB, nullptr);
    xcd_barrier(xbar);
    {
        pg8::Gemm g{XB, (const bf16_t*)(ws + WS_WUP1), MTOK, FF, DM, DM, NOG, 0}; pg8::StaticOrder S; S.init(MTOK, FF, G, c);
        pg8::EpiBf16<1, false> E{BIG, FF, nullptr};
        pg8::gemm_phase(lds, g, S, E);
    }
    xcd_barrier(xbar);
    {
        pg8::Gemm g{BIG, (const bf16_t*)(ws + WS_WDN1), MTOK, DM, FF, FF, NOG, 0}; pg8::StaticOrder S; S.init(MTOK, DM, G, c);
        pg8::EpiRes E{XB, XA, DM, ALPHA};
        pg8::gemm_phase(lds, g, S, E);
    }
    xcd_barrier(xbar);
    phase_ln<true>(XA, p.ln_mlp_g + DM, p.ln_mlp_b + DM, nullptr, p.out);
}

extern "C" void kernel_launch(void* const* d_in, const int* in_sizes, int n_in, void* d_out, int out_size, void* d_ws, size_t ws_size, hipStream_t stream) {
    static int grid = 0;
    if (grid == 0) {
        if (n_in != 13 || in_sizes[0] != MTOK * DM || out_size != MTOK * DM || ws_size < WS_END) {
            fprintf(stderr, "kernel_launch: unexpected shapes: n_in %d in0 %d out %d ws %zu (need %zu); nothing launched\n", n_in, n_in > 0 ? in_sizes[0] : -1, out_size, ws_size, (size_t)WS_END); grid = -1; return; }
        int dev = 0, cus = 0, per_cu = 0;
        hipGetDevice(&dev);
        hipDeviceGetAttribute(&cus, hipDeviceAttributeMultiprocessorCount, dev);
        if (hipFuncSetAttribute((const void*)fwd_megakernel, hipFuncAttributeMaxDynamicSharedMemorySize, LDS_BYTES) != hipSuccess) { fprintf(stderr, "kernel_launch: hipFuncSetAttribute failed\n"); grid = -1; return; }
        if (hipOccupancyMaxActiveBlocksPerMultiprocessor(&per_cu, (const void*)fwd_megakernel, NTHR, LDS_BYTES) != hipSuccess || per_cu < 1) { fprintf(stderr, "kernel_launch: occupancy query gave %d\n", per_cu); per_cu = 1; }
        (void)hipGetLastError();
        grid = cus * per_cu;
        if (grid != 256) { fprintf(stderr, "kernel_launch: this kernel needs exactly 256 co-resident workgroups, got %d\n", grid); if (grid > 256) grid = 256; }
        fprintf(stderr, "kernel_launch: grid %d (cus %d x %d)\n", grid, cus, per_cu);
    }
    if (grid < 0) return;
    Params p{};
    p.x = (const float*)d_in[0]; p.w_in = (const float*)d_in[1]; p.w_group = (const float*)d_in[2]; p.pool_scale = (const float*)d_in[3]; p.w_out = (const float*)d_in[4];
    p.w_qkv = (const float*)d_in[5]; p.w_ao = (const float*)d_in[6]; p.w_up = (const float*)d_in[7]; p.w_dn = (const float*)d_in[8];
    p.ln_mix_g = (const float*)d_in[9]; p.ln_mix_b = (const float*)d_in[10]; p.ln_mlp_g = (const float*)d_in[11]; p.ln_mlp_b = (const float*)d_in[12];
    p.out = (float*)d_out; p.ws = (unsigned char*)d_ws;
    void* args[] = {&p};
    hipError_t e = hipLaunchCooperativeKernel((const void*)fwd_megakernel, dim3(grid), dim3(NTHR), args, LDS_BYTES, stream);
    if (e != hipSuccess) fprintf(stderr, "kernel_launch: cooperative launch failed: %s (grid %d)\n", hipGetErrorString(e), grid);
}
```

```cpp
#include <hip/hip_runtime.h>
#include <hip/hip_cooperative_groups.h>
#include <cstdio>
#include <cstdint>
namespace cg = cooperative_groups;

#define LAS __attribute__((address_space(3)))
typedef unsigned short bf16_t;
typedef short bf16x8 __attribute__((ext_vector_type(8)));
typedef short s16x4 __attribute__((ext_vector_type(4)));
typedef float f32x4 __attribute__((ext_vector_type(4)));
typedef float f32x2 __attribute__((ext_vector_type(2)));
typedef unsigned u32x4 __attribute__((ext_vector_type(4)));
typedef unsigned u32x2 __attribute__((ext_vector_type(2)));

constexpr int DM = 2048, BATCH = 16, SEQ = 2048, MTOK = BATCH * SEQ, FF = 8192, QKVW = 9216, GWID = 1024, HD = 128, NSLOT = 8;
constexpr float LN_EPS = 1e-5f;
constexpr float ALPHA = 1.4142135623730951f;
constexpr size_t MiB = 1u << 20;
constexpr size_t WS_WIN = 1 * MiB, WS_WG = 9 * MiB, WS_WOUT = 11 * MiB, WS_WQKV = 19 * MiB, WS_WAO = 55 * MiB, WS_WUP0 = 59 * MiB, WS_WUP1 = 91 * MiB,
                 WS_WDN0 = 123 * MiB, WS_WDN1 = 155 * MiB, WS_LSE = 188 * MiB, WS_XA = 192 * MiB, WS_XB = 320 * MiB, WS_BIG = 448 * MiB, WS_END = 1024 * MiB;

__device__ __forceinline__ unsigned f2bf(float f) { unsigned u = __builtin_bit_cast(unsigned, f); return (u + 0x7fffu + ((u >> 16) & 1u)) >> 16; }
typedef __bf16 bf16x2_t __attribute__((ext_vector_type(2)));
__device__ __forceinline__ unsigned pk2(float lo, float hi) { const f32x2 v = {lo, hi}; const bf16x2_t b = __builtin_convertvector(v, bf16x2_t); return __builtin_bit_cast(unsigned, b); }
__device__ __forceinline__ float bf_lo(unsigned w) { return __builtin_bit_cast(float, w << 16); }
__device__ __forceinline__ float bf_hi(unsigned w) { return __builtin_bit_cast(float, w & 0xffff0000u); }

__device__ __forceinline__ int lane_id_opaque() { int l; asm volatile("v_mbcnt_lo_u32_b32 %0, -1, 0\n\tv_mbcnt_hi_u32_b32 %0, -1, %0" : "=v"(l)); return l; }
#define MYTID(wave_s) ((wave_s) * 64 + lane_id_opaque())
namespace pg8 {
constexpr int BM = 256, BK = 64, HALF = 128, HTB = HALF * BK * 2, STAGE_BYTES = 8 * HTB, NXCD = 8, WGM = 8;
__host__ __device__ __forceinline__ int lds_byte(int r, int c) { const int st = (r >> 4) * 2 + (c >> 5), rr = r & 15, cc = c & 31, ob = rr * 64 + cc * 2; return st * 1024 + (ob ^ (((ob >> 9) & 1) << 5)); }
__host__ __device__ __forceinline__ void stage_rc(int b, int& R, int& C) { const int st = b / 1024, sb = b % 1024, swz = sb ^ (((sb >> 9) & 1) << 5); R = (st >> 1) * 16 + swz / 64; C = (st & 1) * 32 + (swz % 64) / 2; }
__host__ __device__ __forceinline__ int perm32(int rho) { const int n = rho >> 4, i = rho & 15; return 8 * (i >> 2) + 4 * n + (i & 3); }

struct Unit { int pm, pn; };
struct Gemm { const bf16_t* A; const bf16_t* Bt; int M, N, K, lda, agdiv, agk; };

struct StaticOrder {
    int nM, nN, nwg, G, c;
    __host__ __device__ void init(int M, int N, int G_, int c_) { nM = M / BM; nN = N / BM; nwg = nM * nN; G = G_; c = c_; }
    __host__ __device__ bool next(int i, Unit& u) const {
        const long L = (long)i * G + c; if (L >= nwg) return false;
        int wgid = (int)L; { const int q = nwg / NXCD, r = nwg % NXCD, xcd = wgid % NXCD, off = wgid / NXCD; wgid = (xcd < r ? xcd * (q + 1) : r * (q + 1) + (xcd - r) * q) + off; }
        const int nig = WGM * nN, gid = wgid / nig, fm = gid * WGM, gsz = (nM - fm) < WGM ? (nM - fm) : WGM;
        u.pm = fm + ((wgid % nig) % gsz); u.pn = (wgid % nig) / gsz; return true;
    }
};

__device__ __forceinline__ unsigned cvt_pk_bf16(float lo, float hi) { unsigned r; asm volatile("v_cvt_pk_bf16_f32 %0, %1, %2" : "=v"(r) : "v"(lo), "v"(hi)); return r; }

template <int ACT, bool SCALE> struct EpiBf16 {
    bf16_t* O; int ldc; const float* colscale;
    __device__ __forceinline__ void operator()(const f32x4 (&acc)[2][2][4][2], const Unit& u, int wr, int wc, int fr, int fq) const {
        const int row0 = u.pm * BM + wr * 64 + fr; const int col0 = u.pn * BM + wc * 32 + 8 * fq;
        f32x4 cs[2][2];
#pragma unroll
        for (int bj = 0; bj < 2; ++bj)
#pragma unroll
            for (int n = 0; n < 2; ++n) cs[bj][n] = SCALE ? *(const f32x4*)(colscale + col0 + bj * HALF + 4 * n) : (f32x4){1.f, 1.f, 1.f, 1.f};
#pragma unroll
        for (int ai = 0; ai < 2; ++ai)
#pragma unroll
            for (int m = 0; m < 4; ++m) { bf16_t* rowp = O + (size_t)(row0 + ai * HALF + m * 16) * ldc + col0;
#pragma unroll
                for (int bj = 0; bj < 2; ++bj) { f32x4 v0 = acc[ai][bj][m][0], v1 = acc[ai][bj][m][1];
                    if (SCALE) { v0 = v0 * cs[bj][0]; v1 = v1 * cs[bj][1]; }
                    if (ACT == 1) {
#pragma unroll
                        for (int j = 0; j < 4; ++j) { const float a = fmaxf(v0[j], 0.f), b = fmaxf(v1[j], 0.f); v0[j] = a * a; v1[j] = b * b; } }
                    u32x4 w; w.x = cvt_pk_bf16(v0[0], v0[1]); w.y = cvt_pk_bf16(v0[2], v0[3]); w.z = cvt_pk_bf16(v1[0], v1[1]); w.w = cvt_pk_bf16(v1[2], v1[3]);
                    *(u32x4*)(rowp + bj * HALF) = w; } }
    }
};
struct EpiRes {
    const bf16_t* X; bf16_t* R; int ldc; float alpha;
    __device__ __forceinline__ void operator()(const f32x4 (&acc)[2][2][4][2], const Unit& u, int wr, int wc, int fr, int fq) const {
        const int row0 = u.pm * BM + wr * 64 + fr; const int col0 = u.pn * BM + wc * 32 + 8 * fq;
#pragma unroll
        for (int ai = 0; ai < 2; ++ai)
#pragma unroll
            for (int m = 0; m < 4; ++m) { const size_t off = (size_t)(row0 + ai * HALF + m * 16) * ldc + col0;
#pragma unroll
                for (int bj = 0; bj < 2; ++bj) { const u32x4 xw = *(const u32x4*)(X + off + bj * HALF);
                    const f32x4 x0 = {bf_lo(xw.x), bf_hi(xw.x), bf_lo(xw.y), bf_hi(xw.y)}, x1 = {bf_lo(xw.z), bf_hi(xw.z), bf_lo(xw.w), bf_hi(xw.w)};
                    const f32x4 v0 = x0 * alpha + acc[ai][bj][m][0], v1 = x1 * alpha + acc[ai][bj][m][1];
                    u32x4 w; w.x = cvt_pk_bf16(v0[0], v0[1]); w.y = cvt_pk_bf16(v0[2], v0[3]); w.z = cvt_pk_bf16(v1[0], v1[1]); w.w = cvt_pk_bf16(v1[2], v1[3]);
                    *(u32x4*)(R + off + bj * HALF) = w; } }
    }
};

struct EpiQKV {
    bf16_t* O;
    __device__ __forceinline__ void operator()(const f32x4 (&acc)[2][2][4][2], const Unit& u, int wr, int wc, int fr, int fq) const {
        const int which = u.pn / 12, g = (u.pn % 12) >> 2, jp = u.pn & 3, dsh = 2 * g;
        const int m0 = u.pm * BM, b = m0 >> 11, tb = (m0 & 2047) + wr * 64 + fr;
        bf16_t* base = O + ((size_t)((which * 3 + g) * 8 + 2 * jp) * MTOK + (size_t)b * 2048) * 128 + wc * 32 + 8 * fq;
#pragma unroll
        for (int ai = 0; ai < 2; ++ai)
#pragma unroll
            for (int m = 0; m < 4; ++m) { const int t = tb + ai * HALF + m * 16; const int tp = ((t & ((1 << dsh) - 1)) << (11 - dsh)) + (t >> dsh);
                bf16_t* rowp = base + (size_t)tp * 128;
#pragma unroll
                for (int bj = 0; bj < 2; ++bj) { const f32x4 v0 = acc[ai][bj][m][0], v1 = acc[ai][bj][m][1];
                    u32x4 w; w.x = cvt_pk_bf16(v0[0], v0[1]); w.y = cvt_pk_bf16(v0[2], v0[3]); w.z = cvt_pk_bf16(v1[0], v1[1]); w.w = cvt_pk_bf16(v1[2], v1[3]);
                    *(u32x4*)(rowp + (size_t)bj * MTOK * 128) = w; } }
    }
};

template <class Epi, class Sched>
__device__ __forceinline__ void gemm_phase(LAS unsigned char* lds, const Gemm g, const Sched& S, const Epi& E, int wave_s) {
    const int tid = MYTID(wave_s), wid = wave_s, lane = tid & 63, wr = wid >> 2, wc = wid & 3, fr = lane & 15, fq = lane >> 4;
    const int K = g.K, nt = K / BK, lda = g.lda;
    unsigned voffA[2], voffB[2];
#pragma unroll
    for (int i = 0; i < 2; ++i) { int R, C; stage_rc(tid * 16 + i * 8192, R, C); const int Rb = (R & ~31) + perm32(R & 31);
        voffA[i] = (unsigned)(R * lda + C) * 2u; voffB[i] = (unsigned)(Rb * K + C) * 2u; }
    const size_t kstep = (size_t)(BK * 2);
    const size_t hstepA = (size_t)HALF * lda * 2, hstepB = (size_t)HALF * K * 2;
    const size_t tstepA = 2 * hstepA, tstepB = 2 * hstepB;
    const unsigned ldsw = (unsigned)wid * 1024u;
    const int aoff = lds_byte(wr * 64 + fr, fq * 8), boff = lds_byte(wc * 32 + fr, fq * 8);
#define PG8_SA(b, h) (((b) * 2 + (h)) * HTB)
#define PG8_SB(b, h) ((4 + (b) * 2 + (h)) * HTB)
#define PG8_STAGE(bufoff, gbase, voff) do { _Pragma("unroll") for (int _i = 0; _i < 2; ++_i) \
        __builtin_amdgcn_global_load_lds((const unsigned*)((const char*)(gbase) + (voff)[_i]), (LAS unsigned*)(lds + (bufoff) + ldsw + _i * 8192), 16, 0, 0); } while (0)
#define PG8_LDA(dst, b, h) do { _Pragma("unroll") for (int m = 0; m < 4; ++m) _Pragma("unroll") for (int k = 0; k < 2; ++k) dst[m][k] = *(const LAS bf16x8*)(lds + PG8_SA(b, h) + aoff + m * 2048 + k * 1024); } while (0)
#define PG8_LDB(dst, b, h) do { _Pragma("unroll") for (int n = 0; n < 2; ++n) _Pragma("unroll") for (int k = 0; k < 2; ++k) dst[n][k] = *(const LAS bf16x8*)(lds + PG8_SB(b, h) + boff + n * 2048 + k * 1024); } while (0)
#define PG8_MMA(ai, bj, At, Bt) do { __builtin_amdgcn_s_setprio(1); _Pragma("unroll") for (int m = 0; m < 4; ++m) _Pragma("unroll") for (int n = 0; n < 2; ++n) _Pragma("unroll") for (int k = 0; k < 2; ++k) \
        acc[ai][bj][m][n] = __builtin_amdgcn_mfma_f32_16x16x32_bf16(Bt[n][k], At[m][k], acc[ai][bj][m][n], 0, 0, 0); __builtin_amdgcn_s_setprio(0); } while (0)
#define PG8_WAIT_V(n) asm volatile("s_waitcnt vmcnt(" #n ")" ::: "memory")
#define PG8_WAIT_L(n) asm volatile("s_waitcnt lgkmcnt(" #n ")" ::: "memory")
#define PG8_BAR __builtin_amdgcn_s_barrier()
#define PG8_SCHED __builtin_amdgcn_sched_barrier(0)
#define PG8_AOFF(u) ((size_t)(((u).pn / g.agdiv) * g.agk) * 2)
    Unit cur, nxt; int ui = 0;
    if (!S.next(0, cur)) return;
    f32x4 acc[2][2][4][2];
#pragma unroll
    for (int a = 0; a < 2; ++a)
#pragma unroll
        for (int b = 0; b < 2; ++b)
#pragma unroll
            for (int m = 0; m < 4; ++m)
#pragma unroll
                for (int n = 0; n < 2; ++n) acc[a][b][m][n] = (f32x4){0.f, 0.f, 0.f, 0.f};
    bf16x8 At[4][2], B0[2][2], B1[2][2];
    const char* cA = (const char*)g.A + (size_t)cur.pm * tstepA + PG8_AOFF(cur); const char* cB = (const char*)g.Bt + (size_t)cur.pn * tstepB;
    PG8_STAGE(PG8_SB(0, 0), cB, voffB); PG8_STAGE(PG8_SB(0, 1), cB + hstepB, voffB); PG8_STAGE(PG8_SA(0, 0), cA, voffA); PG8_STAGE(PG8_SA(0, 1), cA + hstepA, voffA);
    if (wr == 1) PG8_BAR;
    PG8_WAIT_V(2); PG8_BAR;
    PG8_STAGE(PG8_SB(1, 0), cB + kstep, voffB); PG8_STAGE(PG8_SA(1, 0), cA + kstep, voffA); PG8_STAGE(PG8_SB(1, 1), cB + hstepB + kstep, voffB);
    PG8_WAIT_V(6); PG8_BAR;
    for (;;) {
        const bool has_next = S.next(ui + 1, nxt);
        const char* nA = has_next ? (const char*)g.A + (size_t)nxt.pm * tstepA + PG8_AOFF(nxt) : cA; const char* nB = has_next ? (const char*)g.Bt + (size_t)nxt.pn * tstepB : cB;
        for (int t = 0; t < nt; t += 2) {
            const bool last = (t == nt - 2);
            const char* a1 = cA + (size_t)(t + 1) * kstep;
            const char* a2 = last ? nA : cA + (size_t)(t + 2) * kstep; const char* b2 = last ? nB : cB + (size_t)(t + 2) * kstep;
            const char* a3 = a2 + kstep; const char* b3 = b2 + kstep;
            PG8_LDB(B0, 0, 0); PG8_LDB(B1, 0, 1); PG8_SCHED; PG8_LDA(At, 0, 0); PG8_STAGE(PG8_SA(1, 1), a1 + hstepA, voffA);
            PG8_WAIT_V(8); PG8_WAIT_L(0); PG8_BAR; PG8_MMA(0, 0, At, B0); PG8_MMA(0, 1, At, B1); PG8_BAR; PG8_SCHED;
            PG8_LDA(At, 0, 1); PG8_STAGE(PG8_SB(0, 0), b2, voffB); PG8_STAGE(PG8_SB(0, 1), b2 + hstepB, voffB); PG8_STAGE(PG8_SA(0, 0), a2, voffA);
            PG8_WAIT_V(8); PG8_WAIT_L(0); PG8_BAR; PG8_MMA(1, 0, At, B0); PG8_MMA(1, 1, At, B1); PG8_BAR; PG8_SCHED;
            PG8_LDB(B0, 1, 0); PG8_LDB(B1, 1, 1); PG8_SCHED; PG8_LDA(At, 1, 0); PG8_STAGE(PG8_SA(0, 1), a2 + hstepA, voffA);
            PG8_WAIT_V(8); PG8_WAIT_L(0); PG8_BAR; PG8_MMA(0, 0, At, B0); PG8_MMA(0, 1, At, B1); PG8_BAR; PG8_SCHED;
            PG8_LDA(At, 1, 1); PG8_STAGE(PG8_SB(1, 0), b3, voffB); PG8_STAGE(PG8_SB(1, 1), b3 + hstepB, voffB); PG8_STAGE(PG8_SA(1, 0), a3, voffA);
            PG8_WAIT_V(8); PG8_WAIT_L(0); PG8_BAR; PG8_MMA(1, 0, At, B0); PG8_MMA(1, 1, At, B1); PG8_BAR; PG8_SCHED;
        }
        if (wr == 0) PG8_BAR;
        E(acc, cur, wr, wc, fr, fq);
        if (!has_next) break;
#pragma unroll
        for (int a = 0; a < 2; ++a)
#pragma unroll
            for (int b = 0; b < 2; ++b)
#pragma unroll
                for (int m = 0; m < 4; ++m)
#pragma unroll
                    for (int n = 0; n < 2; ++n) acc[a][b][m][n] = (f32x4){0.f, 0.f, 0.f, 0.f};
        cur = nxt; cA = nA; cB = nB; ++ui;
        if (wr == 1) PG8_BAR;
    }
    PG8_WAIT_V(0);
    PG8_BAR;
#undef PG8_SA
#undef PG8_SB
#undef PG8_STAGE
#undef PG8_LDA
#undef PG8_LDB
#undef PG8_MMA
#undef PG8_WAIT_V
#undef PG8_WAIT_L
#undef PG8_BAR
#undef PG8_SCHED
#undef PG8_AOFF
}
}

constexpr int NWAVES = 8, NTHR = 512;
constexpr int ATT_KSTR = 272, ATT_VSTR = 288, ATT_K_OFF = 0, ATT_V_OFF = 256 * ATT_KSTR, ATT_BYTES = ATT_V_OFF + 272 * ATT_VSTR;
constexpr int MISC_OFF = ATT_BYTES;
constexpr int LDS_BYTES = 148480;
static_assert(ATT_BYTES <= LDS_BYTES && pg8::STAGE_BYTES <= LDS_BYTES, "LDS map");

struct Params {
    const float* x; const float* w_in; const float* w_group; const float* pool_scale; const float* w_out; const float* w_qkv; const float* w_ao;
    const float* w_up; const float* w_dn; const float* ln_mix_g; const float* ln_mix_b; const float* ln_mlp_g; const float* ln_mlp_b;
    float* out; unsigned char* ws;
};

__device__ __forceinline__ float wave_sum(float v) {
#pragma unroll
    for (int o = 1; o < 64; o <<= 1) v += __shfl_xor(v, o);
    return v;
}

__device__ __forceinline__ void p0_transpose_item(const float* W, int K, int N, bf16_t* WT, int row_off, LAS float* scr, int item, int lane) {
    const int nblk = N / 32, kb = item / nblk, nb = item % nblk, k0 = 64 * kb, n0 = 32 * nb;
#pragma unroll 8
    for (int i = 0; i < 32; ++i) { const int kk = 2 * i + (lane >> 5); scr[kk * 33 + (lane & 31)] = W[(size_t)(k0 + kk) * N + n0 + (lane & 31)]; }
    asm volatile("s_waitcnt lgkmcnt(0)" ::: "memory");
    const int c = lane & 7;
#pragma unroll
    for (int j = 0; j < 4; ++j) { const int n = (lane >> 3) + 8 * j; const LAS float* s = scr + (8 * c) * 33 + n;
        u32x4 o; o.x = pk2(s[0 * 33], s[1 * 33]); o.y = pk2(s[2 * 33], s[3 * 33]); o.z = pk2(s[4 * 33], s[5 * 33]); o.w = pk2(s[6 * 33], s[7 * 33]);
        *(u32x4*)(WT + (size_t)(row_off + n0 + n) * K + k0 + 8 * c) = o; }
    asm volatile("s_waitcnt lgkmcnt(0)" ::: "memory");
}

__device__ __forceinline__ void phase_prologue(const Params& p, LAS unsigned char* lds, int wave_s) {
    const int tid = MYTID(wave_s), lane = tid & 63, wave = wave_s;
    LAS float* scr = (LAS float*)(lds + wave * 16384);
    const int gw = blockIdx.x * NWAVES + wave, NGW = gridDim.x * NWAVES;
    unsigned char* ws = p.ws;
    constexpr int I_IN = (DM / 64) * (DM / 32), I_G = (512 / 64) * (512 / 32), I_OUT = I_IN, I_QKV = (DM / 64) * (QKVW / 32), I_AO = (GWID / 64) * (DM / 32),
                  I_UP = (DM / 64) * (FF / 32), I_DN = (FF / 64) * (DM / 32);
    constexpr int NITEMS = I_IN + 4 * I_G + I_OUT + I_QKV + I_AO + 2 * I_UP + 2 * I_DN;
    for (int it = gw; it < NITEMS; it += NGW) {
        int r = it;
        if (r < I_IN) { p0_transpose_item(p.w_in, DM, DM, (bf16_t*)(ws + WS_WIN), 0, scr, r, lane); continue; } r -= I_IN;
        if (r < 4 * I_G) { const int g = r / I_G; p0_transpose_item(p.w_group + (size_t)g * 512 * 512, 512, 512, (bf16_t*)(ws + WS_WG), g * 512, scr, r % I_G, lane); continue; } r -= 4 * I_G;
        if (r < I_OUT) { p0_transpose_item(p.w_out, DM, DM, (bf16_t*)(ws + WS_WOUT), 0, scr, r, lane); continue; } r -= I_OUT;
        if (r < I_QKV) { p0_transpose_item(p.w_qkv, DM, QKVW, (bf16_t*)(ws + WS_WQKV), 0, scr, r, lane); continue; } r -= I_QKV;
        if (r < I_AO) { p0_transpose_item(p.w_ao, GWID, DM, (bf16_t*)(ws + WS_WAO), 0, scr, r, lane); continue; } r -= I_AO;
        if (r < 2 * I_UP) { const int l = r / I_UP; p0_transpose_item(p.w_up + (size_t)l * DM * FF, DM, FF, (bf16_t*)(ws + (l ? WS_WUP1 : WS_WUP0)), 0, scr, r % I_UP, lane); continue; } r -= 2 * I_UP;
        { const int l = r / I_DN; p0_transpose_item(p.w_dn + (size_t)l * FF * DM, FF, DM, (bf16_t*)(ws + (l ? WS_WDN1 : WS_WDN0)), 0, scr, r % I_DN, lane); }
    }
    const size_t n8 = (size_t)MTOK * DM / 8; bf16_t* xa = (bf16_t*)(ws + WS_XA);
    for (size_t i = (size_t)blockIdx.x * NTHR + tid; i < n8; i += (size_t)gridDim.x * NTHR) {
        const f32x4 a = *(const f32x4*)(p.x + i * 8), b = *(const f32x4*)(p.x + i * 8 + 4);
        u32x4 o; o.x = pk2(a.x, a.y); o.y = pk2(a.z, a.w); o.z = pk2(b.x, b.y); o.w = pk2(b.z, b.w);
        *(u32x4*)(xa + i * 8) = o;
    }
}

__device__ __forceinline__ void phase_pool(const bf16_t* U, bf16_t* P, int wave_s) {
    const int tid = MYTID(wave_s);
    constexpr int TB = 32, NITEMS = (MTOK / TB) * (DM / 8);
    for (int id = blockIdx.x * NTHR + tid; id < NITEMS; id += gridDim.x * NTHR) {
        const int c8 = id & 255, tb = id >> 8, t0 = tb * TB, pos0 = t0 & (SEQ - 1), g = c8 >> 6, w = 2 << g;
        const bf16_t* up = U + (size_t)t0 * DM + c8 * 8; bf16_t* pp = P + (size_t)t0 * DM + c8 * 8;
        float s[8];
#pragma unroll
        for (int j = 0; j < 8; ++j) s[j] = 0.f;
        for (int k = 1; k <= w; ++k) { if (pos0 - k >= 0) { const u32x4 v = *(const u32x4*)(up - (ptrdiff_t)k * DM);
            s[0] += bf_lo(v.x); s[1] += bf_hi(v.x); s[2] += bf_lo(v.y); s[3] += bf_hi(v.y); s[4] += bf_lo(v.z); s[5] += bf_hi(v.z); s[6] += bf_lo(v.w); s[7] += bf_hi(v.w); } }
        for (int t = 0; t < TB; ++t) {
            const int pos = pos0 + t;
            const u32x4 v = *(const u32x4*)(up + (size_t)t * DM);
            float c[8] = {bf_lo(v.x), bf_hi(v.x), bf_lo(v.y), bf_hi(v.y), bf_lo(v.z), bf_hi(v.z), bf_lo(v.w), bf_hi(v.w)};
#pragma unroll
            for (int j = 0; j < 8; ++j) s[j] += c[j];
            if (pos >= w) { const u32x4 o = *(const u32x4*)(up + (ptrdiff_t)(t - w) * DM);
                s[0] -= bf_lo(o.x); s[1] -= bf_hi(o.x); s[2] -= bf_lo(o.y); s[3] -= bf_hi(o.y); s[4] -= bf_lo(o.z); s[5] -= bf_hi(o.z); s[6] -= bf_lo(o.w); s[7] -= bf_hi(o.w); }
            const float inv = 1.f / (float)(pos + 1 < w ? pos + 1 : w);
            u32x4 r; r.x = pk2(s[0] * inv - c[0], s[1] * inv - c[1]); r.y = pk2(s[2] * inv - c[2], s[3] * inv - c[3]);
            r.z = pk2(s[4] * inv - c[4], s[5] * inv - c[5]); r.w = pk2(s[6] * inv - c[6], s[7] * inv - c[7]);
            *(u32x4*)(pp + (size_t)t * DM) = r;
        }
    }
}

template <bool F32OUT>
__device__ __forceinline__ void phase_ln(const bf16_t* R, const float* gam, const float* bet, bf16_t* XO, float* FO, int wave_s) {
    const int lane = lane_id_opaque(), wave = wave_s;
    const int gw = blockIdx.x * NWAVES + wave, NGW = gridDim.x * NWAVES;
    for (int m0 = gw; m0 < MTOK; m0 += 2 * NGW) {
        const int m1 = m0 + NGW; const bool two = m1 < MTOK; const int m1c = two ? m1 : m0;
        u32x4 wa[4], wb[4];
#pragma unroll
        for (int j = 0; j < 4; ++j) { wa[j] = *((const u32x4*)(R + (size_t)m0 * DM) + lane + 64 * j); wb[j] = *((const u32x4*)(R + (size_t)m1c * DM) + lane + 64 * j); }
#pragma unroll
        for (int rr = 0; rr < 2; ++rr) {
            if (rr == 1 && !two) break;
            const int m = rr ? m1 : m0;
            float v[4][8]; float s = 0.f;
#pragma unroll
            for (int j = 0; j < 4; ++j) { const u32x4 w = rr ? wb[j] : wa[j];
                v[j][0] = bf_lo(w.x); v[j][1] = bf_hi(w.x); v[j][2] = bf_lo(w.y); v[j][3] = bf_hi(w.y); v[j][4] = bf_lo(w.z); v[j][5] = bf_hi(w.z); v[j][6] = bf_lo(w.w); v[j][7] = bf_hi(w.w);
#pragma unroll
                for (int e = 0; e < 8; ++e) s += v[j][e]; }
            const float mean = wave_sum(s) * (1.f / DM); float s2 = 0.f;
#pragma unroll
            for (int j = 0; j < 4; ++j)
#pragma unroll
                for (int e = 0; e < 8; ++e) { v[j][e] -= mean; s2 += v[j][e] * v[j][e]; }
            const float rstd = 1.f / sqrtf(wave_sum(s2) * (1.f / DM) + LN_EPS);
#pragma unroll
            for (int j = 0; j < 4; ++j) {
                const int c0 = (lane + 64 * j) * 8;
                const f32x4 g0 = *(const f32x4*)(gam + c0), g1 = *(const f32x4*)(gam + c0 + 4), b0 = *(const f32x4*)(bet + c0), b1 = *(const f32x4*)(bet + c0 + 4);
                const f32x4 y0 = (f32x4){v[j][0], v[j][1], v[j][2], v[j][3]} * rstd * g0 + b0, y1 = (f32x4){v[j][4], v[j][5], v[j][6], v[j][7]} * rstd * g1 + b1;
                if (F32OUT) { *(f32x4*)(FO + (size_t)m * DM + c0) = y0; *(f32x4*)(FO + (size_t)m * DM + c0 + 4) = y1; }
                else { u32x4 o; o.x = pk2(y0.x, y0.y); o.y = pk2(y0.z, y0.w); o.z = pk2(y1.x, y1.y); o.w = pk2(y1.z, y1.w); *((u32x4*)(XO + (size_t)m * DM) + lane + 64 * j) = o; }
            }
        }
    }
}

__device__ __forceinline__ s16x4 vtr(const LAS unsigned char* p) { return __builtin_bit_cast(s16x4, __builtin_amdgcn_ds_read_tr16_b64_v4i16((LAS s16x4*)p)); }

struct AttnId { int g, b, r, qb, j, ldprev; };
__device__ __forceinline__ AttnId attn_decode(int pass, int c, int i) {
    AttnId a; a.ldprev = 0;
    if (pass == 0) {
        if (i < 8) { a.g = 0; a.j = c & 7; a.b = (c >> 3) & 15; const int half = c >> 7; a.r = 0; a.qb = half * 8 + i; a.ldprev = (half == 1 && i == 0) ? 1 : 0; }
        else { const int ch = 2 * c + ((i - 8) >> 2); a.g = 1; a.j = ch & 7; a.r = (ch >> 3) & 3; a.b = ch >> 5; a.qb = (i - 8) & 3; }
    } else { const int id = 8 * c + i; a.g = 2; a.j = id & 7; a.r = (id >> 3) & 15; a.b = id >> 7; a.qb = 0; }
    return a;
}
__device__ __forceinline__ void attn_fetch(const bf16_t* qkv, const AttnId& a, int blk, u32x4 (&kv)[4], u32x4 (&vv)[4], int tid) {
    const int dsh = 2 * a.g;
    const size_t row0 = (size_t)a.b * SEQ + (size_t)a.r * (SEQ >> dsh) + (size_t)blk * 128;
    const int chunk = tid & 15, rb = tid >> 4;
    const bf16_t* kbase = qkv + ((size_t)((3 + a.g) * 8 + a.j) * MTOK + row0) * HD + chunk * 8;
    const bf16_t* vbase = kbase + (size_t)24 * MTOK * HD;
#pragma unroll
    for (int it = 0; it < 4; ++it) { const size_t ro = (size_t)(it * 32 + rb) * HD; kv[it] = *(const u32x4*)(kbase + ro); vv[it] = *(const u32x4*)(vbase + ro); }
}
__device__ __forceinline__ void attn_fetch_q(const bf16_t* qkv, const AttnId& a, bf16x8 (&qf)[4], int w, int fr, int fq) {
    const int dsh = 2 * a.g;
    const size_t row = (size_t)a.b * SEQ + (size_t)a.r * (SEQ >> dsh) + (size_t)(a.qb * 128 + 16 * w + fr);
    const bf16_t* qb = qkv + ((size_t)(a.g * 8 + a.j) * MTOK + row) * HD + 8 * fq;
#pragma unroll
    for (int kk = 0; kk < 4; ++kk) qf[kk] = *(const bf16x8*)(qb + 32 * kk);
}
__device__ __forceinline__ void attn_put(LAS unsigned char* lds, int half, const u32x4 (&kv)[4], const u32x4 (&vv)[4], int tid) {
    const int chunk = tid & 15, rb = tid >> 4;
#pragma unroll
    for (int it = 0; it < 4; ++it) { const int row = half * 128 + it * 32 + rb;
        *(LAS u32x4*)(lds + ATT_K_OFF + row * ATT_KSTR + chunk * 16) = kv[it]; *(LAS u32x4*)(lds + ATT_V_OFF + row * ATT_VSTR + chunk * 16) = vv[it]; }
}
__device__ __forceinline__ int attn_trow(int T, int ch) { return T >= 16 ? 256 : ((((T >> 3) ^ 1) ^ ch) << 7) + ((T & 7) << 4); }

__device__ __forceinline__ void attn_scores(LAS unsigned char* lds, int ch, bool has_prev, const bf16x8 (&qf)[4], f32x4 (&s)[9], int w, int fr, int fq) {
    LAS unsigned char* Kl = lds + ATT_K_OFF;
#pragma unroll
    for (int tt = 0; tt < 9; ++tt) { s[tt] = (f32x4){0.f, 0.f, 0.f, 0.f}; const int rowb = attn_trow(w + tt, ch);
        if (!has_prev && w + tt < 8) continue;
#pragma unroll
        for (int kk = 0; kk < 4; ++kk) { const bf16x8 av = *(const LAS bf16x8*)(Kl + (rowb + fr) * ATT_KSTR + (32 * kk + 8 * fq) * 2);
            s[tt] = __builtin_amdgcn_mfma_f32_16x16x32_bf16(av, qf[kk], s[tt], 0, 0, 0); } }
}
__device__ __forceinline__ void attn_finish(LAS unsigned char* lds, int ch, const AttnId& a, f32x4 (&s)[9], bf16_t* obuf, float* lsebuf, bf16_t* merged, int w, int fr, int fq) {
    const int g = a.g, j = a.j, qb = a.qb;
    const int dsh = (g == 0) ? 0 : (g == 1 ? 2 : 4), d = 1 << dsh;
    const size_t qrow = (size_t)a.b * SEQ + (size_t)((qb * 128 + 16 * w + fr) << dsh) + a.r;
    LAS unsigned char* Vl = lds + ATT_V_OFF;
    constexpr float LOG2E = 1.4426950408889634f;
    const float sc = 0.08838834764831845f * LOG2E;
    const float slope = exp2f(-8.0f * (float)(g * NSLOT + j + 1) / 24.0f);
    const float sl = slope * (float)d * LOG2E;
    float mx = -INFINITY;
    const float fb = (float)(128 + fr - 4 * fq);
#pragma unroll
    for (int tt = 0; tt < 9; ++tt) {
        const bool tile_ok = (qb > 0) || (w + tt >= 8);
#pragma unroll
        for (int jj = 0; jj < 4; ++jj) {
            const float dist = fb - (float)(16 * tt + jj);
            bool valid = tile_ok;
            if (tt == 0) valid = valid && (dist <= 128.f);
            if (tt == 8) valid = valid && (dist >= 0.f);
            const float v = valid ? (s[tt][jj] * sc - sl * dist) : -INFINITY;
            s[tt][jj] = v; mx = fmaxf(mx, v);
        }
    }
    mx = fmaxf(mx, __shfl_xor(mx, 16)); mx = fmaxf(mx, __shfl_xor(mx, 32));
    float sum = 0.f;
#pragma unroll
    for (int tt = 0; tt < 9; ++tt)
#pragma unroll
        for (int jj = 0; jj < 4; ++jj) { const float e = __builtin_amdgcn_exp2f(s[tt][jj] - mx); s[tt][jj] = e; sum += e; }
    sum += __shfl_xor(sum, 16); sum += __shfl_xor(sum, 32);
    bf16x8 pf[5];
#pragma unroll
    for (int c = 0; c < 5; ++c) {
        u32x4 pw; pw.x = pk2(s[2 * c][0], s[2 * c][1]); pw.y = pk2(s[2 * c][2], s[2 * c][3]);
        if (c < 4) { pw.z = pk2(s[2 * c + 1][0], s[2 * c + 1][1]); pw.w = pk2(s[2 * c + 1][2], s[2 * c + 1][3]); } else { pw.z = 0u; pw.w = 0u; }
        pf[c] = __builtin_bit_cast(bf16x8, pw);
    }
    u32x2 m0[8]; float l0 = 0.f, l1 = 0.f;
    const bf16_t* o0p = obuf + qrow * GWID + j * HD + 4 * fq;
    if (g == 2) { l0 = lsebuf[qrow * NSLOT + j]; l1 = lsebuf[((size_t)MTOK + qrow) * NSLOT + j];
#pragma unroll
        for (int dt = 0; dt < 8; ++dt) m0[dt] = *(const u32x2*)(o0p + 16 * dt); }
    else {
#pragma unroll
        for (int dt = 0; dt < 8; ++dt) m0[dt] = (u32x2){0u, 0u}; }
    f32x4 o[8];
#pragma unroll
    for (int dt = 0; dt < 8; ++dt) o[dt] = (f32x4){0.f, 0.f, 0.f, 0.f};
    const int lofs = (4 * fq + (fr >> 2)) * ATT_VSTR + (4 * (fr & 3)) * 2;
#pragma unroll
    for (int c = 0; c < 5; ++c) {
        __builtin_amdgcn_sched_barrier(0);
        if (qb == 0 && w + 2 * c + 1 < 8) continue;
        const LAS unsigned char* v0 = Vl + attn_trow(w + 2 * c, ch) * ATT_VSTR + lofs; const LAS unsigned char* v1 = Vl + attn_trow(w + 2 * c + 1, ch) * ATT_VSTR + lofs;
#pragma unroll
        for (int dt = 0; dt < 8; ++dt) {
            const s16x4 lo = vtr(v0 + dt * 32), hi = vtr(v1 + dt * 32);
            const bf16x8 av = {lo[0], lo[1], lo[2], lo[3], hi[0], hi[1], hi[2], hi[3]};
            o[dt] = __builtin_amdgcn_mfma_f32_16x16x32_bf16(av, pf[c], o[dt], 0, 0, 0);
        }
    }
    const float inv = 1.f / sum;
    const float lse = (mx + log2f(sum)) * 0.6931471805599453f;
    if (g < 2) {
        bf16_t* orow = obuf + ((size_t)g * MTOK + qrow) * GWID + j * HD + 4 * fq;
#pragma unroll
        for (int dt = 0; dt < 8; ++dt) { u32x2 ow; ow.x = pk2(o[dt][0] * inv, o[dt][1] * inv); ow.y = pk2(o[dt][2] * inv, o[dt][3] * inv); *(u32x2*)(orow + 16 * dt) = ow; }
        if (fq == 0) lsebuf[((size_t)g * MTOK + qrow) * NSLOT + j] = lse;
    } else {
        const float lm = fmaxf(lse, fmaxf(l0, l1));
        float e0 = __expf(l0 - lm), e1 = __expf(l1 - lm), e2 = __expf(lse - lm); const float wi = 1.f / (e0 + e1 + e2); e0 *= wi; e1 *= wi; e2 *= wi * inv;
        bf16_t* mrow = merged + qrow * GWID + j * HD + 4 * fq;
#pragma unroll
        for (int dt = 0; dt < 8; ++dt) { const u32x2 a0 = m0[dt], a1 = *(const u32x2*)(o0p + (size_t)MTOK * GWID + 16 * dt);
            u32x2 ow; ow.x = pk2(e0 * bf_lo(a0.x) + e1 * bf_lo(a1.x) + e2 * o[dt][0], e0 * bf_hi(a0.x) + e1 * bf_hi(a1.x) + e2 * o[dt][1]);
            ow.y = pk2(e0 * bf_lo(a0.y) + e1 * bf_lo(a1.y) + e2 * o[dt][2], e0 * bf_hi(a0.y) + e1 * bf_hi(a1.y) + e2 * o[dt][3]);
            *(u32x2*)(mrow + 16 * dt) = ow; }
    }
}

#define ATT_LBAR() do { asm volatile("s_waitcnt lgkmcnt(0)" ::: "memory"); __builtin_amdgcn_s_barrier(); asm volatile("" ::: "memory"); } while (0)
__device__ __forceinline__ void phase_attn(LAS unsigned char* lds, const bf16_t* qkv, bf16_t* obuf, float* lsebuf, bf16_t* merged, int pass, int wave_s) {
    const int tid = MYTID(wave_s), lane = tid & 63, w = wave_s, fr = lane & 15, fq = lane >> 4;
    const int c = blockIdx.x, n = pass == 0 ? 16 : 8;
    for (int i = tid; i < ATT_BYTES / 16; i += NTHR) ((LAS u32x4*)lds)[i] = (u32x4){0u, 0u, 0u, 0u};
    ATT_LBAR();
    u32x4 kv[4], vv[4]; bf16x8 qn[4];
    AttnId cur = attn_decode(pass, c, 0);
    attn_fetch(qkv, cur, cur.qb, kv, vv, tid); attn_fetch_q(qkv, cur, qn, w, fr, fq);
    for (int i = 0; i < n; ++i) {
        const int ch = cur.qb & 1;
        attn_put(lds, ch, kv, vv, tid);
        if (cur.ldprev) { attn_fetch(qkv, cur, cur.qb - 1, kv, vv, tid); attn_put(lds, ch ^ 1, kv, vv, tid); }
        ATT_LBAR();
        f32x4 sacc[9];
        attn_scores(lds, ch, cur.qb > 0, qn, sacc, w, fr, fq);
        __builtin_amdgcn_sched_barrier(0);
        AttnId nxt = cur;
        if (i + 1 < n) { nxt = attn_decode(pass, c, i + 1); attn_fetch(qkv, nxt, nxt.qb, kv, vv, tid); attn_fetch_q(qkv, nxt, qn, w, fr, fq); }
        attn_finish(lds, ch, cur, sacc, obuf, lsebuf, merged, w, fr, fq);
        ATT_LBAR();
        cur = nxt;
    }
}

#define XB_TMO      128
#define XB_XCNT(j)  (256  + 64 * (j))
#define XB_XSUB(j)  (1280 + 64 * (j))
#define XB_XGEN(j)  (2304 + 64 * (j))
#define XB_TOP      3328
#define XB_TOPGEN   3392
#define XCD_BAR_WORDS 3456
#define XB_SPIN_CAP (1u << 22)
__device__ __forceinline__ unsigned xb_ld(unsigned* p)              { return __hip_atomic_load(p, __ATOMIC_RELAXED, __HIP_MEMORY_SCOPE_AGENT); }
__device__ __forceinline__ unsigned xb_add(unsigned* p, unsigned v) { return __hip_atomic_fetch_add(p, v, __ATOMIC_RELAXED, __HIP_MEMORY_SCOPE_AGENT); }
__device__ __forceinline__ unsigned xb_xcc_id() { return (unsigned)__builtin_amdgcn_s_getreg((3 << 11) | 20) & 0xFu; }
#define XB_SPIN(cond, bar) do { unsigned _sp = 0; while (cond) { __builtin_amdgcn_s_sleep(1); \
    if ((++_sp & 255u) == 0u) { if (xb_ld(&(bar)[XB_TMO])) break; if (_sp > XB_SPIN_CAP) { atomicAdd(&(bar)[XB_TMO], 1u); break; } } } } while (0)
struct XcdBarrier { unsigned* bar; unsigned x; volatile LAS unsigned* st; };
__device__ __forceinline__ XcdBarrier xcd_barrier_post(unsigned* bar, volatile LAS unsigned* st, int wave_s) {
    XcdBarrier b; b.bar = bar; b.x = xb_xcc_id(); b.st = st;
    if (MYTID(wave_s) == 0) (void)xb_add(&bar[XB_XCNT(b.x)], 1u);
    return b;
}
__device__ __forceinline__ void xcd_barrier_complete(unsigned* bar, unsigned x, unsigned& nloc, unsigned& nx) {
    const unsigned G = gridDim.x * gridDim.y * gridDim.z;
    unsigned sum, cnt, mine, sp = 0u;
    for (;;) {
        sum = 0u; cnt = 0u; mine = 0u;
#pragma unroll
        for (unsigned j = 0; j < 16; ++j) { const unsigned c = xb_ld(&bar[XB_XCNT(j)]); sum += c; cnt += (c > 0u) ? 1u : 0u; mine = (j == x) ? c : mine; }
        if (sum == G) break;
        __builtin_amdgcn_s_sleep(1);
        if ((++sp & 255u) == 0u) { if (xb_ld(&bar[XB_TMO])) break; if (sp > XB_SPIN_CAP) { atomicAdd(&bar[XB_TMO], 1u); break; } }
    }
    nloc = mine > 0u ? mine : 1u; nx = cnt > 0u ? cnt : 1u;
}
__device__ __forceinline__ void xcd_barrier(const XcdBarrier& b, int wave_s) {
    asm volatile("s_waitcnt vmcnt(0)" ::: "memory");
    __syncthreads();
    if (MYTID(wave_s) == 0) {
        unsigned* bar = b.bar;
        __builtin_amdgcn_s_waitcnt(0);
        unsigned nloc = b.st[0], nx = b.st[1];
        if (nloc == 0u) { xcd_barrier_complete(bar, b.x, nloc, nx); b.st[0] = nloc; b.st[1] = nx; }
        const unsigned old = xb_add(&bar[XB_XSUB(b.x)], 1u);
        const unsigned gen = old / nloc;
        if (old + 1u == (gen + 1u) * nloc) {
            __builtin_amdgcn_fence(__ATOMIC_RELEASE, "agent");
            asm volatile("s_waitcnt vmcnt(0)" ::: "memory");
            const unsigned og = xb_add(&bar[XB_TOP], 1u);
            const unsigned tg = og / nx;
            if (og + 1u == (tg + 1u) * nx) xb_add(&bar[XB_TOPGEN], 1u);
            else XB_SPIN(xb_ld(&bar[XB_TOPGEN]) == tg, bar);
            __builtin_amdgcn_fence(__ATOMIC_ACQUIRE, "agent");
            xb_add(&bar[XB_XGEN(b.x)], 1u);
            asm volatile("s_waitcnt vmcnt(0)" ::: "memory");
        } else {
            XB_SPIN(xb_ld(&bar[XB_XGEN(b.x)]) == gen, bar);
            __builtin_amdgcn_fence(__ATOMIC_ACQUIRE, "agent");
            asm volatile("s_waitcnt vmcnt(0)" ::: "memory");
        }
    }
    __syncthreads();
}

__global__ void __launch_bounds__(NTHR, 2) fwd_megakernel(Params p) {
    extern __shared__ __attribute__((aligned(16))) unsigned char lds_raw[];
    LAS unsigned char* lds = (LAS unsigned char*)lds_raw;
    cg::grid_group grid = cg::this_grid();
    unsigned char* ws = p.ws;
    bf16_t* XA = (bf16_t*)(ws + WS_XA); bf16_t* XB = (bf16_t*)(ws + WS_XB);
    bf16_t* BIG = (bf16_t*)(ws + WS_BIG);
    bf16_t* U = BIG; bf16_t* PB = BIG + (size_t)MTOK * DM; bf16_t* Y = BIG + 2 * (size_t)MTOK * DM;
    bf16_t* R = (bf16_t*)p.out;
    volatile LAS unsigned* MISC = (volatile LAS unsigned*)(lds + MISC_OFF);
    unsigned* barw = (unsigned*)ws;
    const int G = gridDim.x, c = blockIdx.x;
    constexpr int NOG = 1 << 30;

    const int wave_s = __builtin_amdgcn_readfirstlane((int)threadIdx.x >> 6);
    { const int t0 = MYTID(wave_s); if (blockIdx.x == 0) for (int i = t0; i < XCD_BAR_WORDS; i += NTHR) barw[i] = 0u;
      if (t0 < 2) MISC[t0] = 0u; }
    phase_prologue(p, lds, wave_s);
    grid.sync();
    const XcdBarrier xbar = xcd_barrier_post(barw, MISC, wave_s);
    {
        pg8::Gemm g{XA, (const bf16_t*)(ws + WS_WIN), MTOK, DM, DM, DM, NOG, 0}; pg8::StaticOrder S; S.init(MTOK, DM, G, c);
        pg8::EpiBf16<0, false> E{U, DM, nullptr};
        pg8::gemm_phase(lds, g, S, E, wave_s);
    }
    xcd_barrier(xbar, wave_s);
    phase_pool(U, PB, wave_s);
    xcd_barrier(xbar, wave_s);
    {
        pg8::Gemm g{PB, (const bf16_t*)(ws + WS_WG), MTOK, DM, 512, DM, 2, 512}; pg8::StaticOrder S; S.init(MTOK, DM, G, c);
        pg8::EpiBf16<0, true> E{Y, DM, p.pool_scale};
        pg8::gemm_phase(lds, g, S, E, wave_s);
    }
    xcd_barrier(xbar, wave_s);
    {
        pg8::Gemm g{Y, (const bf16_t*)(ws + WS_WOUT), MTOK, DM, DM, DM, NOG, 0}; pg8::StaticOrder S; S.init(MTOK, DM, G, c);
        pg8::EpiRes E{XA, R, DM, ALPHA};
        pg8::gemm_phase(lds, g, S, E, wave_s);
    }
    xcd_barrier(xbar, wave_s);
    phase_ln<false>(R, p.ln_mix_g, p.ln_mix_b, XB, nullptr, wave_s);
    xcd_barrier(xbar, wave_s);
    {
        pg8::Gemm g{XB, (const bf16_t*)(ws + WS_WUP0), MTOK, FF, DM, DM, NOG, 0}; pg8::StaticOrder S; S.init(MTOK, FF, G, c);
        pg8::EpiBf16<1, false> E{BIG, FF, nullptr};
        pg8::gemm_phase(lds, g, S, E, wave_s);
    }
    xcd_barrier(xbar, wave_s);
    {
        pg8::Gemm g{BIG, (const bf16_t*)(ws + WS_WDN0), MTOK, DM, FF, FF, NOG, 0}; pg8::StaticOrder S; S.init(MTOK, DM, G, c);
        pg8::EpiRes E{XB, R, DM, ALPHA};
        pg8::gemm_phase(lds, g, S, E, wave_s);
    }
    xcd_barrier(xbar, wave_s);
    phase_ln<false>(R, p.ln_mlp_g, p.ln_mlp_b, XA, nullptr, wave_s);
    xcd_barrier(xbar, wave_s);
    {
        pg8::Gemm g{XA, (const bf16_t*)(ws + WS_WQKV), MTOK, QKVW, DM, DM, NOG, 0}; pg8::StaticOrder S; S.init(MTOK, QKVW, G, c);
        pg8::EpiQKV E{BIG};
        pg8::gemm_phase(lds, g, S, E, wave_s);
    }
    xcd_barrier(xbar, wave_s);
    phase_attn(lds, BIG, (bf16_t*)p.out, (float*)(ws + WS_LSE), XB, 0, wave_s);
    xcd_barrier(xbar, wave_s);
    phase_attn(lds, BIG, (bf16_t*)p.out, (float*)(ws + WS_LSE), XB, 1, wave_s);
    xcd_barrier(xbar, wave_s);
    {
        pg8::Gemm g{XB, (const bf16_t*)(ws + WS_WAO), MTOK, DM, GWID, GWID, NOG, 0}; pg8::StaticOrder S; S.init(MTOK, DM, G, c);
        pg8::EpiRes E{XA, R, DM, ALPHA};
        pg8::gemm_phase(lds, g, S, E, wave_s);
    }
    xcd_barrier(xbar, wave_s);
    phase_ln<false>(R, p.ln_mix_g + DM, p.ln_mix_b + DM, XB, nullptr, wave_s);
    xcd_barrier(xbar, wave_s);
    {
        pg8::Gemm g{XB, (const bf16_t*)(ws + WS_WUP1), MTOK, FF, DM, DM, NOG, 0}; pg8::StaticOrder S; S.init(MTOK, FF, G, c);
        pg8::EpiBf16<1, false> E{BIG, FF, nullptr};
        pg8::gemm_phase(lds, g, S, E, wave_s);
    }
    xcd_barrier(xbar, wave_s);
    {
        pg8::Gemm g{BIG, (const bf16_t*)(ws + WS_WDN1), MTOK, DM, FF, FF, NOG, 0}; pg8::StaticOrder S; S.init(MTOK, DM, G, c);
        pg8::EpiRes E{XB, XA, DM, ALPHA};
        pg8::gemm_phase(lds, g, S, E, wave_s);
    }
    xcd_barrier(xbar, wave_s);
    phase_ln<true>(XA, p.ln_mlp_g + DM, p.ln_mlp_b + DM, nullptr, p.out, wave_s);
}

extern "C" void kernel_launch(void* const* d_in, const int* in_sizes, int n_in, void* d_out, int out_size, void* d_ws, size_t ws_size, hipStream_t stream) {
    static int grid = 0;
    if (grid == 0) {
        if (n_in != 13 || in_sizes[0] != MTOK * DM || out_size != MTOK * DM || ws_size < WS_END) {
            fprintf(stderr, "kernel_launch: unexpected shapes: n_in %d in0 %d out %d ws %zu (need %zu); nothing launched\n", n_in, n_in > 0 ? in_sizes[0] : -1, out_size, ws_size, (size_t)WS_END); grid = -1; return; }
        int dev = 0, cus = 0, per_cu = 0;
        hipGetDevice(&dev);
        hipDeviceGetAttribute(&cus, hipDeviceAttributeMultiprocessorCount, dev);
        if (hipFuncSetAttribute((const void*)fwd_megakernel, hipFuncAttributeMaxDynamicSharedMemorySize, LDS_BYTES) != hipSuccess) { fprintf(stderr, "kernel_launch: hipFuncSetAttribute failed\n"); grid = -1; return; }
        if (hipOccupancyMaxActiveBlocksPerMultiprocessor(&per_cu, (const void*)fwd_megakernel, NTHR, LDS_BYTES) != hipSuccess || per_cu < 1) { fprintf(stderr, "kernel_launch: occupancy query gave %d\n", per_cu); per_cu = 1; }
        (void)hipGetLastError();
        grid = cus * per_cu;
        if (grid != 256) { fprintf(stderr, "kernel_launch: this kernel needs exactly 256 co-resident workgroups, got %d\n", grid); if (grid > 256) grid = 256; }
        fprintf(stderr, "kernel_launch: grid %d (cus %d x %d)\n", grid, cus, per_cu);
    }
    if (grid < 0) return;
    Params p{};
    p.x = (const float*)d_in[0]; p.w_in = (const float*)d_in[1]; p.w_group = (const float*)d_in[2]; p.pool_scale = (const float*)d_in[3]; p.w_out = (const float*)d_in[4];
    p.w_qkv = (const float*)d_in[5]; p.w_ao = (const float*)d_in[6]; p.w_up = (const float*)d_in[7]; p.w_dn = (const float*)d_in[8];
    p.ln_mix_g = (const float*)d_in[9]; p.ln_mix_b = (const float*)d_in[10]; p.ln_mlp_g = (const float*)d_in[11]; p.ln_mlp_b = (const float*)d_in[12];
    p.out = (float*)d_out; p.ws = (unsigned char*)d_ws;
    void* args[] = {&p};
    hipError_t e = hipLaunchCooperativeKernel((const void*)fwd_megakernel, dim3(grid), dim3(NTHR), args, LDS_BYTES, stream);
    if (e != hipSuccess) fprintf(stderr, "kernel_launch: cooperative launch failed: %s (grid %d)\n", hipGetErrorString(e), grid);
}
```

```cpp
#include <hip/hip_runtime.h>
#include <hip/hip_cooperative_groups.h>
#include <cstdio>
#include <cstdint>
namespace cg = cooperative_groups;

#define LAS __attribute__((address_space(3)))
typedef unsigned short bf16_t;
typedef short bf16x8 __attribute__((ext_vector_type(8)));
typedef short s16x4 __attribute__((ext_vector_type(4)));
typedef float f32x4 __attribute__((ext_vector_type(4)));
typedef float f32x2 __attribute__((ext_vector_type(2)));
typedef unsigned u32x4 __attribute__((ext_vector_type(4)));
typedef unsigned u32x2 __attribute__((ext_vector_type(2)));

constexpr int DM = 2048, BATCH = 16, SEQ = 2048, MTOK = BATCH * SEQ, FF = 8192, QKVW = 9216, GWID = 1024, HD = 128, NSLOT = 8;
constexpr float LN_EPS = 1e-5f;
constexpr float ALPHA = 1.4142135623730951f;
constexpr size_t MiB = 1u << 20;
constexpr size_t WS_WIN = 1 * MiB, WS_WG = 9 * MiB, WS_WOUT = 11 * MiB, WS_WQKV = 19 * MiB, WS_WAO = 55 * MiB, WS_WUP0 = 59 * MiB, WS_WUP1 = 91 * MiB,
                 WS_WDN0 = 123 * MiB, WS_WDN1 = 155 * MiB, WS_LSE = 188 * MiB, WS_XA = 192 * MiB, WS_XB = 320 * MiB, WS_BIG = 448 * MiB, WS_END = 1024 * MiB;

__device__ __forceinline__ unsigned f2bf(float f) { unsigned u = __builtin_bit_cast(unsigned, f); return (u + 0x7fffu + ((u >> 16) & 1u)) >> 16; }
typedef __bf16 bf16x2_t __attribute__((ext_vector_type(2)));
__device__ __forceinline__ unsigned pk2(float lo, float hi) { const f32x2 v = {lo, hi}; const bf16x2_t b = __builtin_convertvector(v, bf16x2_t); return __builtin_bit_cast(unsigned, b); }
__device__ __forceinline__ float bf_lo(unsigned w) { return __builtin_bit_cast(float, w << 16); }
__device__ __forceinline__ float bf_hi(unsigned w) { return __builtin_bit_cast(float, w & 0xffff0000u); }

__device__ __forceinline__ int lane_id_opaque() { int l; asm volatile("v_mbcnt_lo_u32_b32 %0, -1, 0\n\tv_mbcnt_hi_u32_b32 %0, -1, %0" : "=v"(l)); return l; }
#define MYTID(wave_s) ((wave_s) * 64 + lane_id_opaque())
namespace pg8 {
constexpr int BM = 256, BK = 64, HALF = 128, HTB = HALF * BK * 2, STAGE_BYTES = 8 * HTB, NXCD = 8, WGM = 8;
__host__ __device__ __forceinline__ int lds_byte(int r, int c) { const int st = (r >> 4) * 2 + (c >> 5), rr = r & 15, cc = c & 31, ob = rr * 64 + cc * 2; return st * 1024 + (ob ^ (((ob >> 9) & 1) << 5)); }
__host__ __device__ __forceinline__ void stage_rc(int b, int& R, int& C) { const int st = b / 1024, sb = b % 1024, swz = sb ^ (((sb >> 9) & 1) << 5); R = (st >> 1) * 16 + swz / 64; C = (st & 1) * 32 + (swz % 64) / 2; }
__host__ __device__ __forceinline__ int perm32(int rho) { const int n = rho >> 4, i = rho & 15; return 8 * (i >> 2) + 4 * n + (i & 3); }

struct Unit { int pm, pn; };
struct Gemm { const bf16_t* A; const bf16_t* Bt; int M, N, K, lda, agdiv, agk; };

struct StaticOrder {
    int nM, nN, nwg, G, c, wgm;
    __host__ __device__ void init(int M, int N, int G_, int c_) { nM = M / BM; nN = N / BM; nwg = nM * nN; G = G_; c = c_; wgm = (nN <= 8) ? 4 : WGM; }
    __host__ __device__ bool next(int i, Unit& u) const {
        const long L = (long)i * G + c; if (L >= nwg) return false;
        int wgid = (int)L; { const int q = nwg / NXCD, r = nwg % NXCD, xcd = wgid % NXCD, off = wgid / NXCD; wgid = (xcd < r ? xcd * (q + 1) : r * (q + 1) + (xcd - r) * q) + off; }
        const int nig = wgm * nN, gid = wgid / nig, fm = gid * wgm, gsz = (nM - fm) < wgm ? (nM - fm) : wgm;
        u.pm = fm + ((wgid % nig) % gsz); u.pn = (wgid % nig) / gsz; return true;
    }
};

__device__ __forceinline__ unsigned cvt_pk_bf16(float lo, float hi) { unsigned r; asm volatile("v_cvt_pk_bf16_f32 %0, %1, %2" : "=v"(r) : "v"(lo), "v"(hi)); return r; }

template <int ACT, bool SCALE> struct EpiBf16 {
    bf16_t* O; int ldc; const float* colscale;
    __device__ __forceinline__ void operator()(const f32x4 (&acc)[2][2][4][2], const Unit& u, int wr, int wc, int fr, int fq) const {
        const int row0 = u.pm * BM + wr * 64 + fr; const int col0 = u.pn * BM + wc * 32 + 8 * fq;
        f32x4 cs[2][2];
#pragma unroll
        for (int bj = 0; bj < 2; ++bj)
#pragma unroll
            for (int n = 0; n < 2; ++n) cs[bj][n] = SCALE ? *(const f32x4*)(colscale + col0 + bj * HALF + 4 * n) : (f32x4){1.f, 1.f, 1.f, 1.f};
#pragma unroll
        for (int ai = 0; ai < 2; ++ai)
#pragma unroll
            for (int m = 0; m < 4; ++m) { bf16_t* rowp = O + (size_t)(row0 + ai * HALF + m * 16) * ldc + col0;
#pragma unroll
                for (int bj = 0; bj < 2; ++bj) { f32x4 v0 = acc[ai][bj][m][0], v1 = acc[ai][bj][m][1];
                    if (SCALE) { v0 = v0 * cs[bj][0]; v1 = v1 * cs[bj][1]; }
                    if (ACT == 1) {
#pragma unroll
                        for (int j = 0; j < 4; ++j) { const float a = fmaxf(v0[j], 0.f), b = fmaxf(v1[j], 0.f); v0[j] = a * a; v1[j] = b * b; } }
                    u32x4 w; w.x = cvt_pk_bf16(v0[0], v0[1]); w.y = cvt_pk_bf16(v0[2], v0[3]); w.z = cvt_pk_bf16(v1[0], v1[1]); w.w = cvt_pk_bf16(v1[2], v1[3]);
                    *(u32x4*)(rowp + bj * HALF) = w; } }
    }
};
struct EpiRes {
    const bf16_t* X; bf16_t* R; int ldc; float alpha;
    __device__ __forceinline__ void operator()(const f32x4 (&acc)[2][2][4][2], const Unit& u, int wr, int wc, int fr, int fq) const {
        const int row0 = u.pm * BM + wr * 64 + fr; const int col0 = u.pn * BM + wc * 32 + 8 * fq;
#pragma unroll
        for (int ai = 0; ai < 2; ++ai)
#pragma unroll
            for (int m = 0; m < 4; ++m) { const size_t off = (size_t)(row0 + ai * HALF + m * 16) * ldc + col0;
#pragma unroll
                for (int bj = 0; bj < 2; ++bj) { const u32x4 xw = *(const u32x4*)(X + off + bj * HALF);
                    const f32x4 x0 = {bf_lo(xw.x), bf_hi(xw.x), bf_lo(xw.y), bf_hi(xw.y)}, x1 = {bf_lo(xw.z), bf_hi(xw.z), bf_lo(xw.w), bf_hi(xw.w)};
                    const f32x4 v0 = x0 * alpha + acc[ai][bj][m][0], v1 = x1 * alpha + acc[ai][bj][m][1];
                    u32x4 w; w.x = cvt_pk_bf16(v0[0], v0[1]); w.y = cvt_pk_bf16(v0[2], v0[3]); w.z = cvt_pk_bf16(v1[0], v1[1]); w.w = cvt_pk_bf16(v1[2], v1[3]);
                    *(u32x4*)(R + off + bj * HALF) = w; } }
    }
};

struct EpiQKV {
    bf16_t* O;
    __device__ __forceinline__ void operator()(const f32x4 (&acc)[2][2][4][2], const Unit& u, int wr, int wc, int fr, int fq) const {
        const int which = u.pn / 12, g = (u.pn % 12) >> 2, jp = u.pn & 3, dsh = 2 * g;
        const int m0 = u.pm * BM, b = m0 >> 11, tb = (m0 & 2047) + wr * 64 + fr;
        bf16_t* base = O + ((size_t)((which * 3 + g) * 8 + 2 * jp) * MTOK + (size_t)b * 2048) * 128 + wc * 32 + 8 * fq;
#pragma unroll
        for (int ai = 0; ai < 2; ++ai)
#pragma unroll
            for (int m = 0; m < 4; ++m) { const int t = tb + ai * HALF + m * 16; const int tp = ((t & ((1 << dsh) - 1)) << (11 - dsh)) + (t >> dsh);
                bf16_t* rowp = base + (size_t)tp * 128;
#pragma unroll
                for (int bj = 0; bj < 2; ++bj) { const f32x4 v0 = acc[ai][bj][m][0], v1 = acc[ai][bj][m][1];
                    u32x4 w; w.x = cvt_pk_bf16(v0[0], v0[1]); w.y = cvt_pk_bf16(v0[2], v0[3]); w.z = cvt_pk_bf16(v1[0], v1[1]); w.w = cvt_pk_bf16(v1[2], v1[3]);
                    *(u32x4*)(rowp + (size_t)bj * MTOK * 128) = w; } }
    }
};

template <class Epi, class Sched>
__device__ __forceinline__ void gemm_phase(LAS unsigned char* lds, const Gemm g, const Sched& S, const Epi& E, int wave_s) {
    const int tid = MYTID(wave_s), wid = wave_s, lane = tid & 63, wr = wid >> 2, wc = wid & 3, fr = lane & 15, fq = lane >> 4;
    const int K = g.K, nt = K / BK, lda = g.lda;
    unsigned voffA[2], voffB[2];
#pragma unroll
    for (int i = 0; i < 2; ++i) { int R, C; stage_rc(tid * 16 + i * 8192, R, C); const int Rb = (R & ~31) + perm32(R & 31);
        voffA[i] = (unsigned)(R * lda + C) * 2u; voffB[i] = (unsigned)(Rb * K + C) * 2u; }
    const size_t kstep = (size_t)(BK * 2);
    const size_t hstepA = (size_t)HALF * lda * 2, hstepB = (size_t)HALF * K * 2;
    const size_t tstepA = 2 * hstepA, tstepB = 2 * hstepB;
    const unsigned ldsw = (unsigned)wid * 1024u;
    const int aoff = lds_byte(wr * 64 + fr, fq * 8), boff = lds_byte(wc * 32 + fr, fq * 8);
#define PG8_SA(b, h) (((b) * 2 + (h)) * HTB)
#define PG8_SB(b, h) ((4 + (b) * 2 + (h)) * HTB)
#define PG8_STAGE(bufoff, gbase, voff) do { _Pragma("unroll") for (int _i = 0; _i < 2; ++_i) \
        __builtin_amdgcn_global_load_lds((const unsigned*)((const char*)(gbase) + (voff)[_i]), (LAS unsigned*)(lds + (bufoff) + ldsw + _i * 8192), 16, 0, 0); } while (0)
#define PG8_LDA(dst, b, h) do { _Pragma("unroll") for (int m = 0; m < 4; ++m) _Pragma("unroll") for (int k = 0; k < 2; ++k) dst[m][k] = *(const LAS bf16x8*)(lds + PG8_SA(b, h) + aoff + m * 2048 + k * 1024); } while (0)
#define PG8_LDB(dst, b, h) do { _Pragma("unroll") for (int n = 0; n < 2; ++n) _Pragma("unroll") for (int k = 0; k < 2; ++k) dst[n][k] = *(const LAS bf16x8*)(lds + PG8_SB(b, h) + boff + n * 2048 + k * 1024); } while (0)
#define PG8_MMA(ai, bj, At, Bt) do { __builtin_amdgcn_s_setprio(1); _Pragma("unroll") for (int m = 0; m < 4; ++m) _Pragma("unroll") for (int n = 0; n < 2; ++n) _Pragma("unroll") for (int k = 0; k < 2; ++k) \
        acc[ai][bj][m][n] = __builtin_amdgcn_mfma_f32_16x16x32_bf16(Bt[n][k], At[m][k], acc[ai][bj][m][n], 0, 0, 0); __builtin_amdgcn_s_setprio(0); } while (0)
#define PG8_WAIT_V(n) asm volatile("s_waitcnt vmcnt(" #n ")" ::: "memory")
#define PG8_WAIT_L(n) asm volatile("s_waitcnt lgkmcnt(" #n ")" ::: "memory")
#define PG8_BAR __builtin_amdgcn_s_barrier()
#define PG8_SCHED __builtin_amdgcn_sched_barrier(0)
#define PG8_AOFF(u) ((size_t)(((u).pn / g.agdiv) * g.agk) * 2)
    Unit cur, nxt; int ui = 0;
    if (!S.next(0, cur)) return;
    f32x4 acc[2][2][4][2];
#pragma unroll
    for (int a = 0; a < 2; ++a)
#pragma unroll
        for (int b = 0; b < 2; ++b)
#pragma unroll
            for (int m = 0; m < 4; ++m)
#pragma unroll
                for (int n = 0; n < 2; ++n) acc[a][b][m][n] = (f32x4){0.f, 0.f, 0.f, 0.f};
    bf16x8 At[4][2], B0[2][2], B1[2][2];
    const char* cA = (const char*)g.A + (size_t)cur.pm * tstepA + PG8_AOFF(cur); const char* cB = (const char*)g.Bt + (size_t)cur.pn * tstepB;
    PG8_STAGE(PG8_SB(0, 0), cB, voffB); PG8_STAGE(PG8_SB(0, 1), cB + hstepB, voffB); PG8_STAGE(PG8_SA(0, 0), cA, voffA); PG8_STAGE(PG8_SA(0, 1), cA + hstepA, voffA);
    if (wr == 1) PG8_BAR;
    PG8_WAIT_V(2); PG8_BAR;
    PG8_STAGE(PG8_SB(1, 0), cB + kstep, voffB); PG8_STAGE(PG8_SA(1, 0), cA + kstep, voffA); PG8_STAGE(PG8_SB(1, 1), cB + hstepB + kstep, voffB);
    PG8_WAIT_V(6); PG8_BAR;
    for (;;) {
        const bool has_next = S.next(ui + 1, nxt);
        const char* nA = has_next ? (const char*)g.A + (size_t)nxt.pm * tstepA + PG8_AOFF(nxt) : cA; const char* nB = has_next ? (const char*)g.Bt + (size_t)nxt.pn * tstepB : cB;
        for (int t = 0; t < nt; t += 2) {
            const bool last = (t == nt - 2);
            const char* a1 = cA + (size_t)(t + 1) * kstep;
            const char* a2 = last ? nA : cA + (size_t)(t + 2) * kstep; const char* b2 = last ? nB : cB + (size_t)(t + 2) * kstep;
            const char* a3 = a2 + kstep; const char* b3 = b2 + kstep;
            PG8_LDB(B0, 0, 0); PG8_LDB(B1, 0, 1); PG8_SCHED; PG8_LDA(At, 0, 0); PG8_STAGE(PG8_SA(1, 1), a1 + hstepA, voffA);
            PG8_WAIT_V(8); PG8_WAIT_L(0); PG8_BAR; PG8_MMA(0, 0, At, B0); PG8_MMA(0, 1, At, B1); PG8_BAR; PG8_SCHED;
            PG8_LDA(At, 0, 1); PG8_STAGE(PG8_SB(0, 0), b2, voffB); PG8_STAGE(PG8_SB(0, 1), b2 + hstepB, voffB); PG8_STAGE(PG8_SA(0, 0), a2, voffA);
            PG8_WAIT_V(8); PG8_WAIT_L(0); PG8_BAR; PG8_MMA(1, 0, At, B0); PG8_MMA(1, 1, At, B1); PG8_BAR; PG8_SCHED;
            PG8_LDB(B0, 1, 0); PG8_LDB(B1, 1, 1); PG8_SCHED; PG8_LDA(At, 1, 0); PG8_STAGE(PG8_SA(0, 1), a2 + hstepA, voffA);
            PG8_WAIT_V(8); PG8_WAIT_L(0); PG8_BAR; PG8_MMA(0, 0, At, B0); PG8_MMA(0, 1, At, B1); PG8_BAR; PG8_SCHED;
            PG8_LDA(At, 1, 1); PG8_STAGE(PG8_SB(1, 0), b3, voffB); PG8_STAGE(PG8_SB(1, 1), b3 + hstepB, voffB); PG8_STAGE(PG8_SA(1, 0), a3, voffA);
            PG8_WAIT_V(8); PG8_WAIT_L(0); PG8_BAR; PG8_MMA(1, 0, At, B0); PG8_MMA(1, 1, At, B1); PG8_BAR; PG8_SCHED;
        }
        if (wr == 0) PG8_BAR;
        E(acc, cur, wr, wc, fr, fq);
        if (!has_next) break;
#pragma unroll
        for (int a = 0; a < 2; ++a)
#pragma unroll
            for (int b = 0; b < 2; ++b)
#pragma unroll
                for (int m = 0; m < 4; ++m)
#pragma unroll
                    for (int n = 0; n < 2; ++n) acc[a][b][m][n] = (f32x4){0.f, 0.f, 0.f, 0.f};
        cur = nxt; cA = nA; cB = nB; ++ui;
        if (wr == 1) PG8_BAR;
    }
    PG8_WAIT_V(0);
    PG8_BAR;
#undef PG8_SA
#undef PG8_SB
#undef PG8_STAGE
#undef PG8_LDA
#undef PG8_LDB
#undef PG8_MMA
#undef PG8_WAIT_V
#undef PG8_WAIT_L
#undef PG8_BAR
#undef PG8_SCHED
#undef PG8_AOFF
}
}

constexpr int NWAVES = 8, NTHR = 512;
constexpr int ATT_KSTR = 272, ATT_VSTR = 288, ATT_K_OFF = 0, ATT_V_OFF = 256 * ATT_KSTR, ATT_BYTES = ATT_V_OFF + 272 * ATT_VSTR;
constexpr int MISC_OFF = ATT_BYTES;
constexpr int LDS_BYTES = 148480;
static_assert(ATT_BYTES <= LDS_BYTES && pg8::STAGE_BYTES <= LDS_BYTES, "LDS map");

struct Params {
    const float* x; const float* w_in; const float* w_group; const float* pool_scale; const float* w_out; const float* w_qkv; const float* w_ao;
    const float* w_up; const float* w_dn; const float* ln_mix_g; const float* ln_mix_b; const float* ln_mlp_g; const float* ln_mlp_b;
    float* out; unsigned char* ws;
};

__device__ __forceinline__ float wave_sum(float v) {
#pragma unroll
    for (int o = 1; o < 64; o <<= 1) v += __shfl_xor(v, o);
    return v;
}

__device__ __forceinline__ void p0_transpose_item(const float* W, int K, int N, bf16_t* WT, int row_off, LAS float* scr, int item, int lane) {
    const int nblk = N / 32, kb = item / nblk, nb = item % nblk, k0 = 64 * kb, n0 = 32 * nb;
#pragma unroll 8
    for (int i = 0; i < 32; ++i) { const int kk = 2 * i + (lane >> 5); scr[kk * 33 + (lane & 31)] = W[(size_t)(k0 + kk) * N + n0 + (lane & 31)]; }
    asm volatile("s_waitcnt lgkmcnt(0)" ::: "memory");
    const int c = lane & 7;
#pragma unroll
    for (int j = 0; j < 4; ++j) { const int n = (lane >> 3) + 8 * j; const LAS float* s = scr + (8 * c) * 33 + n;
        u32x4 o; o.x = pk2(s[0 * 33], s[1 * 33]); o.y = pk2(s[2 * 33], s[3 * 33]); o.z = pk2(s[4 * 33], s[5 * 33]); o.w = pk2(s[6 * 33], s[7 * 33]);
        *(u32x4*)(WT + (size_t)(row_off + n0 + n) * K + k0 + 8 * c) = o; }
    asm volatile("s_waitcnt lgkmcnt(0)" ::: "memory");
}

__device__ __forceinline__ void phase_prologue(const Params& p, LAS unsigned char* lds, int wave_s) {
    const int tid = MYTID(wave_s), lane = tid & 63, wave = wave_s;
    LAS float* scr = (LAS float*)(lds + wave * 16384);
    const int gw = blockIdx.x * NWAVES + wave, NGW = gridDim.x * NWAVES;
    unsigned char* ws = p.ws;
    constexpr int I_IN = (DM / 64) * (DM / 32), I_G = (512 / 64) * (512 / 32), I_OUT = I_IN, I_QKV = (DM / 64) * (QKVW / 32), I_AO = (GWID / 64) * (DM / 32),
                  I_UP = (DM / 64) * (FF / 32), I_DN = (FF / 64) * (DM / 32);
    constexpr int NITEMS = I_IN + 4 * I_G + I_OUT + I_QKV + I_AO + 2 * I_UP + 2 * I_DN;
    for (int it = gw; it < NITEMS; it += NGW) {
        int r = it;
        if (r < I_IN) { p0_transpose_item(p.w_in, DM, DM, (bf16_t*)(ws + WS_WIN), 0, scr, r, lane); continue; } r -= I_IN;
        if (r < 4 * I_G) { const int g = r / I_G; p0_transpose_item(p.w_group + (size_t)g * 512 * 512, 512, 512, (bf16_t*)(ws + WS_WG), g * 512, scr, r % I_G, lane); continue; } r -= 4 * I_G;
        if (r < I_OUT) { p0_transpose_item(p.w_out, DM, DM, (bf16_t*)(ws + WS_WOUT), 0, scr, r, lane); continue; } r -= I_OUT;
        if (r < I_QKV) { p0_transpose_item(p.w_qkv, DM, QKVW, (bf16_t*)(ws + WS_WQKV), 0, scr, r, lane); continue; } r -= I_QKV;
        if (r < I_AO) { p0_transpose_item(p.w_ao, GWID, DM, (bf16_t*)(ws + WS_WAO), 0, scr, r, lane); continue; } r -= I_AO;
        if (r < 2 * I_UP) { const int l = r / I_UP; p0_transpose_item(p.w_up + (size_t)l * DM * FF, DM, FF, (bf16_t*)(ws + (l ? WS_WUP1 : WS_WUP0)), 0, scr, r % I_UP, lane); continue; } r -= 2 * I_UP;
        { const int l = r / I_DN; p0_transpose_item(p.w_dn + (size_t)l * FF * DM, FF, DM, (bf16_t*)(ws + (l ? WS_WDN1 : WS_WDN0)), 0, scr, r % I_DN, lane); }
    }
    const size_t n8 = (size_t)MTOK * DM / 8; bf16_t* xa = (bf16_t*)(ws + WS_XA);
    for (size_t i = (size_t)blockIdx.x * NTHR + tid; i < n8; i += (size_t)gridDim.x * NTHR) {
        const f32x4 a = *(const f32x4*)(p.x + i * 8), b = *(const f32x4*)(p.x + i * 8 + 4);
        u32x4 o; o.x = pk2(a.x, a.y); o.y = pk2(a.z, a.w); o.z = pk2(b.x, b.y); o.w = pk2(b.z, b.w);
        *(u32x4*)(xa + i * 8) = o;
    }
}

__device__ __forceinline__ void phase_pool(const bf16_t* U, bf16_t* P, int wave_s) {
    const int tid = MYTID(wave_s);
    constexpr int TB = 32, NITEMS = (MTOK / TB) * (DM / 8);
    for (int id = blockIdx.x * NTHR + tid; id < NITEMS; id += gridDim.x * NTHR) {
        const int c8 = id & 255, tb = id >> 8, t0 = tb * TB, pos0 = t0 & (SEQ - 1), g = c8 >> 6, w = 2 << g;
        const bf16_t* up = U + (size_t)t0 * DM + c8 * 8; bf16_t* pp = P + (size_t)t0 * DM + c8 * 8;
        float s[8];
#pragma unroll
        for (int j = 0; j < 8; ++j) s[j] = 0.f;
        for (int k = 1; k <= w; ++k) { if (pos0 - k >= 0) { const u32x4 v = *(const u32x4*)(up - (ptrdiff_t)k * DM);
            s[0] += bf_lo(v.x); s[1] += bf_hi(v.x); s[2] += bf_lo(v.y); s[3] += bf_hi(v.y); s[4] += bf_lo(v.z); s[5] += bf_hi(v.z); s[6] += bf_lo(v.w); s[7] += bf_hi(v.w); } }
        for (int t = 0; t < TB; ++t) {
            const int pos = pos0 + t;
            const u32x4 v = *(const u32x4*)(up + (size_t)t * DM);
            float c[8] = {bf_lo(v.x), bf_hi(v.x), bf_lo(v.y), bf_hi(v.y), bf_lo(v.z), bf_hi(v.z), bf_lo(v.w), bf_hi(v.w)};
#pragma unroll
            for (int j = 0; j < 8; ++j) s[j] += c[j];
            if (pos >= w) { const u32x4 o = *(const u32x4*)(up + (ptrdiff_t)(t - w) * DM);
                s[0] -= bf_lo(o.x); s[1] -= bf_hi(o.x); s[2] -= bf_lo(o.y); s[3] -= bf_hi(o.y); s[4] -= bf_lo(o.z); s[5] -= bf_hi(o.z); s[6] -= bf_lo(o.w); s[7] -= bf_hi(o.w); }
            const float inv = 1.f / (float)(pos + 1 < w ? pos + 1 : w);
            u32x4 r; r.x = pk2(s[0] * inv - c[0], s[1] * inv - c[1]); r.y = pk2(s[2] * inv - c[2], s[3] * inv - c[3]);
            r.z = pk2(s[4] * inv - c[4], s[5] * inv - c[5]); r.w = pk2(s[6] * inv - c[6], s[7] * inv - c[7]);
            *(u32x4*)(pp + (size_t)t * DM) = r;
        }
    }
}

template <bool F32OUT>
__device__ __forceinline__ void phase_ln(const bf16_t* R, const float* gam, const float* bet, bf16_t* XO, float* FO, int wave_s) {
    const int lane = lane_id_opaque(), wave = wave_s;
    const int gw = blockIdx.x * NWAVES + wave, NGW = gridDim.x * NWAVES;
    for (int m0 = gw; m0 < MTOK; m0 += 2 * NGW) {
        const int m1 = m0 + NGW; const bool two = m1 < MTOK; const int m1c = two ? m1 : m0;
        u32x4 wa[4], wb[4];
#pragma unroll
        for (int j = 0; j < 4; ++j) { wa[j] = *((const u32x4*)(R + (size_t)m0 * DM) + lane + 64 * j); wb[j] = *((const u32x4*)(R + (size_t)m1c * DM) + lane + 64 * j); }
#pragma unroll
        for (int rr = 0; rr < 2; ++rr) {
            if (rr == 1 && !two) break;
            const int m = rr ? m1 : m0;
            float v[4][8]; float s = 0.f;
#pragma unroll
            for (int j = 0; j < 4; ++j) { const u32x4 w = rr ? wb[j] : wa[j];
                v[j][0] = bf_lo(w.x); v[j][1] = bf_hi(w.x); v[j][2] = bf_lo(w.y); v[j][3] = bf_hi(w.y); v[j][4] = bf_lo(w.z); v[j][5] = bf_hi(w.z); v[j][6] = bf_lo(w.w); v[j][7] = bf_hi(w.w);
#pragma unroll
                for (int e = 0; e < 8; ++e) s += v[j][e]; }
            const float mean = wave_sum(s) * (1.f / DM); float s2 = 0.f;
#pragma unroll
            for (int j = 0; j < 4; ++j)
#pragma unroll
                for (int e = 0; e < 8; ++e) { v[j][e] -= mean; s2 += v[j][e] * v[j][e]; }
            const float rstd = 1.f / sqrtf(wave_sum(s2) * (1.f / DM) + LN_EPS);
#pragma unroll
            for (int j = 0; j < 4; ++j) {
                const int c0 = (lane + 64 * j) * 8;
                const f32x4 g0 = *(const f32x4*)(gam + c0), g1 = *(const f32x4*)(gam + c0 + 4), b0 = *(const f32x4*)(bet + c0), b1 = *(const f32x4*)(bet + c0 + 4);
                const f32x4 y0 = (f32x4){v[j][0], v[j][1], v[j][2], v[j][3]} * rstd * g0 + b0, y1 = (f32x4){v[j][4], v[j][5], v[j][6], v[j][7]} * rstd * g1 + b1;
                if (F32OUT) { *(f32x4*)(FO + (size_t)m * DM + c0) = y0; *(f32x4*)(FO + (size_t)m * DM + c0 + 4) = y1; }
                else { u32x4 o; o.x = pk2(y0.x, y0.y); o.y = pk2(y0.z, y0.w); o.z = pk2(y1.x, y1.y); o.w = pk2(y1.z, y1.w); *((u32x4*)(XO + (size_t)m * DM) + lane + 64 * j) = o; }
            }
        }
    }
}

__device__ __forceinline__ s16x4 vtr(const LAS unsigned char* p) { return __builtin_bit_cast(s16x4, __builtin_amdgcn_ds_read_tr16_b64_v4i16((LAS s16x4*)p)); }

struct AttnId { int g, b, r, qb, j, ldprev; };
__device__ __forceinline__ AttnId attn_decode(int pass, int c, int i) {
    AttnId a; a.ldprev = 0;
    if (pass == 0) {
        if (i < 8) { a.g = 0; a.j = c & 7; a.b = (c >> 3) & 15; const int half = c >> 7; a.r = 0; a.qb = half * 8 + i; a.ldprev = (half == 1 && i == 0) ? 1 : 0; }
        else { const int ch = 2 * c + ((i - 8) >> 2); a.g = 1; a.j = ch & 7; a.r = (ch >> 3) & 3; a.b = ch >> 5; a.qb = (i - 8) & 3; }
    } else { const int id = 8 * c + i; a.g = 2; a.j = id & 7; a.r = (id >> 3) & 15; a.b = id >> 7; a.qb = 0; }
    return a;
}
__device__ __forceinline__ void attn_fetch(const bf16_t* qkv, const AttnId& a, int blk, u32x4 (&kv)[4], u32x4 (&vv)[4], int tid) {
    const int dsh = 2 * a.g;
    const size_t row0 = (size_t)a.b * SEQ + (size_t)a.r * (SEQ >> dsh) + (size_t)blk * 128;
    const int chunk = tid & 15, rb = tid >> 4;
    const bf16_t* kbase = qkv + ((size_t)((3 + a.g) * 8 + a.j) * MTOK + row0) * HD + chunk * 8;
    const bf16_t* vbase = kbase + (size_t)24 * MTOK * HD;
#pragma unroll
    for (int it = 0; it < 4; ++it) { const size_t ro = (size_t)(it * 32 + rb) * HD; kv[it] = *(const u32x4*)(kbase + ro); vv[it] = *(const u32x4*)(vbase + ro); }
}
__device__ __forceinline__ void attn_fetch_q(const bf16_t* qkv, const AttnId& a, bf16x8 (&qf)[4], int w, int fr, int fq) {
    const int dsh = 2 * a.g;
    const size_t row = (size_t)a.b * SEQ + (size_t)a.r * (SEQ >> dsh) + (size_t)(a.qb * 128 + 16 * w + fr);
    const bf16_t* qb = qkv + ((size_t)(a.g * 8 + a.j) * MTOK + row) * HD + 8 * fq;
#pragma unroll
    for (int kk = 0; kk < 4; ++kk) qf[kk] = *(const bf16x8*)(qb + 32 * kk);
}
__device__ __forceinline__ void attn_put(LAS unsigned char* lds, int half, const u32x4 (&kv)[4], const u32x4 (&vv)[4], int tid) {
    const int chunk = tid & 15, rb = tid >> 4;
#pragma unroll
    for (int it = 0; it < 4; ++it) { const int row = half * 128 + it * 32 + rb;
        *(LAS u32x4*)(lds + ATT_K_OFF + row * ATT_KSTR + chunk * 16) = kv[it]; *(LAS u32x4*)(lds + ATT_V_OFF + row * ATT_VSTR + chunk * 16) = vv[it]; }
}
__device__ __forceinline__ int attn_trow(int T, int ch) { return T >= 16 ? 256 : ((((T >> 3) ^ 1) ^ ch) << 7) + ((T & 7) << 4); }

__device__ __forceinline__ void attn_scores(LAS unsigned char* lds, int ch, bool has_prev, const bf16x8 (&qf)[4], f32x4 (&s)[9], int w, int fr, int fq) {
    LAS unsigned char* Kl = lds + ATT_K_OFF;
#pragma unroll
    for (int tt = 0; tt < 9; ++tt) { s[tt] = (f32x4){0.f, 0.f, 0.f, 0.f}; const int rowb = attn_trow(w + tt, ch);
        if (!has_prev && w + tt < 8) continue;
#pragma unroll
        for (int kk = 0; kk < 4; ++kk) { const bf16x8 av = *(const LAS bf16x8*)(Kl + (rowb + fr) * ATT_KSTR + (32 * kk + 8 * fq) * 2);
            s[tt] = __builtin_amdgcn_mfma_f32_16x16x32_bf16(av, qf[kk], s[tt], 0, 0, 0); } }
}
__device__ __forceinline__ void attn_finish(LAS unsigned char* lds, int ch, const AttnId& a, f32x4 (&s)[9], bf16_t* obuf, float* lsebuf, bf16_t* merged, int w, int fr, int fq) {
    const int g = a.g, j = a.j, qb = a.qb;
    const int dsh = (g == 0) ? 0 : (g == 1 ? 2 : 4), d = 1 << dsh;
    const size_t qrow = (size_t)a.b * SEQ + (size_t)((qb * 128 + 16 * w + fr) << dsh) + a.r;
    LAS unsigned char* Vl = lds + ATT_V_OFF;
    constexpr float LOG2E = 1.4426950408889634f;
    const float sc = 0.08838834764831845f * LOG2E;
    const float slope = exp2f(-8.0f * (float)(g * NSLOT + j + 1) / 24.0f);
    const float sl = slope * (float)d * LOG2E;
    float mx = -INFINITY;
    const float fb = (float)(128 + fr - 4 * fq);
#pragma unroll
    for (int tt = 0; tt < 9; ++tt) {
        const bool tile_ok = (qb > 0) || (w + tt >= 8);
#pragma unroll
        for (int jj = 0; jj < 4; ++jj) {
            const float dist = fb - (float)(16 * tt + jj);
            bool valid = tile_ok;
            if (tt == 0) valid = valid && (dist <= 128.f);
            if (tt == 8) valid = valid && (dist >= 0.f);
            const float v = valid ? (s[tt][jj] * sc - sl * dist) : -INFINITY;
            s[tt][jj] = v; mx = fmaxf(mx, v);
        }
    }
    mx = fmaxf(mx, __shfl_xor(mx, 16)); mx = fmaxf(mx, __shfl_xor(mx, 32));
    float sum = 0.f;
#pragma unroll
    for (int tt = 0; tt < 9; ++tt)
#pragma unroll
        for (int jj = 0; jj < 4; ++jj) { const float e = __builtin_amdgcn_exp2f(s[tt][jj] - mx); s[tt][jj] = e; sum += e; }
    sum += __shfl_xor(sum, 16); sum += __shfl_xor(sum, 32);
    bf16x8 pf[5];
#pragma unroll
    for (int c = 0; c < 5; ++c) {
        u32x4 pw; pw.x = pk2(s[2 * c][0], s[2 * c][1]); pw.y = pk2(s[2 * c][2], s[2 * c][3]);
        if (c < 4) { pw.z = pk2(s[2 * c + 1][0], s[2 * c + 1][1]); pw.w = pk2(s[2 * c + 1][2], s[2 * c + 1][3]); } else { pw.z = 0u; pw.w = 0u; }
        pf[c] = __builtin_bit_cast(bf16x8, pw);
    }
    u32x2 m0[8]; float l0 = 0.f, l1 = 0.f;
    const bf16_t* o0p = obuf + qrow * GWID + j * HD + 4 * fq;
    if (g == 2) { l0 = lsebuf[qrow * NSLOT + j]; l1 = lsebuf[((size_t)MTOK + qrow) * NSLOT + j];
#pragma unroll
        for (int dt = 0; dt < 8; ++dt) m0[dt] = *(const u32x2*)(o0p + 16 * dt); }
    else {
#pragma unroll
        for (int dt = 0; dt < 8; ++dt) m0[dt] = (u32x2){0u, 0u}; }
    f32x4 o[8];
#pragma unroll
    for (int dt = 0; dt < 8; ++dt) o[dt] = (f32x4){0.f, 0.f, 0.f, 0.f};
    const int lofs = (4 * fq + (fr >> 2)) * ATT_VSTR + (4 * (fr & 3)) * 2;
#pragma unroll
    for (int c = 0; c < 5; ++c) {
        __builtin_amdgcn_sched_barrier(0);
        if (qb == 0 && w + 2 * c + 1 < 8) continue;
        const LAS unsigned char* v0 = Vl + attn_trow(w + 2 * c, ch) * ATT_VSTR + lofs; const LAS unsigned char* v1 = Vl + attn_trow(w + 2 * c + 1, ch) * ATT_VSTR + lofs;
#pragma unroll
        for (int dt = 0; dt < 8; ++dt) {
            const s16x4 lo = vtr(v0 + dt * 32), hi = vtr(v1 + dt * 32);
            const bf16x8 av = {lo[0], lo[1], lo[2], lo[3], hi[0], hi[1], hi[2], hi[3]};
            o[dt] = __builtin_amdgcn_mfma_f32_16x16x32_bf16(av, pf[c], o[dt], 0, 0, 0);
        }
    }
    const float inv = 1.f / sum;
    const float lse = (mx + log2f(sum)) * 0.6931471805599453f;
    if (g < 2) {
        bf16_t* orow = obuf + ((size_t)g * MTOK + qrow) * GWID + j * HD + 4 * fq;
#pragma unroll
        for (int dt = 0; dt < 8; ++dt) { u32x2 ow; ow.x = pk2(o[dt][0] * inv, o[dt][1] * inv); ow.y = pk2(o[dt][2] * inv, o[dt][3] * inv); *(u32x2*)(orow + 16 * dt) = ow; }
        if (fq == 0) lsebuf[((size_t)g * MTOK + qrow) * NSLOT + j] = lse;
    } else {
        const float lm = fmaxf(lse, fmaxf(l0, l1));
        float e0 = __expf(l0 - lm), e1 = __expf(l1 - lm), e2 = __expf(lse - lm); const float wi = 1.f / (e0 + e1 + e2); e0 *= wi; e1 *= wi; e2 *= wi * inv;
        bf16_t* mrow = merged + qrow * GWID + j * HD + 4 * fq;
#pragma unroll
        for (int dt = 0; dt < 8; ++dt) { const u32x2 a0 = m0[dt], a1 = *(const u32x2*)(o0p + (size_t)MTOK * GWID + 16 * dt);
            u32x2 ow; ow.x = pk2(e0 * bf_lo(a0.x) + e1 * bf_lo(a1.x) + e2 * o[dt][0], e0 * bf_hi(a0.x) + e1 * bf_hi(a1.x) + e2 * o[dt][1]);
            ow.y = pk2(e0 * bf_lo(a0.y) + e1 * bf_lo(a1.y) + e2 * o[dt][2], e0 * bf_hi(a0.y) + e1 * bf_hi(a1.y) + e2 * o[dt][3]);
            *(u32x2*)(mrow + 16 * dt) = ow; }
    }
}

#define ATT_LBAR() do { asm volatile("s_waitcnt lgkmcnt(0)" ::: "memory"); __builtin_amdgcn_s_barrier(); asm volatile("" ::: "memory"); } while (0)
__device__ __forceinline__ void phase_attn(LAS unsigned char* lds, const bf16_t* qkv, bf16_t* obuf, float* lsebuf, bf16_t* merged, int pass, int wave_s) {
    const int tid = MYTID(wave_s), lane = tid & 63, w = wave_s, fr = lane & 15, fq = lane >> 4;
    const int c = blockIdx.x, n = pass == 0 ? 16 : 8;
    for (int i = tid; i < ATT_BYTES / 16; i += NTHR) ((LAS u32x4*)lds)[i] = (u32x4){0u, 0u, 0u, 0u};
    ATT_LBAR();
    u32x4 kv[4], vv[4]; bf16x8 qn[4];
    AttnId cur = attn_decode(pass, c, 0);
    attn_fetch(qkv, cur, cur.qb, kv, vv, tid); attn_fetch_q(qkv, cur, qn, w, fr, fq);
    for (int i = 0; i < n; ++i) {
        const int ch = cur.qb & 1;
        attn_put(lds, ch, kv, vv, tid);
        if (cur.ldprev) { attn_fetch(qkv, cur, cur.qb - 1, kv, vv, tid); attn_put(lds, ch ^ 1, kv, vv, tid); }
        ATT_LBAR();
        f32x4 sacc[9];
        attn_scores(lds, ch, cur.qb > 0, qn, sacc, w, fr, fq);
        __builtin_amdgcn_sched_barrier(0);
        AttnId nxt = cur;
        if (i + 1 < n) { nxt = attn_decode(pass, c, i + 1); attn_fetch(qkv, nxt, nxt.qb, kv, vv, tid); attn_fetch_q(qkv, nxt, qn, w, fr, fq); }
        attn_finish(lds, ch, cur, sacc, obuf, lsebuf, merged, w, fr, fq);
        ATT_LBAR();
        cur = nxt;
    }
}

#define XB_TMO      128
#define XB_XCNT(j)  (256  + 64 * (j))
#define XB_XSUB(j)  (1280 + 64 * (j))
#define XB_XGEN(j)  (2304 + 64 * (j))
#define XB_TOP      3328
#define XB_TOPGEN   3392
#define XCD_BAR_WORDS 3456
#define XB_SPIN_CAP (1u << 22)
__device__ __forceinline__ unsigned xb_ld(unsigned* p)              { return __hip_atomic_load(p, __ATOMIC_RELAXED, __HIP_MEMORY_SCOPE_AGENT); }
__device__ __forceinline__ unsigned xb_add(unsigned* p, unsigned v) { return __hip_atomic_fetch_add(p, v, __ATOMIC_RELAXED, __HIP_MEMORY_SCOPE_AGENT); }
__device__ __forceinline__ unsigned xb_xcc_id() { return (unsigned)__builtin_amdgcn_s_getreg((3 << 11) | 20) & 0xFu; }
#define XB_SPIN(cond, bar) do { unsigned _sp = 0; while (cond) { __builtin_amdgcn_s_sleep(1); \
    if ((++_sp & 255u) == 0u) { if (xb_ld(&(bar)[XB_TMO])) break; if (_sp > XB_SPIN_CAP) { atomicAdd(&(bar)[XB_TMO], 1u); break; } } } } while (0)
struct XcdBarrier { unsigned* bar; unsigned x; volatile LAS unsigned* st; };
__device__ __forceinline__ XcdBarrier xcd_barrier_post(unsigned* bar, volatile LAS unsigned* st, int wave_s) {
    XcdBarrier b; b.bar = bar; b.x = xb_xcc_id(); b.st = st;
    if (MYTID(wave_s) == 0) (void)xb_add(&bar[XB_XCNT(b.x)], 1u);
    return b;
}
__device__ __forceinline__ void xcd_barrier_complete(unsigned* bar, unsigned x, unsigned& nloc, unsigned& nx) {
    const unsigned G = gridDim.x * gridDim.y * gridDim.z;
    unsigned sum, cnt, mine, sp = 0u;
    for (;;) {
        sum = 0u; cnt = 0u; mine = 0u;
#pragma unroll
        for (unsigned j = 0; j < 16; ++j) { const unsigned c = xb_ld(&bar[XB_XCNT(j)]); sum += c; cnt += (c > 0u) ? 1u : 0u; mine = (j == x) ? c : mine; }
        if (sum == G) break;
        __builtin_amdgcn_s_sleep(1);
        if ((++sp & 255u) == 0u) { if (xb_ld(&bar[XB_TMO])) break; if (sp > XB_SPIN_CAP) { atomicAdd(&bar[XB_TMO], 1u); break; } }
    }
    nloc = mine > 0u ? mine : 1u; nx = cnt > 0u ? cnt : 1u;
}
__device__ __forceinline__ void xcd_barrier(const XcdBarrier& b, int wave_s) {
    asm volatile("s_waitcnt vmcnt(0)" ::: "memory");
    __syncthreads();
    if (MYTID(wave_s) == 0) {
        unsigned* bar = b.bar;
        __builtin_amdgcn_s_waitcnt(0);
        unsigned nloc = b.st[0], nx = b.st[1];
        if (nloc == 0u) { xcd_barrier_complete(bar, b.x, nloc, nx); b.st[0] = nloc; b.st[1] = nx; }
        const unsigned old = xb_add(&bar[XB_XSUB(b.x)], 1u);
        const unsigned gen = old / nloc;
        if (old + 1u == (gen + 1u) * nloc) {
            __builtin_amdgcn_fence(__ATOMIC_RELEASE, "agent");
            asm volatile("s_waitcnt vmcnt(0)" ::: "memory");
            const unsigned og = xb_add(&bar[XB_TOP], 1u);
            const unsigned tg = og / nx;
            if (og + 1u == (tg + 1u) * nx) xb_add(&bar[XB_TOPGEN], 1u);
            else XB_SPIN(xb_ld(&bar[XB_TOPGEN]) == tg, bar);
            __builtin_amdgcn_fence(__ATOMIC_ACQUIRE, "agent");
            xb_add(&bar[XB_XGEN(b.x)], 1u);
            asm volatile("s_waitcnt vmcnt(0)" ::: "memory");
        } else {
            XB_SPIN(xb_ld(&bar[XB_XGEN(b.x)]) == gen, bar);
            __builtin_amdgcn_fence(__ATOMIC_ACQUIRE, "agent");
            asm volatile("s_waitcnt vmcnt(0)" ::: "memory");
        }
    }
    __syncthreads();
}

__global__ void __launch_bounds__(NTHR, 2) fwd_megakernel(Params p) {
    extern __shared__ __attribute__((aligned(16))) unsigned char lds_raw[];
    LAS unsigned char* lds = (LAS unsigned char*)lds_raw;
    cg::grid_group grid = cg::this_grid();
    unsigned char* ws = p.ws;
    bf16_t* XA = (bf16_t*)(ws + WS_XA); bf16_t* XB = (bf16_t*)(ws + WS_XB);
    bf16_t* BIG = (bf16_t*)(ws + WS_BIG);
    bf16_t* U = BIG; bf16_t* PB = BIG + (size_t)MTOK * DM; bf16_t* Y = BIG + 2 * (size_t)MTOK * DM;
    bf16_t* R = (bf16_t*)p.out;
    volatile LAS unsigned* MISC = (volatile LAS unsigned*)(lds + MISC_OFF);
    unsigned* barw = (unsigned*)ws;
    const int G = gridDim.x, c = blockIdx.x;
    constexpr int NOG = 1 << 30;

    const int wave_s = __builtin_amdgcn_readfirstlane((int)threadIdx.x >> 6);
    { const int t0 = MYTID(wave_s); if (blockIdx.x == 0) for (int i = t0; i < XCD_BAR_WORDS; i += NTHR) barw[i] = 0u;
      if (t0 < 2) MISC[t0] = 0u; }
    phase_prologue(p, lds, wave_s);
    grid.sync();
    const XcdBarrier xbar = xcd_barrier_post(barw, MISC, wave_s);
    {
        pg8::Gemm g{XA, (const bf16_t*)(ws + WS_WIN), MTOK, DM, DM, DM, NOG, 0}; pg8::StaticOrder S; S.init(MTOK, DM, G, c);
        pg8::EpiBf16<0, false> E{U, DM, nullptr};
        pg8::gemm_phase(lds, g, S, E, wave_s);
    }
    xcd_barrier(xbar, wave_s);
    phase_pool(U, PB, wave_s);
    xcd_barrier(xbar, wave_s);
    {
        pg8::Gemm g{PB, (const bf16_t*)(ws + WS_WG), MTOK, DM, 512, DM, 2, 512}; pg8::StaticOrder S; S.init(MTOK, DM, G, c);
        pg8::EpiBf16<0, true> E{Y, DM, p.pool_scale};
        pg8::gemm_phase(lds, g, S, E, wave_s);
    }
    xcd_barrier(xbar, wave_s);
    {
        pg8::Gemm g{Y, (const bf16_t*)(ws + WS_WOUT), MTOK, DM, DM, DM, NOG, 0}; pg8::StaticOrder S; S.init(MTOK, DM, G, c);
        pg8::EpiRes E{XA, R, DM, ALPHA};
        pg8::gemm_phase(lds, g, S, E, wave_s);
    }
    xcd_barrier(xbar, wave_s);
    phase_ln<false>(R, p.ln_mix_g, p.ln_mix_b, XB, nullptr, wave_s);
    xcd_barrier(xbar, wave_s);
    {
        pg8::Gemm g{XB, (const bf16_t*)(ws + WS_WUP0), MTOK, FF, DM, DM, NOG, 0}; pg8::StaticOrder S; S.init(MTOK, FF, G, c);
        pg8::EpiBf16<1, false> E{BIG, FF, nullptr};
        pg8::gemm_phase(lds, g, S, E, wave_s);
    }
    xcd_barrier(xbar, wave_s);
    {
        pg8::Gemm g{BIG, (const bf16_t*)(ws + WS_WDN0), MTOK, DM, FF, FF, NOG, 0}; pg8::StaticOrder S; S.init(MTOK, DM, G, c);
        pg8::EpiRes E{XB, R, DM, ALPHA};
        pg8::gemm_phase(lds, g, S, E, wave_s);
    }
    xcd_barrier(xbar, wave_s);
    phase_ln<false>(R, p.ln_mlp_g, p.ln_mlp_b, XA, nullptr, wave_s);
    xcd_barrier(xbar, wave_s);
    {
        pg8::Gemm g{XA, (const bf16_t*)(ws + WS_WQKV), MTOK, QKVW, DM, DM, NOG, 0}; pg8::StaticOrder S; S.init(MTOK, QKVW, G, c);
        pg8::EpiQKV E{BIG};
        pg8::gemm_phase(lds, g, S, E, wave_s);
    }
    xcd_barrier(xbar, wave_s);
    phase_attn(lds, BIG, (bf16_t*)p.out, (float*)(ws + WS_LSE), XB, 0, wave_s);
    xcd_barrier(xbar, wave_s);
    phase_attn(lds, BIG, (bf16_t*)p.out, (float*)(ws + WS_LSE), XB, 1, wave_s);
    xcd_barrier(xbar, wave_s);
    {
        pg8::Gemm g{XB, (const bf16_t*)(ws + WS_WAO), MTOK, DM, GWID, GWID, NOG, 0}; pg8::StaticOrder S; S.init(MTOK, DM, G, c);
        pg8::EpiRes E{XA, R, DM, ALPHA};
        pg8::gemm_phase(lds, g, S, E, wave_s);
    }
    xcd_barrier(xbar, wave_s);
    phase_ln<false>(R, p.ln_mix_g + DM, p.ln_mix_b + DM, XB, nullptr, wave_s);
    xcd_barrier(xbar, wave_s);
    {
        pg8::Gemm g{XB, (const bf16_t*)(ws + WS_WUP1), MTOK, FF, DM, DM, NOG, 0}; pg8::StaticOrder S; S.init(MTOK, FF, G, c);
        pg8::EpiBf16<1, false> E{BIG, FF, nullptr};
        pg8::gemm_phase(lds, g, S, E, wave_s);
    }
    xcd_barrier(xbar, wave_s);
    {
        pg8::Gemm g{BIG, (const bf16_t*)(ws + WS_WDN1), MTOK, DM, FF, FF, NOG, 0}; pg8::StaticOrder S; S.init(MTOK, DM, G, c);
        pg8::EpiRes E{XB, XA, DM, ALPHA};
        pg8::gemm_phase(lds, g, S, E, wave_s);
    }
    xcd_barrier(xbar, wave_s);
    phase_ln<true>(XA, p.ln_mlp_g + DM, p.ln_mlp_b + DM, nullptr, p.out, wave_s);
}

extern "C" void kernel_launch(void* const* d_in, const int* in_sizes, int n_in, void* d_out, int out_size, void* d_ws, size_t ws_size, hipStream_t stream) {
    static int grid = 0;
    if (grid == 0) {
        if (n_in != 13 || in_sizes[0] != MTOK * DM || out_size != MTOK * DM || ws_size < WS_END) {
            fprintf(stderr, "kernel_launch: unexpected shapes: n_in %d in0 %d out %d ws %zu (need %zu); nothing launched\n", n_in, n_in > 0 ? in_sizes[0] : -1, out_size, ws_size, (size_t)WS_END); grid = -1; return; }
        int dev = 0, cus = 0, per_cu = 0;
        hipGetDevice(&dev);
        hipDeviceGetAttribute(&cus, hipDeviceAttributeMultiprocessorCount, dev);
        if (hipFuncSetAttribute((const void*)fwd_megakernel, hipFuncAttributeMaxDynamicSharedMemorySize, LDS_BYTES) != hipSuccess) { fprintf(stderr, "kernel_launch: hipFuncSetAttribute failed\n"); grid = -1; return; }
        if (hipOccupancyMaxActiveBlocksPerMultiprocessor(&per_cu, (const void*)fwd_megakernel, NTHR, LDS_BYTES) != hipSuccess || per_cu < 1) { fprintf(stderr, "kernel_launch: occupancy query gave %d\n", per_cu); per_cu = 1; }
        (void)hipGetLastError();
        grid = cus * per_cu;
        if (grid != 256) { fprintf(stderr, "kernel_launch: this kernel needs exactly 256 co-resident workgroups, got %d\n", grid); if (grid > 256) grid = 256; }
        fprintf(stderr, "kernel_launch: grid %d (cus %d x %d)\n", grid, cus, per_cu);
    }
    if (grid < 0) return;
    Params p{};
    p.x = (const float*)d_in[0]; p.w_in = (const float*)d_in[1]; p.w_group = (const float*)d_in[2]; p.pool_scale = (const float*)d_in[3]; p.w_out = (const float*)d_in[4];
    p.w_qkv = (const float*)d_in[5]; p.w_ao = (const float*)d_in[6]; p.w_up = (const float*)d_in[7]; p.w_dn = (const float*)d_in[8];
    p.ln_mix_g = (const float*)d_in[9]; p.ln_mix_b = (const float*)d_in[10]; p.ln_mlp_g = (const float*)d_in[11]; p.ln_mlp_b = (const float*)d_in[12];
    p.out = (float*)d_out; p.ws = (unsigned char*)d_ws;
    void* args[] = {&p};
    hipError_t e = hipLaunchCooperativeKernel((const void*)fwd_megakernel, dim3(grid), dim3(NTHR), args, LDS_BYTES, stream);
    if (e != hipSuccess) fprintf(stderr, "kernel_launch: cooperative launch failed: %s (grid %d)\n", hipGetErrorString(e), grid);
}
```

```cpp
#include <hip/hip_runtime.h>
#include <hip/hip_cooperative_groups.h>
#include <cstdio>
#include <cstdint>
namespace cg = cooperative_groups;

#define LAS __attribute__((address_space(3)))
typedef unsigned short bf16_t;
typedef short bf16x8 __attribute__((ext_vector_type(8)));
typedef short s16x4 __attribute__((ext_vector_type(4)));
typedef float f32x4 __attribute__((ext_vector_type(4)));
typedef float f32x2 __attribute__((ext_vector_type(2)));
typedef unsigned u32x4 __attribute__((ext_vector_type(4)));
typedef unsigned u32x2 __attribute__((ext_vector_type(2)));

constexpr int DM = 2048, BATCH = 16, SEQ = 2048, MTOK = BATCH * SEQ, FF = 8192, QKVW = 9216, GWID = 1024, HD = 128, NSLOT = 8;
constexpr float LN_EPS = 1e-5f;
constexpr float ALPHA = 1.4142135623730951f;
constexpr size_t MiB = 1u << 20;
constexpr size_t WS_WIN = 1 * MiB, WS_WG = 9 * MiB, WS_WOUT = 11 * MiB, WS_WQKV = 19 * MiB, WS_WAO = 55 * MiB, WS_WUP0 = 59 * MiB, WS_WUP1 = 91 * MiB,
                 WS_WDN0 = 123 * MiB, WS_WDN1 = 155 * MiB, WS_LSE = 188 * MiB, WS_XA = 192 * MiB, WS_XB = 320 * MiB, WS_BIG = 448 * MiB, WS_END = 1024 * MiB;

__device__ __forceinline__ unsigned f2bf(float f) { unsigned u = __builtin_bit_cast(unsigned, f); return (u + 0x7fffu + ((u >> 16) & 1u)) >> 16; }
typedef __bf16 bf16x2_t __attribute__((ext_vector_type(2)));
__device__ __forceinline__ unsigned pk2(float lo, float hi) { const f32x2 v = {lo, hi}; const bf16x2_t b = __builtin_convertvector(v, bf16x2_t); return __builtin_bit_cast(unsigned, b); }
__device__ __forceinline__ float bf_lo(unsigned w) { return __builtin_bit_cast(float, w << 16); }
__device__ __forceinline__ float bf_hi(unsigned w) { return __builtin_bit_cast(float, w & 0xffff0000u); }

__device__ __forceinline__ int lane_id_opaque() { int l; asm volatile("v_mbcnt_lo_u32_b32 %0, -1, 0\n\tv_mbcnt_hi_u32_b32 %0, -1, %0" : "=v"(l)); return l; }
#define MYTID(wave_s) ((wave_s) * 64 + lane_id_opaque())
namespace pg8 {
constexpr int BM = 256, BK = 64, HALF = 128, HTB = HALF * BK * 2, STAGE_BYTES = 8 * HTB, NXCD = 8, WGM = 8;
__host__ __device__ __forceinline__ int lds_byte(int r, int c) { const int st = (r >> 4) * 2 + (c >> 5), rr = r & 15, cc = c & 31, ob = rr * 64 + cc * 2; return st * 1024 + (ob ^ (((ob >> 9) & 1) << 5)); }
__host__ __device__ __forceinline__ void stage_rc(int b, int& R, int& C) { const int st = b / 1024, sb = b % 1024, swz = sb ^ (((sb >> 9) & 1) << 5); R = (st >> 1) * 16 + swz / 64; C = (st & 1) * 32 + (swz % 64) / 2; }
__host__ __device__ __forceinline__ int perm32(int rho) { const int n = rho >> 4, i = rho & 15; return 8 * (i >> 2) + 4 * n + (i & 3); }

struct Unit { int pm, pn; };
struct Gemm { const bf16_t* A; const bf16_t* Bt; int M, N, K, lda, agdiv, agk; };

struct StaticOrder {
    int nM, nN, nwg, G, c, wgm;
    __host__ __device__ void init(int M, int N, int G_, int c_) { nM = M / BM; nN = N / BM; nwg = nM * nN; G = G_; c = c_; wgm = 4; }
    __host__ __device__ bool next(int i, Unit& u) const {
        const long L = (long)i * G + c; if (L >= nwg) return false;
        int wgid = (int)L; { const int q = nwg / NXCD, r = nwg % NXCD, xcd = wgid % NXCD, off = wgid / NXCD; wgid = (xcd < r ? xcd * (q + 1) : r * (q + 1) + (xcd - r) * q) + off; }
        const int nig = wgm * nN, gid = wgid / nig, fm = gid * wgm, gsz = (nM - fm) < wgm ? (nM - fm) : wgm;
        u.pm = fm + ((wgid % nig) % gsz); u.pn = (wgid % nig) / gsz; return true;
    }
};

__device__ __forceinline__ unsigned cvt_pk_bf16(float lo, float hi) { unsigned r; asm volatile("v_cvt_pk_bf16_f32 %0, %1, %2" : "=v"(r) : "v"(lo), "v"(hi)); return r; }

template <int ACT, bool SCALE> struct EpiBf16 {
    bf16_t* O; int ldc; const float* colscale;
    __device__ __forceinline__ void operator()(const f32x4 (&acc)[2][2][4][2], const Unit& u, int wr, int wc, int fr, int fq) const {
        const int row0 = u.pm * BM + wr * 64 + fr; const int col0 = u.pn * BM + wc * 32 + 8 * fq;
        f32x4 cs[2][2];
#pragma unroll
        for (int bj = 0; bj < 2; ++bj)
#pragma unroll
            for (int n = 0; n < 2; ++n) cs[bj][n] = SCALE ? *(const f32x4*)(colscale + col0 + bj * HALF + 4 * n) : (f32x4){1.f, 1.f, 1.f, 1.f};
#pragma unroll
        for (int ai = 0; ai < 2; ++ai)
#pragma unroll
            for (int m = 0; m < 4; ++m) { bf16_t* rowp = O + (size_t)(row0 + ai * HALF + m * 16) * ldc + col0;
#pragma unroll
                for (int bj = 0; bj < 2; ++bj) { f32x4 v0 = acc[ai][bj][m][0], v1 = acc[ai][bj][m][1];
                    if (SCALE) { v0 = v0 * cs[bj][0]; v1 = v1 * cs[bj][1]; }
                    if (ACT == 1) {
#pragma unroll
                        for (int j = 0; j < 4; ++j) { const float a = fmaxf(v0[j], 0.f), b = fmaxf(v1[j], 0.f); v0[j] = a * a; v1[j] = b * b; } }
                    u32x4 w; w.x = cvt_pk_bf16(v0[0], v0[1]); w.y = cvt_pk_bf16(v0[2], v0[3]); w.z = cvt_pk_bf16(v1[0], v1[1]); w.w = cvt_pk_bf16(v1[2], v1[3]);
                    *(u32x4*)(rowp + bj * HALF) = w; } }
    }
};
struct EpiRes {
    const bf16_t* X; bf16_t* R; int ldc; float alpha;
    __device__ __forceinline__ void operator()(const f32x4 (&acc)[2][2][4][2], const Unit& u, int wr, int wc, int fr, int fq) const {
        const int row0 = u.pm * BM + wr * 64 + fr; const int col0 = u.pn * BM + wc * 32 + 8 * fq;
#pragma unroll
        for (int ai = 0; ai < 2; ++ai)
#pragma unroll
            for (int m = 0; m < 4; ++m) { const size_t off = (size_t)(row0 + ai * HALF + m * 16) * ldc + col0;
#pragma unroll
                for (int bj = 0; bj < 2; ++bj) { const u32x4 xw = *(const u32x4*)(X + off + bj * HALF);
                    const f32x4 x0 = {bf_lo(xw.x), bf_hi(xw.x), bf_lo(xw.y), bf_hi(xw.y)}, x1 = {bf_lo(xw.z), bf_hi(xw.z), bf_lo(xw.w), bf_hi(xw.w)};
                    const f32x4 v0 = x0 * alpha + acc[ai][bj][m][0], v1 = x1 * alpha + acc[ai][bj][m][1];
                    u32x4 w; w.x = cvt_pk_bf16(v0[0], v0[1]); w.y = cvt_pk_bf16(v0[2], v0[3]); w.z = cvt_pk_bf16(v1[0], v1[1]); w.w = cvt_pk_bf16(v1[2], v1[3]);
                    *(u32x4*)(R + off + bj * HALF) = w; } }
    }
};

struct EpiQKV {
    bf16_t* O;
    __device__ __forceinline__ void operator()(const f32x4 (&acc)[2][2][4][2], const Unit& u, int wr, int wc, int fr, int fq) const {
        const int which = u.pn / 12, g = (u.pn % 12) >> 2, jp = u.pn & 3, dsh = 2 * g;
        const int m0 = u.pm * BM, b = m0 >> 11, tb = (m0 & 2047) + wr * 64 + fr;
        bf16_t* base = O + ((size_t)((which * 3 + g) * 8 + 2 * jp) * MTOK + (size_t)b * 2048) * 128 + wc * 32 + 8 * fq;
#pragma unroll
        for (int ai = 0; ai < 2; ++ai)
#pragma unroll
            for (int m = 0; m < 4; ++m) { const int t = tb + ai * HALF + m * 16; const int tp = ((t & ((1 << dsh) - 1)) << (11 - dsh)) + (t >> dsh);
                bf16_t* rowp = base + (size_t)tp * 128;
#pragma unroll
                for (int bj = 0; bj < 2; ++bj) { const f32x4 v0 = acc[ai][bj][m][0], v1 = acc[ai][bj][m][1];
                    u32x4 w; w.x = cvt_pk_bf16(v0[0], v0[1]); w.y = cvt_pk_bf16(v0[2], v0[3]); w.z = cvt_pk_bf16(v1[0], v1[1]); w.w = cvt_pk_bf16(v1[2], v1[3]);
                    *(u32x4*)(rowp + (size_t)bj * MTOK * 128) = w; } }
    }
};

template <class Epi, class Sched>
__device__ __forceinline__ void gemm_phase(LAS unsigned char* lds, const Gemm g, const Sched& S, const Epi& E, int wave_s) {
    const int tid = MYTID(wave_s), wid = wave_s, lane = tid & 63, wr = wid >> 2, wc = wid & 3, fr = lane & 15, fq = lane >> 4;
    const int K = g.K, nt = K / BK, lda = g.lda;
    unsigned voffA[2], voffB[2];
#pragma unroll
    for (int i = 0; i < 2; ++i) { int R, C; stage_rc(tid * 16 + i * 8192, R, C); const int Rb = (R & ~31) + perm32(R & 31);
        voffA[i] = (unsigned)(R * lda + C) * 2u; voffB[i] = (unsigned)(Rb * K + C) * 2u; }
    const size_t kstep = (size_t)(BK * 2);
    const size_t hstepA = (size_t)HALF * lda * 2, hstepB = (size_t)HALF * K * 2;
    const size_t tstepA = 2 * hstepA, tstepB = 2 * hstepB;
    const unsigned ldsw = (unsigned)wid * 1024u;
    const int aoff = lds_byte(wr * 64 + fr, fq * 8), boff = lds_byte(wc * 32 + fr, fq * 8);
#define PG8_SA(b, h) (((b) * 2 + (h)) * HTB)
#define PG8_SB(b, h) ((4 + (b) * 2 + (h)) * HTB)
#define PG8_STAGE(bufoff, gbase, voff) do { _Pragma("unroll") for (int _i = 0; _i < 2; ++_i) \
        __builtin_amdgcn_global_load_lds((const unsigned*)((const char*)(gbase) + (voff)[_i]), (LAS unsigned*)(lds + (bufoff) + ldsw + _i * 8192), 16, 0, 0); } while (0)
#define PG8_LDA(dst, b, h) do { _Pragma("unroll") for (int m = 0; m < 4; ++m) _Pragma("unroll") for (int k = 0; k < 2; ++k) dst[m][k] = *(const LAS bf16x8*)(lds + PG8_SA(b, h) + aoff + m * 2048 + k * 1024); } while (0)
#define PG8_LDB(dst, b, h) do { _Pragma("unroll") for (int n = 0; n < 2; ++n) _Pragma("unroll") for (int k = 0; k < 2; ++k) dst[n][k] = *(const LAS bf16x8*)(lds + PG8_SB(b, h) + boff + n * 2048 + k * 1024); } while (0)
#define PG8_MMA(ai, bj, At, Bt) do { __builtin_amdgcn_s_setprio(1); _Pragma("unroll") for (int m = 0; m < 4; ++m) _Pragma("unroll") for (int n = 0; n < 2; ++n) _Pragma("unroll") for (int k = 0; k < 2; ++k) \
        acc[ai][bj][m][n] = __builtin_amdgcn_mfma_f32_16x16x32_bf16(Bt[n][k], At[m][k], acc[ai][bj][m][n], 0, 0, 0); __builtin_amdgcn_s_setprio(0); } while (0)
#define PG8_WAIT_V(n) asm volatile("s_waitcnt vmcnt(" #n ")" ::: "memory")
#define PG8_WAIT_L(n) asm volatile("s_waitcnt lgkmcnt(" #n ")" ::: "memory")
#define PG8_BAR __builtin_amdgcn_s_barrier()
#define PG8_SCHED __builtin_amdgcn_sched_barrier(0)
#define PG8_AOFF(u) ((size_t)(((u).pn / g.agdiv) * g.agk) * 2)
    Unit cur, nxt; int ui = 0;
    if (!S.next(0, cur)) return;
    f32x4 acc[2][2][4][2];
#pragma unroll
    for (int a = 0; a < 2; ++a)
#pragma unroll
        for (int b = 0; b < 2; ++b)
#pragma unroll
            for (int m = 0; m < 4; ++m)
#pragma unroll
                for (int n = 0; n < 2; ++n) acc[a][b][m][n] = (f32x4){0.f, 0.f, 0.f, 0.f};
    bf16x8 At[4][2], B0[2][2], B1[2][2];
    const char* cA = (const char*)g.A + (size_t)cur.pm * tstepA + PG8_AOFF(cur); const char* cB = (const char*)g.Bt + (size_t)cur.pn * tstepB;
    PG8_STAGE(PG8_SB(0, 0), cB, voffB); PG8_STAGE(PG8_SB(0, 1), cB + hstepB, voffB); PG8_STAGE(PG8_SA(0, 0), cA, voffA); PG8_STAGE(PG8_SA(0, 1), cA + hstepA, voffA);
    if (wr == 1) PG8_BAR;
    PG8_WAIT_V(2); PG8_BAR;
    PG8_STAGE(PG8_SB(1, 0), cB + kstep, voffB); PG8_STAGE(PG8_SA(1, 0), cA + kstep, voffA); PG8_STAGE(PG8_SB(1, 1), cB + hstepB + kstep, voffB);
    PG8_WAIT_V(6); PG8_BAR;
    for (;;) {
        const bool has_next = S.next(ui + 1, nxt);
        const char* nA = has_next ? (const char*)g.A + (size_t)nxt.pm * tstepA + PG8_AOFF(nxt) : cA; const char* nB = has_next ? (const char*)g.Bt + (size_t)nxt.pn * tstepB : cB;
        for (int t = 0; t < nt; t += 2) {
            const bool last = (t == nt - 2);
            const char* a1 = cA + (size_t)(t + 1) * kstep;
            const char* a2 = last ? nA : cA + (size_t)(t + 2) * kstep; const char* b2 = last ? nB : cB + (size_t)(t + 2) * kstep;
            const char* a3 = a2 + kstep; const char* b3 = b2 + kstep;
            PG8_LDB(B0, 0, 0); PG8_LDB(B1, 0, 1); PG8_SCHED; PG8_LDA(At, 0, 0); PG8_STAGE(PG8_SA(1, 1), a1 + hstepA, voffA);
            PG8_WAIT_V(8); PG8_WAIT_L(0); PG8_BAR; PG8_MMA(0, 0, At, B0); PG8_MMA(0, 1, At, B1); PG8_BAR; PG8_SCHED;
            PG8_LDA(At, 0, 1); PG8_STAGE(PG8_SB(0, 0), b2, voffB); PG8_STAGE(PG8_SB(0, 1), b2 + hstepB, voffB); PG8_STAGE(PG8_SA(0, 0), a2, voffA);
            PG8_WAIT_V(8); PG8_WAIT_L(0); PG8_BAR; PG8_MMA(1, 0, At, B0); PG8_MMA(1, 1, At, B1); PG8_BAR; PG8_SCHED;
            PG8_LDB(B0, 1, 0); PG8_LDB(B1, 1, 1); PG8_SCHED; PG8_LDA(At, 1, 0); PG8_STAGE(PG8_SA(0, 1), a2 + hstepA, voffA);
            PG8_WAIT_V(8); PG8_WAIT_L(0); PG8_BAR; PG8_MMA(0, 0, At, B0); PG8_MMA(0, 1, At, B1); PG8_BAR; PG8_SCHED;
            PG8_LDA(At, 1, 1); PG8_STAGE(PG8_SB(1, 0), b3, voffB); PG8_STAGE(PG8_SB(1, 1), b3 + hstepB, voffB); PG8_STAGE(PG8_SA(1, 0), a3, voffA);
            PG8_WAIT_V(8); PG8_WAIT_L(0); PG8_BAR; PG8_MMA(1, 0, At, B0); PG8_MMA(1, 1, At, B1); PG8_BAR; PG8_SCHED;
        }
        if (wr == 0) PG8_BAR;
        E(acc, cur, wr, wc, fr, fq);
        if (!has_next) break;
#pragma unroll
        for (int a = 0; a < 2; ++a)
#pragma unroll
            for (int b = 0; b < 2; ++b)
#pragma unroll
                for (int m = 0; m < 4; ++m)
#pragma unroll
                    for (int n = 0; n < 2; ++n) acc[a][b][m][n] = (f32x4){0.f, 0.f, 0.f, 0.f};
        cur = nxt; cA = nA; cB = nB; ++ui;
        if (wr == 1) PG8_BAR;
    }
    PG8_WAIT_V(0);
    PG8_BAR;
#undef PG8_SA
#undef PG8_SB
#undef PG8_STAGE
#undef PG8_LDA
#undef PG8_LDB
#undef PG8_MMA
#undef PG8_WAIT_V
#undef PG8_WAIT_L
#undef PG8_BAR
#undef PG8_SCHED
#undef PG8_AOFF
}
}

constexpr int NWAVES = 8, NTHR = 512;
constexpr int ATT_KSTR = 272, ATT_VSTR = 288, ATT_K_OFF = 0, ATT_V_OFF = 256 * ATT_KSTR, ATT_BYTES = ATT_V_OFF + 272 * ATT_VSTR;
constexpr int MISC_OFF = ATT_BYTES;
constexpr int LDS_BYTES = 148480;
static_assert(ATT_BYTES <= LDS_BYTES && pg8::STAGE_BYTES <= LDS_BYTES, "LDS map");

struct Params {
    const float* x; const float* w_in; const float* w_group; const float* pool_scale; const float* w_out; const float* w_qkv; const float* w_ao;
    const float* w_up; const float* w_dn; const float* ln_mix_g; const float* ln_mix_b; const float* ln_mlp_g; const float* ln_mlp_b;
    float* out; unsigned char* ws;
};

__device__ __forceinline__ float wave_sum(float v) {
#pragma unroll
    for (int o = 1; o < 64; o <<= 1) v += __shfl_xor(v, o);
    return v;
}

__device__ __forceinline__ void p0_transpose_item(const float* W, int K, int N, bf16_t* WT, int row_off, LAS float* scr, int item, int lane) {
    const int nblk = N / 32, kb = item / nblk, nb = item % nblk, k0 = 64 * kb, n0 = 32 * nb;
#pragma unroll 8
    for (int i = 0; i < 32; ++i) { const int kk = 2 * i + (lane >> 5); scr[kk * 33 + (lane & 31)] = W[(size_t)(k0 + kk) * N + n0 + (lane & 31)]; }
    asm volatile("s_waitcnt lgkmcnt(0)" ::: "memory");
    const int c = lane & 7;
#pragma unroll
    for (int j = 0; j < 4; ++j) { const int n = (lane >> 3) + 8 * j; const LAS float* s = scr + (8 * c) * 33 + n;
        u32x4 o; o.x = pk2(s[0 * 33], s[1 * 33]); o.y = pk2(s[2 * 33], s[3 * 33]); o.z = pk2(s[4 * 33], s[5 * 33]); o.w = pk2(s[6 * 33], s[7 * 33]);
        *(u32x4*)(WT + (size_t)(row_off + n0 + n) * K + k0 + 8 * c) = o; }
    asm volatile("s_waitcnt lgkmcnt(0)" ::: "memory");
}

__device__ __forceinline__ void phase_prologue(const Params& p, LAS unsigned char* lds, int wave_s) {
    const int tid = MYTID(wave_s), lane = tid & 63, wave = wave_s;
    LAS float* scr = (LAS float*)(lds + wave * 16384);
    const int gw = blockIdx.x * NWAVES + wave, NGW = gridDim.x * NWAVES;
    unsigned char* ws = p.ws;
    constexpr int I_IN = (DM / 64) * (DM / 32), I_G = (512 / 64) * (512 / 32), I_OUT = I_IN, I_QKV = (DM / 64) * (QKVW / 32), I_AO = (GWID / 64) * (DM / 32),
                  I_UP = (DM / 64) * (FF / 32), I_DN = (FF / 64) * (DM / 32);
    constexpr int NITEMS = I_IN + 4 * I_G + I_OUT + I_QKV + I_AO + 2 * I_UP + 2 * I_DN;
    for (int it = gw; it < NITEMS; it += NGW) {
        int r = it;
        if (r < I_IN) { p0_transpose_item(p.w_in, DM, DM, (bf16_t*)(ws + WS_WIN), 0, scr, r, lane); continue; } r -= I_IN;
        if (r < 4 * I_G) { const int g = r / I_G; p0_transpose_item(p.w_group + (size_t)g * 512 * 512, 512, 512, (bf16_t*)(ws + WS_WG), g * 512, scr, r % I_G, lane); continue; } r -= 4 * I_G;
        if (r < I_OUT) { p0_transpose_item(p.w_out, DM, DM, (bf16_t*)(ws + WS_WOUT), 0, scr, r, lane); continue; } r -= I_OUT;
        if (r < I_QKV) { p0_transpose_item(p.w_qkv, DM, QKVW, (bf16_t*)(ws + WS_WQKV), 0, scr, r, lane); continue; } r -= I_QKV;
        if (r < I_AO) { p0_transpose_item(p.w_ao, GWID, DM, (bf16_t*)(ws + WS_WAO), 0, scr, r, lane); continue; } r -= I_AO;
        if (r < 2 * I_UP) { const int l = r / I_UP; p0_transpose_item(p.w_up + (size_t)l * DM * FF, DM, FF, (bf16_t*)(ws + (l ? WS_WUP1 : WS_WUP0)), 0, scr, r % I_UP, lane); continue; } r -= 2 * I_UP;
        { const int l = r / I_DN; p0_transpose_item(p.w_dn + (size_t)l * FF * DM, FF, DM, (bf16_t*)(ws + (l ? WS_WDN1 : WS_WDN0)), 0, scr, r % I_DN, lane); }
    }
    const size_t n8 = (size_t)MTOK * DM / 8; bf16_t* xa = (bf16_t*)(ws + WS_XA);
    for (size_t i = (size_t)blockIdx.x * NTHR + tid; i < n8; i += (size_t)gridDim.x * NTHR) {
        const f32x4 a = *(const f32x4*)(p.x + i * 8), b = *(const f32x4*)(p.x + i * 8 + 4);
        u32x4 o; o.x = pk2(a.x, a.y); o.y = pk2(a.z, a.w); o.z = pk2(b.x, b.y); o.w = pk2(b.z, b.w);
        *(u32x4*)(xa + i * 8) = o;
    }
}

__device__ __forceinline__ void phase_pool(const bf16_t* U, bf16_t* P, int wave_s) {
    const int tid = MYTID(wave_s);
    constexpr int TB = 32, NITEMS = (MTOK / TB) * (DM / 8);
    for (int id = blockIdx.x * NTHR + tid; id < NITEMS; id += gridDim.x * NTHR) {
        const int c8 = id & 255, tb = id >> 8, t0 = tb * TB, pos0 = t0 & (SEQ - 1), g = c8 >> 6, w = 2 << g;
        const bf16_t* up = U + (size_t)t0 * DM + c8 * 8; bf16_t* pp = P + (size_t)t0 * DM + c8 * 8;
        float s[8];
#pragma unroll
        for (int j = 0; j < 8; ++j) s[j] = 0.f;
        for (int k = 1; k <= w; ++k) { if (pos0 - k >= 0) { const u32x4 v = *(const u32x4*)(up - (ptrdiff_t)k * DM);
            s[0] += bf_lo(v.x); s[1] += bf_hi(v.x); s[2] += bf_lo(v.y); s[3] += bf_hi(v.y); s[4] += bf_lo(v.z); s[5] += bf_hi(v.z); s[6] += bf_lo(v.w); s[7] += bf_hi(v.w); } }
        for (int t = 0; t < TB; ++t) {
            const int pos = pos0 + t;
            const u32x4 v = *(const u32x4*)(up + (size_t)t * DM);
            float c[8] = {bf_lo(v.x), bf_hi(v.x), bf_lo(v.y), bf_hi(v.y), bf_lo(v.z), bf_hi(v.z), bf_lo(v.w), bf_hi(v.w)};
#pragma unroll
            for (int j = 0; j < 8; ++j) s[j] += c[j];
            if (pos >= w) { const u32x4 o = *(const u32x4*)(up + (ptrdiff_t)(t - w) * DM);
                s[0] -= bf_lo(o.x); s[1] -= bf_hi(o.x); s[2] -= bf_lo(o.y); s[3] -= bf_hi(o.y); s[4] -= bf_lo(o.z); s[5] -= bf_hi(o.z); s[6] -= bf_lo(o.w); s[7] -= bf_hi(o.w); }
            const float inv = 1.f / (float)(pos + 1 < w ? pos + 1 : w);
            u32x4 r; r.x = pk2(s[0] * inv - c[0], s[1] * inv - c[1]); r.y = pk2(s[2] * inv - c[2], s[3] * inv - c[3]);
            r.z = pk2(s[4] * inv - c[4], s[5] * inv - c[5]); r.w = pk2(s[6] * inv - c[6], s[7] * inv - c[7]);
            *(u32x4*)(pp + (size_t)t * DM) = r;
        }
    }
}

template <bool F32OUT>
__device__ __forceinline__ void phase_ln(const bf16_t* R, const float* gam, const float* bet, bf16_t* XO, float* FO, int wave_s) {
    const int lane = lane_id_opaque(), wave = wave_s;
    const int gw = blockIdx.x * NWAVES + wave, NGW = gridDim.x * NWAVES;
    for (int m0 = gw; m0 < MTOK; m0 += 2 * NGW) {
        const int m1 = m0 + NGW; const bool two = m1 < MTOK; const int m1c = two ? m1 : m0;
        u32x4 wa[4], wb[4];
#pragma unroll
        for (int j = 0; j < 4; ++j) { wa[j] = *((const u32x4*)(R + (size_t)m0 * DM) + lane + 64 * j); wb[j] = *((const u32x4*)(R + (size_t)m1c * DM) + lane + 64 * j); }
#pragma unroll
        for (int rr = 0; rr < 2; ++rr) {
            if (rr == 1 && !two) break;
            const int m = rr ? m1 : m0;
            float v[4][8]; float s = 0.f;
#pragma unroll
            for (int j = 0; j < 4; ++j) { const u32x4 w = rr ? wb[j] : wa[j];
                v[j][0] = bf_lo(w.x); v[j][1] = bf_hi(w.x); v[j][2] = bf_lo(w.y); v[j][3] = bf_hi(w.y); v[j][4] = bf_lo(w.z); v[j][5] = bf_hi(w.z); v[j][6] = bf_lo(w.w); v[j][7] = bf_hi(w.w);
#pragma unroll
                for (int e = 0; e < 8; ++e) s += v[j][e]; }
            const float mean = wave_sum(s) * (1.f / DM); float s2 = 0.f;
#pragma unroll
            for (int j = 0; j < 4; ++j)
#pragma unroll
                for (int e = 0; e < 8; ++e) { v[j][e] -= mean; s2 += v[j][e] * v[j][e]; }
            const float rstd = 1.f / sqrtf(wave_sum(s2) * (1.f / DM) + LN_EPS);
#pragma unroll
            for (int j = 0; j < 4; ++j) {
                const int c0 = (lane + 64 * j) * 8;
                const f32x4 g0 = *(const f32x4*)(gam + c0), g1 = *(const f32x4*)(gam + c0 + 4), b0 = *(const f32x4*)(bet + c0), b1 = *(const f32x4*)(bet + c0 + 4);
                const f32x4 y0 = (f32x4){v[j][0], v[j][1], v[j][2], v[j][3]} * rstd * g0 + b0, y1 = (f32x4){v[j][4], v[j][5], v[j][6], v[j][7]} * rstd * g1 + b1;
                if (F32OUT) { *(f32x4*)(FO + (size_t)m * DM + c0) = y0; *(f32x4*)(FO + (size_t)m * DM + c0 + 4) = y1; }
                else { u32x4 o; o.x = pk2(y0.x, y0.y); o.y = pk2(y0.z, y0.w); o.z = pk2(y1.x, y1.y); o.w = pk2(y1.z, y1.w); *((u32x4*)(XO + (size_t)m * DM) + lane + 64 * j) = o; }
            }
        }
    }
}

__device__ __forceinline__ s16x4 vtr(const LAS unsigned char* p) { return __builtin_bit_cast(s16x4, __builtin_amdgcn_ds_read_tr16_b64_v4i16((LAS s16x4*)p)); }

struct AttnId { int g, b, r, qb, j, ldprev; };
__device__ __forceinline__ AttnId attn_decode(int pass, int c, int i) {
    AttnId a; a.ldprev = 0;
    if (pass == 0) {
        if (i < 8) { a.g = 0; a.j = c & 7; a.b = (c >> 3) & 15; const int half = c >> 7; a.r = 0; a.qb = half * 8 + i; a.ldprev = (half == 1 && i == 0) ? 1 : 0; }
        else { const int ch = 2 * c + ((i - 8) >> 2); a.g = 1; a.j = ch & 7; a.r = (ch >> 3) & 3; a.b = ch >> 5; a.qb = (i - 8) & 3; }
    } else { const int id = 8 * c + i; a.g = 2; a.j = id & 7; a.r = (id >> 3) & 15; a.b = id >> 7; a.qb = 0; }
    return a;
}
__device__ __forceinline__ void attn_fetch(const bf16_t* qkv, const AttnId& a, int blk, u32x4 (&kv)[4], u32x4 (&vv)[4], int tid) {
    const int dsh = 2 * a.g;
    const size_t row0 = (size_t)a.b * SEQ + (size_t)a.r * (SEQ >> dsh) + (size_t)blk * 128;
    const int chunk = tid & 15, rb = tid >> 4;
    const bf16_t* kbase = qkv + ((size_t)((3 + a.g) * 8 + a.j) * MTOK + row0) * HD + chunk * 8;
    const bf16_t* vbase = kbase + (size_t)24 * MTOK * HD;
#pragma unroll
    for (int it = 0; it < 4; ++it) { const size_t ro = (size_t)(it * 32 + rb) * HD; kv[it] = *(const u32x4*)(kbase + ro); vv[it] = *(const u32x4*)(vbase + ro); }
}
__device__ __forceinline__ void attn_fetch_q(const bf16_t* qkv, const AttnId& a, bf16x8 (&qf)[4], int w, int fr, int fq) {
    const int dsh = 2 * a.g;
    const size_t row = (size_t)a.b * SEQ + (size_t)a.r * (SEQ >> dsh) + (size_t)(a.qb * 128 + 16 * w + fr);
    const bf16_t* qb = qkv + ((size_t)(a.g * 8 + a.j) * MTOK + row) * HD + 8 * fq;
#pragma unroll
    for (int kk = 0; kk < 4; ++kk) qf[kk] = *(const bf16x8*)(qb + 32 * kk);
}
__device__ __forceinline__ void attn_put(LAS unsigned char* lds, int half, const u32x4 (&kv)[4], const u32x4 (&vv)[4], int tid) {
    const int chunk = tid & 15, rb = tid >> 4;
#pragma unroll
    for (int it = 0; it < 4; ++it) { const int row = half * 128 + it * 32 + rb;
        *(LAS u32x4*)(lds + ATT_K_OFF + row * ATT_KSTR + chunk * 16) = kv[it]; *(LAS u32x4*)(lds + ATT_V_OFF + row * ATT_VSTR + chunk * 16) = vv[it]; }
}
__device__ __forceinline__ int attn_trow(int T, int ch) { return T >= 16 ? 256 : ((((T >> 3) ^ 1) ^ ch) << 7) + ((T & 7) << 4); }

__device__ __forceinline__ void attn_scores(LAS unsigned char* lds, int ch, bool has_prev, const bf16x8 (&qf)[4], f32x4 (&s)[9], int w, int fr, int fq) {
    LAS unsigned char* Kl = lds + ATT_K_OFF;
#pragma unroll
    for (int tt = 0; tt < 9; ++tt) { s[tt] = (f32x4){0.f, 0.f, 0.f, 0.f}; const int rowb = attn_trow(w + tt, ch);
        if (!has_prev && w + tt < 8) continue;
#pragma unroll
        for (int kk = 0; kk < 4; ++kk) { const bf16x8 av = *(const LAS bf16x8*)(Kl + (rowb + fr) * ATT_KSTR + (32 * kk + 8 * fq) * 2);
            s[tt] = __builtin_amdgcn_mfma_f32_16x16x32_bf16(av, qf[kk], s[tt], 0, 0, 0); } }
}
__device__ __forceinline__ void attn_finish(LAS unsigned char* lds, int ch, const AttnId& a, f32x4 (&s)[9], bf16_t* obuf, float* lsebuf, bf16_t* merged, int w, int fr, int fq) {
    const int g = a.g, j = a.j, qb = a.qb;
    const int dsh = (g == 0) ? 0 : (g == 1 ? 2 : 4), d = 1 << dsh;
    const size_t qrow = (size_t)a.b * SEQ + (size_t)((qb * 128 + 16 * w + fr) << dsh) + a.r;
    LAS unsigned char* Vl = lds + ATT_V_OFF;
    constexpr float LOG2E = 1.4426950408889634f;
    const float sc = 0.08838834764831845f * LOG2E;
    const float slope = exp2f(-8.0f * (float)(g * NSLOT + j + 1) / 24.0f);
    const float sl = slope * (float)d * LOG2E;
    float mx = -INFINITY;
    const float fb = (float)(128 + fr - 4 * fq);
#pragma unroll
    for (int tt = 0; tt < 9; ++tt) {
        const bool tile_ok = (qb > 0) || (w + tt >= 8);
#pragma unroll
        for (int jj = 0; jj < 4; ++jj) {
            const float dist = fb - (float)(16 * tt + jj);
            bool valid = tile_ok;
            if (tt == 0) valid = valid && (dist <= 128.f);
            if (tt == 8) valid = valid && (dist >= 0.f);
            const float v = valid ? (s[tt][jj] * sc - sl * dist) : -INFINITY;
            s[tt][jj] = v; mx = fmaxf(mx, v);
        }
    }
    mx = fmaxf(mx, __shfl_xor(mx, 16)); mx = fmaxf(mx, __shfl_xor(mx, 32));
    float sum = 0.f;
#pragma unroll
    for (int tt = 0; tt < 9; ++tt)
#pragma unroll
        for (int jj = 0; jj < 4; ++jj) { const float e = __builtin_amdgcn_exp2f(s[tt][jj] - mx); s[tt][jj] = e; sum += e; }
    sum += __shfl_xor(sum, 16); sum += __shfl_xor(sum, 32);
    bf16x8 pf[5];
#pragma unroll
    for (int c = 0; c < 5; ++c) {
        u32x4 pw; pw.x = pk2(s[2 * c][0], s[2 * c][1]); pw.y = pk2(s[2 * c][2], s[2 * c][3]);
        if (c < 4) { pw.z = pk2(s[2 * c + 1][0], s[2 * c + 1][1]); pw.w = pk2(s[2 * c + 1][2], s[2 * c + 1][3]); } else { pw.z = 0u; pw.w = 0u; }
        pf[c] = __builtin_bit_cast(bf16x8, pw);
    }
    u32x4 m0[4]; float l0 = 0.f, l1 = 0.f;
    const bf16_t* o0p = obuf + qrow * GWID + j * HD + 32 * fq;
    if (g == 2) { l0 = lsebuf[qrow * NSLOT + j]; l1 = lsebuf[((size_t)MTOK + qrow) * NSLOT + j];
#pragma unroll
        for (int dp = 0; dp < 4; ++dp) m0[dp] = *(const u32x4*)(o0p + 8 * dp); }
    else {
#pragma unroll
        for (int dp = 0; dp < 4; ++dp) m0[dp] = (u32x4){0u, 0u, 0u, 0u}; }
    f32x4 o[8];
#pragma unroll
    for (int dt = 0; dt < 8; ++dt) o[dt] = (f32x4){0.f, 0.f, 0.f, 0.f};
    const int lofs = (4 * fq + (fr >> 2)) * ATT_VSTR + (4 * (fr & 3)) * 2;
#pragma unroll
    for (int c = 0; c < 5; ++c) {
        __builtin_amdgcn_sched_barrier(0);
        if (qb == 0 && w + 2 * c + 1 < 8) continue;
        const LAS unsigned char* v0 = Vl + attn_trow(w + 2 * c, ch) * ATT_VSTR + lofs; const LAS unsigned char* v1 = Vl + attn_trow(w + 2 * c + 1, ch) * ATT_VSTR + lofs;
#pragma unroll
        for (int dt = 0; dt < 8; ++dt) {
            const s16x4 lo = vtr(v0 + dt * 32), hi = vtr(v1 + dt * 32);
            const bf16x8 av = {lo[0], lo[1], lo[2], lo[3], hi[0], hi[1], hi[2], hi[3]};
            o[dt] = __builtin_amdgcn_mfma_f32_16x16x32_bf16(av, pf[c], o[dt], 0, 0, 0);
        }
    }
    const float inv = 1.f / sum;
    const float lse = (mx + log2f(sum)) * 0.6931471805599453f;
    if (g < 2) {
        bf16_t* orow = obuf + ((size_t)g * MTOK + qrow) * GWID + j * HD + 32 * fq;
#pragma unroll
        for (int dp = 0; dp < 4; ++dp) { u32x4 ow; ow.x = pk2(o[2 * dp][0] * inv, o[2 * dp][1] * inv); ow.y = pk2(o[2 * dp][2] * inv, o[2 * dp][3] * inv);
            ow.z = pk2(o[2 * dp + 1][0] * inv, o[2 * dp + 1][1] * inv); ow.w = pk2(o[2 * dp + 1][2] * inv, o[2 * dp + 1][3] * inv); *(u32x4*)(orow + 8 * dp) = ow; }
        if (fq == 0) lsebuf[((size_t)g * MTOK + qrow) * NSLOT + j] = lse;
    } else {
        const float lm = fmaxf(lse, fmaxf(l0, l1));
        float e0 = __expf(l0 - lm), e1 = __expf(l1 - lm), e2 = __expf(lse - lm); const float wi = 1.f / (e0 + e1 + e2); e0 *= wi; e1 *= wi; e2 *= wi * inv;
        bf16_t* mrow = merged + qrow * GWID + j * HD + 4 * fq;
#pragma unroll
        for (int dp = 0; dp < 4; ++dp) { const u32x4 a0 = m0[dp], a1 = *(const u32x4*)(o0p + (size_t)MTOK * GWID + 8 * dp);
            u32x2 ow; ow.x = pk2(e0 * bf_lo(a0.x) + e1 * bf_lo(a1.x) + e2 * o[2 * dp][0], e0 * bf_hi(a0.x) + e1 * bf_hi(a1.x) + e2 * o[2 * dp][1]);
            ow.y = pk2(e0 * bf_lo(a0.y) + e1 * bf_lo(a1.y) + e2 * o[2 * dp][2], e0 * bf_hi(a0.y) + e1 * bf_hi(a1.y) + e2 * o[2 * dp][3]);
            *(u32x2*)(mrow + 32 * dp) = ow;
            ow.x = pk2(e0 * bf_lo(a0.z) + e1 * bf_lo(a1.z) + e2 * o[2 * dp + 1][0], e0 * bf_hi(a0.z) + e1 * bf_hi(a1.z) + e2 * o[2 * dp + 1][1]);
            ow.y = pk2(e0 * bf_lo(a0.w) + e1 * bf_lo(a1.w) + e2 * o[2 * dp + 1][2], e0 * bf_hi(a0.w) + e1 * bf_hi(a1.w) + e2 * o[2 * dp + 1][3]);
            *(u32x2*)(mrow + 32 * dp + 16) = ow; }
    }
}

#define ATT_LBAR() do { asm volatile("s_waitcnt lgkmcnt(0)" ::: "memory"); __builtin_amdgcn_s_barrier(); asm volatile("" ::: "memory"); } while (0)
__device__ __forceinline__ void phase_attn(LAS unsigned char* lds, const bf16_t* qkv, bf16_t* obuf, float* lsebuf, bf16_t* merged, int pass, int wave_s) {
    const int tid = MYTID(wave_s), lane = tid & 63, w = wave_s, fr = lane & 15, fq = lane >> 4;
    const int c = blockIdx.x, n = pass == 0 ? 16 : 8;
    for (int i = tid; i < ATT_BYTES / 16; i += NTHR) ((LAS u32x4*)lds)[i] = (u32x4){0u, 0u, 0u, 0u};
    ATT_LBAR();
    u32x4 kv[4], vv[4]; bf16x8 qn[4];
    AttnId cur = attn_decode(pass, c, 0);
    attn_fetch(qkv, cur, cur.qb, kv, vv, tid); attn_fetch_q(qkv, cur, qn, w, fr, fq);
    for (int i = 0; i < n; ++i) {
        const int ch = cur.qb & 1;
        attn_put(lds, ch, kv, vv, tid);
        if (cur.ldprev) { attn_fetch(qkv, cur, cur.qb - 1, kv, vv, tid); attn_put(lds, ch ^ 1, kv, vv, tid); }
        ATT_LBAR();
        f32x4 sacc[9];
        attn_scores(lds, ch, cur.qb > 0, qn, sacc, w, fr, fq);
        __builtin_amdgcn_sched_barrier(0);
        AttnId nxt = cur;
        if (i + 1 < n) { nxt = attn_decode(pass, c, i + 1); attn_fetch(qkv, nxt, nxt.qb, kv, vv, tid); attn_fetch_q(qkv, nxt, qn, w, fr, fq); }
        attn_finish(lds, ch, cur, sacc, obuf, lsebuf, merged, w, fr, fq);
        ATT_LBAR();
        cur = nxt;
    }
}

#define XB_TMO      128
#define XB_XCNT(j)  (256  + 64 * (j))
#define XB_XSUB(j)  (1280 + 64 * (j))
#define XB_XGEN(j)  (2304 + 64 * (j))
#define XB_TOP      3328
#define XB_TOPGEN   3392
#define XCD_BAR_WORDS 3456
#define XB_SPIN_CAP (1u << 22)
__device__ __forceinline__ unsigned xb_ld(unsigned* p)              { return __hip_atomic_load(p, __ATOMIC_RELAXED, __HIP_MEMORY_SCOPE_AGENT); }
__device__ __forceinline__ unsigned xb_add(unsigned* p, unsigned v) { return __hip_atomic_fetch_add(p, v, __ATOMIC_RELAXED, __HIP_MEMORY_SCOPE_AGENT); }
__device__ __forceinline__ unsigned xb_xcc_id() { return (unsigned)__builtin_amdgcn_s_getreg((3 << 11) | 20) & 0xFu; }
#define XB_SPIN(cond, bar) do { unsigned _sp = 0; while (cond) { __builtin_amdgcn_s_sleep(1); \
    if ((++_sp & 255u) == 0u) { if (xb_ld(&(bar)[XB_TMO])) break; if (_sp > XB_SPIN_CAP) { atomicAdd(&(bar)[XB_TMO], 1u); break; } } } } while (0)
struct XcdBarrier { unsigned* bar; unsigned x; volatile LAS unsigned* st; };
__device__ __forceinline__ XcdBarrier xcd_barrier_post(unsigned* bar, volatile LAS unsigned* st, int wave_s) {
    XcdBarrier b; b.bar = bar; b.x = xb_xcc_id(); b.st = st;
    if (MYTID(wave_s) == 0) (void)xb_add(&bar[XB_XCNT(b.x)], 1u);
    return b;
}
__device__ __forceinline__ void xcd_barrier_complete(unsigned* bar, unsigned x, unsigned& nloc, unsigned& nx) {
    const unsigned G = gridDim.x * gridDim.y * gridDim.z;
    unsigned sum, cnt, mine, sp = 0u;
    for (;;) {
        sum = 0u; cnt = 0u; mine = 0u;
#pragma unroll
        for (unsigned j = 0; j < 16; ++j) { const unsigned c = xb_ld(&bar[XB_XCNT(j)]); sum += c; cnt += (c > 0u) ? 1u : 0u; mine = (j == x) ? c : mine; }
        if (sum == G) break;
        __builtin_amdgcn_s_sleep(1);
        if ((++sp & 255u) == 0u) { if (xb_ld(&bar[XB_TMO])) break; if (sp > XB_SPIN_CAP) { atomicAdd(&bar[XB_TMO], 1u); break; } }
    }
    nloc = mine > 0u ? mine : 1u; nx = cnt > 0u ? cnt : 1u;
}
__device__ __forceinline__ void xcd_barrier(const XcdBarrier& b, int wave_s) {
    asm volatile("s_waitcnt vmcnt(0)" ::: "memory");
    __syncthreads();
    if (MYTID(wave_s) == 0) {
        unsigned* bar = b.bar;
        __builtin_amdgcn_s_waitcnt(0);
        unsigned nloc = b.st[0], nx = b.st[1];
        if (nloc == 0u) { xcd_barrier_complete(bar, b.x, nloc, nx); b.st[0] = nloc; b.st[1] = nx; }
        const unsigned old = xb_add(&bar[XB_XSUB(b.x)], 1u);
        const unsigned gen = old / nloc;
        if (old + 1u == (gen + 1u) * nloc) {
            __builtin_amdgcn_fence(__ATOMIC_RELEASE, "agent");
            asm volatile("s_waitcnt vmcnt(0)" ::: "memory");
            const unsigned og = xb_add(&bar[XB_TOP], 1u);
            const unsigned tg = og / nx;
            if (og + 1u == (tg + 1u) * nx) xb_add(&bar[XB_TOPGEN], 1u);
            else XB_SPIN(xb_ld(&bar[XB_TOPGEN]) == tg, bar);
            __builtin_amdgcn_fence(__ATOMIC_ACQUIRE, "agent");
            xb_add(&bar[XB_XGEN(b.x)], 1u);
            asm volatile("s_waitcnt vmcnt(0)" ::: "memory");
        } else {
            XB_SPIN(xb_ld(&bar[XB_XGEN(b.x)]) == gen, bar);
            __builtin_amdgcn_fence(__ATOMIC_ACQUIRE, "agent");
            asm volatile("s_waitcnt vmcnt(0)" ::: "memory");
        }
    }
    __syncthreads();
}

__global__ void __launch_bounds__(NTHR, 2) fwd_megakernel(Params p) {
    extern __shared__ __attribute__((aligned(16))) unsigned char lds_raw[];
    LAS unsigned char* lds = (LAS unsigned char*)lds_raw;
    cg::grid_group grid = cg::this_grid();
    unsigned char* ws = p.ws;
    bf16_t* XA = (bf16_t*)(ws + WS_XA); bf16_t* XB = (bf16_t*)(ws + WS_XB);
    bf16_t* BIG = (bf16_t*)(ws + WS_BIG);
    bf16_t* U = BIG; bf16_t* PB = BIG + (size_t)MTOK * DM; bf16_t* Y = BIG + 2 * (size_t)MTOK * DM;
    bf16_t* R = (bf16_t*)p.out;
    volatile LAS unsigned* MISC = (volatile LAS unsigned*)(lds + MISC_OFF);
    unsigned* barw = (unsigned*)ws;
    const int G = gridDim.x, c = blockIdx.x;
    constexpr int NOG = 1 << 30;

    const int wave_s = __builtin_amdgcn_readfirstlane((int)threadIdx.x >> 6);
    { const int t0 = MYTID(wave_s); if (blockIdx.x == 0) for (int i = t0; i < XCD_BAR_WORDS; i += NTHR) barw[i] = 0u;
      if (t0 < 2) MISC[t0] = 0u; }
    phase_prologue(p, lds, wave_s);
    grid.sync();
    const XcdBarrier xbar = xcd_barrier_post(barw, MISC, wave_s);
    {
        pg8::Gemm g{XA, (const bf16_t*)(ws + WS_WIN), MTOK, DM, DM, DM, NOG, 0}; pg8::StaticOrder S; S.init(MTOK, DM, G, c);
        pg8::EpiBf16<0, false> E{U, DM, nullptr};
        pg8::gemm_phase(lds, g, S, E, wave_s);
    }
    xcd_barrier(xbar, wave_s);
    phase_pool(U, PB, wave_s);
    xcd_barrier(xbar, wave_s);
    {
        pg8::Gemm g{PB, (const bf16_t*)(ws + WS_WG), MTOK, DM, 512, DM, 2, 512}; pg8::StaticOrder S; S.init(MTOK, DM, G, c);
        pg8::EpiBf16<0, true> E{Y, DM, p.pool_scale};
        pg8::gemm_phase(lds, g, S, E, wave_s);
    }
    xcd_barrier(xbar, wave_s);
    {
        pg8::Gemm g{Y, (const bf16_t*)(ws + WS_WOUT), MTOK, DM, DM, DM, NOG, 0}; pg8::StaticOrder S; S.init(MTOK, DM, G, c);
        pg8::EpiRes E{XA, R, DM, ALPHA};
        pg8::gemm_phase(lds, g, S, E, wave_s);
    }
    xcd_barrier(xbar, wave_s);
    phase_ln<false>(R, p.ln_mix_g, p.ln_mix_b, XB, nullptr, wave_s);
    xcd_barrier(xbar, wave_s);
    {
        pg8::Gemm g{XB, (const bf16_t*)(ws + WS_WUP0), MTOK, FF, DM, DM, NOG, 0}; pg8::StaticOrder S; S.init(MTOK, FF, G, c);
        pg8::EpiBf16<1, false> E{BIG, FF, nullptr};
        pg8::gemm_phase(lds, g, S, E, wave_s);
    }
    xcd_barrier(xbar, wave_s);
    {
        pg8::Gemm g{BIG, (const bf16_t*)(ws + WS_WDN0), MTOK, DM, FF, FF, NOG, 0}; pg8::StaticOrder S; S.init(MTOK, DM, G, c);
        pg8::EpiRes E{XB, R, DM, ALPHA};
        pg8::gemm_phase(lds, g, S, E, wave_s);
    }
    xcd_barrier(xbar, wave_s);
    phase_ln<false>(R, p.ln_mlp_g, p.ln_mlp_b, XA, nullptr, wave_s);
    xcd_barrier(xbar, wave_s);
    {
        pg8::Gemm g{XA, (const bf16_t*)(ws + WS_WQKV), MTOK, QKVW, DM, DM, NOG, 0}; pg8::StaticOrder S; S.init(MTOK, QKVW, G, c);
        pg8::EpiQKV E{BIG};
        pg8::gemm_phase(lds, g, S, E, wave_s);
    }
    xcd_barrier(xbar, wave_s);
    phase_attn(lds, BIG, (bf16_t*)p.out, (float*)(ws + WS_LSE), XB, 0, wave_s);
    xcd_barrier(xbar, wave_s);
    phase_attn(lds, BIG, (bf16_t*)p.out, (float*)(ws + WS_LSE), XB, 1, wave_s);
    xcd_barrier(xbar, wave_s);
    {
        pg8::Gemm g{XB, (const bf16_t*)(ws + WS_WAO), MTOK, DM, GWID, GWID, NOG, 0}; pg8::StaticOrder S; S.init(MTOK, DM, G, c);
        pg8::EpiRes E{XA, R, DM, ALPHA};
        pg8::gemm_phase(lds, g, S, E, wave_s);
    }
    xcd_barrier(xbar, wave_s);
    phase_ln<false>(R, p.ln_mix_g + DM, p.ln_mix_b + DM, XB, nullptr, wave_s);
    xcd_barrier(xbar, wave_s);
    {
        pg8::Gemm g{XB, (const bf16_t*)(ws + WS_WUP1), MTOK, FF, DM, DM, NOG, 0}; pg8::StaticOrder S; S.init(MTOK, FF, G, c);
        pg8::EpiBf16<1, false> E{BIG, FF, nullptr};
        pg8::gemm_phase(lds, g, S, E, wave_s);
    }
    xcd_barrier(xbar, wave_s);
    {
        pg8::Gemm g{BIG, (const bf16_t*)(ws + WS_WDN1), MTOK, DM, FF, FF, NOG, 0}; pg8::StaticOrder S; S.init(MTOK, DM, G, c);
        pg8::EpiRes E{XB, XA, DM, ALPHA};
        pg8::gemm_phase(lds, g, S, E, wave_s);
    }
    xcd_barrier(xbar, wave_s);
    phase_ln<true>(XA, p.ln_mlp_g + DM, p.ln_mlp_b + DM, nullptr, p.out, wave_s);
}

extern "C" void kernel_launch(void* const* d_in, const int* in_sizes, int n_in, void* d_out, int out_size, void* d_ws, size_t ws_size, hipStream_t stream) {
    static int grid = 0;
    if (grid == 0) {
        if (n_in != 13 || in_sizes[0] != MTOK * DM || out_size != MTOK * DM || ws_size < WS_END) {
            fprintf(stderr, "kernel_launch: unexpected shapes: n_in %d in0 %d out %d ws %zu (need %zu); nothing launched\n", n_in, n_in > 0 ? in_sizes[0] : -1, out_size, ws_size, (size_t)WS_END); grid = -1; return; }
        int dev = 0, cus = 0, per_cu = 0;
        hipGetDevice(&dev);
        hipDeviceGetAttribute(&cus, hipDeviceAttributeMultiprocessorCount, dev);
        if (hipFuncSetAttribute((const void*)fwd_megakernel, hipFuncAttributeMaxDynamicSharedMemorySize, LDS_BYTES) != hipSuccess) { fprintf(stderr, "kernel_launch: hipFuncSetAttribute failed\n"); grid = -1; return; }
        if (hipOccupancyMaxActiveBlocksPerMultiprocessor(&per_cu, (const void*)fwd_megakernel, NTHR, LDS_BYTES) != hipSuccess || per_cu < 1) { fprintf(stderr, "kernel_launch: occupancy query gave %d\n", per_cu); per_cu = 1; }
        (void)hipGetLastError();
        grid = cus * per_cu;
        if (grid != 256) { fprintf(stderr, "kernel_launch: this kernel needs exactly 256 co-resident workgroups, got %d\n", grid); if (grid > 256) grid = 256; }
        fprintf(stderr, "kernel_launch: grid %d (cus %d x %d)\n", grid, cus, per_cu);
    }
    if (grid < 0) return;
    Params p{};
    p.x = (const float*)d_in[0]; p.w_in = (const float*)d_in[1]; p.w_group = (const float*)d_in[2]; p.pool_scale = (const float*)d_in[3]; p.w_out = (const float*)d_in[4];
    p.w_qkv = (const float*)d_in[5]; p.w_ao = (const float*)d_in[6]; p.w_up = (const float*)d_in[7]; p.w_dn = (const float*)d_in[8];
    p.ln_mix_g = (const float*)d_in[9]; p.ln_mix_b = (const float*)d_in[10]; p.ln_mlp_g = (const float*)d_in[11]; p.ln_mlp_b = (const float*)d_in[12];
    p.out = (float*)d_out; p.ws = (unsigned char*)d_ws;
    void* args[] = {&p};
    hipError_t e = hipLaunchCooperativeKernel((const void*)fwd_megakernel, dim3(grid), dim3(NTHR), args, LDS_BYTES, stream);
    if (e != hipSuccess) fprintf(stderr, "kernel_launch: cooperative launch failed: %s (grid %d)\n", hipGetErrorString(e), grid);
}
```

```cpp
#include <hip/hip_runtime.h>
#include <hip/hip_cooperative_groups.h>
#include <cstdio>
#include <cstdint>
namespace cg = cooperative_groups;

#define LAS __attribute__((address_space(3)))
typedef unsigned short bf16_t;
typedef short bf16x8 __attribute__((ext_vector_type(8)));
typedef short s16x4 __attribute__((ext_vector_type(4)));
typedef float f32x4 __attribute__((ext_vector_type(4)));
typedef float f32x2 __attribute__((ext_vector_type(2)));
typedef unsigned u32x4 __attribute__((ext_vector_type(4)));
typedef unsigned u32x2 __attribute__((ext_vector_type(2)));

constexpr int DM = 2048, BATCH = 16, SEQ = 2048, MTOK = BATCH * SEQ, FF = 8192, QKVW = 9216, GWID = 1024, HD = 128, NSLOT = 8;
constexpr float LN_EPS = 1e-5f;
constexpr float ALPHA = 1.4142135623730951f;
constexpr size_t MiB = 1u << 20;
constexpr size_t WS_WIN = 1 * MiB, WS_WG = 9 * MiB, WS_WOUT = 11 * MiB, WS_WQKV = 19 * MiB, WS_WAO = 55 * MiB, WS_WUP0 = 59 * MiB, WS_WUP1 = 91 * MiB,
                 WS_WDN0 = 123 * MiB, WS_WDN1 = 155 * MiB, WS_LSE = 188 * MiB, WS_XA = 192 * MiB, WS_XB = 320 * MiB, WS_BIG = 448 * MiB, WS_END = 1024 * MiB;

__device__ __forceinline__ unsigned f2bf(float f) { unsigned u = __builtin_bit_cast(unsigned, f); return (u + 0x7fffu + ((u >> 16) & 1u)) >> 16; }
typedef __bf16 bf16x2_t __attribute__((ext_vector_type(2)));
__device__ __forceinline__ unsigned pk2(float lo, float hi) { const f32x2 v = {lo, hi}; const bf16x2_t b = __builtin_convertvector(v, bf16x2_t); return __builtin_bit_cast(unsigned, b); }
__device__ __forceinline__ float bf_lo(unsigned w) { return __builtin_bit_cast(float, w << 16); }
__device__ __forceinline__ float bf_hi(unsigned w) { return __builtin_bit_cast(float, w & 0xffff0000u); }

__device__ __forceinline__ int lane_id_opaque() { int l; asm volatile("v_mbcnt_lo_u32_b32 %0, -1, 0\n\tv_mbcnt_hi_u32_b32 %0, -1, %0" : "=v"(l)); return l; }
#define MYTID(wave_s) ((wave_s) * 64 + lane_id_opaque())
namespace pg8 {
constexpr int BM = 256, BK = 64, HALF = 128, HTB = HALF * BK * 2, STAGE_BYTES = 8 * HTB, NXCD = 8, WGM = 8;
__host__ __device__ __forceinline__ int lds_byte(int r, int c) { const int st = (r >> 4) * 2 + (c >> 5), rr = r & 15, cc = c & 31, ob = rr * 64 + cc * 2; return st * 1024 + (ob ^ (((ob >> 9) & 1) << 5)); }
__host__ __device__ __forceinline__ void stage_rc(int b, int& R, int& C) { const int st = b / 1024, sb = b % 1024, swz = sb ^ (((sb >> 9) & 1) << 5); R = (st >> 1) * 16 + swz / 64; C = (st & 1) * 32 + (swz % 64) / 2; }
__host__ __device__ __forceinline__ int perm32(int rho) { const int n = rho >> 4, i = rho & 15; return 8 * (i >> 2) + 4 * n + (i & 3); }

struct Unit { int pm, pn; };
struct Gemm { const bf16_t* A; const bf16_t* Bt; int M, N, K, lda, agdiv, agk; };

struct StaticOrder {
    int nM, nN, nwg, G, c, wgm;
    __host__ __device__ void init(int M, int N, int G_, int c_) { nM = M / BM; nN = N / BM; nwg = nM * nN; G = G_; c = c_; wgm = 4; }
    __host__ __device__ bool next(int i, Unit& u) const {
        const long L = (long)i * G + c; if (L >= nwg) return false;
        int wgid = (int)L; { const int q = nwg / NXCD, r = nwg % NXCD, xcd = wgid % NXCD, off = wgid / NXCD; wgid = (xcd < r ? xcd * (q + 1) : r * (q + 1) + (xcd - r) * q) + off; }
        const int nig = wgm * nN, gid = wgid / nig, fm = gid * wgm, gsz = (nM - fm) < wgm ? (nM - fm) : wgm;
        u.pm = fm + ((wgid % nig) % gsz); u.pn = (wgid % nig) / gsz; return true;
    }
};

__device__ __forceinline__ unsigned cvt_pk_bf16(float lo, float hi) { unsigned r; asm volatile("v_cvt_pk_bf16_f32 %0, %1, %2" : "=v"(r) : "v"(lo), "v"(hi)); return r; }

template <int ACT, bool SCALE> struct EpiBf16 {
    bf16_t* O; int ldc; const float* colscale;
    __device__ __forceinline__ void operator()(const f32x4 (&acc)[2][2][4][2], const Unit& u, int wr, int wc, int fr, int fq) const {
        const int row0 = u.pm * BM + wr * 64 + fr; const int col0 = u.pn * BM + wc * 32 + 8 * fq;
        f32x4 cs[2][2];
#pragma unroll
        for (int bj = 0; bj < 2; ++bj)
#pragma unroll
            for (int n = 0; n < 2; ++n) cs[bj][n] = SCALE ? *(const f32x4*)(colscale + col0 + bj * HALF + 4 * n) : (f32x4){1.f, 1.f, 1.f, 1.f};
#pragma unroll
        for (int ai = 0; ai < 2; ++ai)
#pragma unroll
            for (int m = 0; m < 4; ++m) { bf16_t* rowp = O + (size_t)(row0 + ai * HALF + m * 16) * ldc + col0;
#pragma unroll
                for (int bj = 0; bj < 2; ++bj) { f32x4 v0 = acc[ai][bj][m][0], v1 = acc[ai][bj][m][1];
                    if (SCALE) { v0 = v0 * cs[bj][0]; v1 = v1 * cs[bj][1]; }
                    if (ACT == 1) {
#pragma unroll
                        for (int j = 0; j < 4; ++j) { const float a = fmaxf(v0[j], 0.f), b = fmaxf(v1[j], 0.f); v0[j] = a * a; v1[j] = b * b; } }
                    u32x4 w; w.x = cvt_pk_bf16(v0[0], v0[1]); w.y = cvt_pk_bf16(v0[2], v0[3]); w.z = cvt_pk_bf16(v1[0], v1[1]); w.w = cvt_pk_bf16(v1[2], v1[3]);
                    *(u32x4*)(rowp + bj * HALF) = w; } }
    }
};
struct EpiRes {
    const bf16_t* X; bf16_t* R; int ldc; float alpha;
    __device__ __forceinline__ void operator()(const f32x4 (&acc)[2][2][4][2], const Unit& u, int wr, int wc, int fr, int fq) const {
        const int row0 = u.pm * BM + wr * 64 + fr; const int col0 = u.pn * BM + wc * 32 + 8 * fq;
#pragma unroll
        for (int ai = 0; ai < 2; ++ai)
#pragma unroll
            for (int m = 0; m < 4; ++m) { const size_t off = (size_t)(row0 + ai * HALF + m * 16) * ldc + col0;
#pragma unroll
                for (int bj = 0; bj < 2; ++bj) { const u32x4 xw = *(const u32x4*)(X + off + bj * HALF);
                    const f32x4 x0 = {bf_lo(xw.x), bf_hi(xw.x), bf_lo(xw.y), bf_hi(xw.y)}, x1 = {bf_lo(xw.z), bf_hi(xw.z), bf_lo(xw.w), bf_hi(xw.w)};
                    const f32x4 v0 = x0 * alpha + acc[ai][bj][m][0], v1 = x1 * alpha + acc[ai][bj][m][1];
                    u32x4 w; w.x = cvt_pk_bf16(v0[0], v0[1]); w.y = cvt_pk_bf16(v0[2], v0[3]); w.z = cvt_pk_bf16(v1[0], v1[1]); w.w = cvt_pk_bf16(v1[2], v1[3]);
                    *(u32x4*)(R + off + bj * HALF) = w; } }
    }
};

struct EpiQKV {
    bf16_t* O;
    __device__ __forceinline__ void operator()(const f32x4 (&acc)[2][2][4][2], const Unit& u, int wr, int wc, int fr, int fq) const {
        const int which = u.pn / 12, g = (u.pn % 12) >> 2, jp = u.pn & 3, dsh = 2 * g;
        const int m0 = u.pm * BM, b = m0 >> 11, tb = (m0 & 2047) + wr * 64 + fr;
        bf16_t* base = O + ((size_t)((which * 3 + g) * 8 + 2 * jp) * MTOK + (size_t)b * 2048) * 128 + wc * 32 + 8 * fq;
#pragma unroll
        for (int ai = 0; ai < 2; ++ai)
#pragma unroll
            for (int m = 0; m < 4; ++m) { const int t = tb + ai * HALF + m * 16; const int tp = ((t & ((1 << dsh) - 1)) << (11 - dsh)) + (t >> dsh);
                bf16_t* rowp = base + (size_t)tp * 128;
#pragma unroll
                for (int bj = 0; bj < 2; ++bj) { const f32x4 v0 = acc[ai][bj][m][0], v1 = acc[ai][bj][m][1];
                    u32x4 w; w.x = cvt_pk_bf16(v0[0], v0[1]); w.y = cvt_pk_bf16(v0[2], v0[3]); w.z = cvt_pk_bf16(v1[0], v1[1]); w.w = cvt_pk_bf16(v1[2], v1[3]);
                    *(u32x4*)(rowp + (size_t)bj * MTOK * 128) = w; } }
    }
};

__device__ __forceinline__ void dma16(const void* sbase, unsigned voff, unsigned lds_dst) {
    unsigned keep;
    asm volatile("s_mov_b32 %0, m0\n\ts_mov_b32 m0, %3\n\ts_nop 0\n\tglobal_load_lds_dwordx4 %2, %1\n\ts_mov_b32 m0, %0" : "=&s"(keep) : "s"(sbase), "v"(voff), "s"(lds_dst) : "memory");
}
template <class Epi, class Sched>
__device__ __forceinline__ void gemm_phase(LAS unsigned char* lds, const Gemm g, const Sched& S, const Epi& E, int wave_s) {
    const int tid = MYTID(wave_s), wid = wave_s, lane = tid & 63, wr = wid >> 2, wc = wid & 3, fr = lane & 15, fq = lane >> 4;
    const int K = g.K, nt = K / BK, lda = g.lda;
    unsigned voffA[2], voffB[2];
#pragma unroll
    for (int i = 0; i < 2; ++i) { int R, C; stage_rc(tid * 16 + i * 8192, R, C); const int Rb = (R & ~31) + perm32(R & 31);
        voffA[i] = (unsigned)(R * lda + C) * 2u; voffB[i] = (unsigned)(Rb * K + C) * 2u; }
    const size_t kstep = (size_t)(BK * 2);
    const size_t hstepA = (size_t)HALF * lda * 2, hstepB = (size_t)HALF * K * 2;
    const size_t tstepA = 2 * hstepA, tstepB = 2 * hstepB;
    const unsigned ldsw = (unsigned)wid * 1024u;
    const unsigned ldsb = (unsigned)__builtin_amdgcn_readfirstlane((int)((unsigned)(uintptr_t)lds + ldsw));
    const int aoff = lds_byte(wr * 64 + fr, fq * 8), boff = lds_byte(wc * 32 + fr, fq * 8);
#define PG8_SA(b, h) (((b) * 2 + (h)) * HTB)
#define PG8_SB(b, h) ((4 + (b) * 2 + (h)) * HTB)
#define PG8_STAGE(bufoff, gbase, voff) do { _Pragma("unroll") for (int _i = 0; _i < 2; ++_i) \
        dma16((const void*)(gbase), (voff)[_i], ldsb + (unsigned)((bufoff) + _i * 8192)); } while (0)
#define PG8_LDA(dst, b, h) do { _Pragma("unroll") for (int m = 0; m < 4; ++m) _Pragma("unroll") for (int k = 0; k < 2; ++k) dst[m][k] = *(const LAS bf16x8*)(lds + PG8_SA(b, h) + aoff + m * 2048 + k * 1024); } while (0)
#define PG8_LDB(dst, b, h) do { _Pragma("unroll") for (int n = 0; n < 2; ++n) _Pragma("unroll") for (int k = 0; k < 2; ++k) dst[n][k] = *(const LAS bf16x8*)(lds + PG8_SB(b, h) + boff + n * 2048 + k * 1024); } while (0)
#define PG8_MMA(ai, bj, At, Bt) do { __builtin_amdgcn_s_setprio(1); _Pragma("unroll") for (int m = 0; m < 4; ++m) _Pragma("unroll") for (int n = 0; n < 2; ++n) _Pragma("unroll") for (int k = 0; k < 2; ++k) \
        acc[ai][bj][m][n] = __builtin_amdgcn_mfma_f32_16x16x32_bf16(Bt[n][k], At[m][k], acc[ai][bj][m][n], 0, 0, 0); __builtin_amdgcn_s_setprio(0); } while (0)
#define PG8_WAIT_V(n) asm volatile("s_waitcnt vmcnt(" #n ")" ::: "memory")
#define PG8_WAIT_L(n) asm volatile("s_waitcnt lgkmcnt(" #n ")" ::: "memory")
#define PG8_BAR __builtin_amdgcn_s_barrier()
#define PG8_SCHED __builtin_amdgcn_sched_barrier(0)
#define PG8_AOFF(u) ((size_t)(((u).pn / g.agdiv) * g.agk) * 2)
    Unit cur, nxt; int ui = 0;
    if (!S.next(0, cur)) return;
    f32x4 acc[2][2][4][2];
#pragma unroll
    for (int a = 0; a < 2; ++a)
#pragma unroll
        for (int b = 0; b < 2; ++b)
#pragma unroll
            for (int m = 0; m < 4; ++m)
#pragma unroll
                for (int n = 0; n < 2; ++n) acc[a][b][m][n] = (f32x4){0.f, 0.f, 0.f, 0.f};
    bf16x8 At[4][2], B0[2][2], B1[2][2];
    const char* cA = (const char*)g.A + (size_t)cur.pm * tstepA + PG8_AOFF(cur); const char* cB = (const char*)g.Bt + (size_t)cur.pn * tstepB;
    PG8_STAGE(PG8_SB(0, 0), cB, voffB); PG8_STAGE(PG8_SB(0, 1), cB + hstepB, voffB); PG8_STAGE(PG8_SA(0, 0), cA, voffA); PG8_STAGE(PG8_SA(0, 1), cA + hstepA, voffA);
    PG8_STAGE(PG8_SB(1, 0), cB + kstep, voffB); PG8_STAGE(PG8_SA(1, 0), cA + kstep, voffA); PG8_STAGE(PG8_SB(1, 1), cB + hstepB + kstep, voffB);
    if (wr == 1) PG8_BAR;
    PG8_WAIT_V(0); PG8_BAR; PG8_BAR;
    for (;;) {
        const bool has_next = S.next(ui + 1, nxt);
        const char* nA = has_next ? (const char*)g.A + (size_t)nxt.pm * tstepA + PG8_AOFF(nxt) : cA; const char* nB = has_next ? (const char*)g.Bt + (size_t)nxt.pn * tstepB : cB;
#define PG8_NOWAIT(n) do { } while (0)
#define PG8_BODY(WV) do { \
            const bool last = (t == nt - 2); \
            const char* a1 = cA + (size_t)(t + 1) * kstep; \
            const char* a2 = last ? nA : cA + (size_t)(t + 2) * kstep; const char* b2 = last ? nB : cB + (size_t)(t + 2) * kstep; \
            const char* a3 = a2 + kstep; const char* b3 = b2 + kstep; \
            PG8_LDB(B0, 0, 0); PG8_LDB(B1, 0, 1); PG8_SCHED; PG8_LDA(At, 0, 0); PG8_STAGE(PG8_SA(1, 1), a1 + hstepA, voffA); \
            WV(8); PG8_WAIT_L(0); PG8_BAR; PG8_MMA(0, 0, At, B0); PG8_MMA(0, 1, At, B1); PG8_BAR; PG8_SCHED; \
            PG8_LDA(At, 0, 1); PG8_STAGE(PG8_SB(0, 0), b2, voffB); PG8_STAGE(PG8_SB(0, 1), b2 + hstepB, voffB); PG8_STAGE(PG8_SA(0, 0), a2, voffA); \
            WV(8); PG8_WAIT_L(0); PG8_BAR; PG8_MMA(1, 0, At, B0); PG8_MMA(1, 1, At, B1); PG8_BAR; PG8_SCHED; \
            PG8_LDB(B0, 1, 0); PG8_LDB(B1, 1, 1); PG8_SCHED; PG8_LDA(At, 1, 0); PG8_STAGE(PG8_SA(0, 1), a2 + hstepA, voffA); \
            PG8_WAIT_V(8); PG8_WAIT_L(0); PG8_BAR; PG8_MMA(0, 0, At, B0); PG8_MMA(0, 1, At, B1); PG8_BAR; PG8_SCHED; \
            PG8_LDA(At, 1, 1); PG8_STAGE(PG8_SB(1, 0), b3, voffB); PG8_STAGE(PG8_SB(1, 1), b3 + hstepB, voffB); PG8_STAGE(PG8_SA(1, 0), a3, voffA); \
            PG8_WAIT_V(8); PG8_WAIT_L(0); PG8_BAR; PG8_MMA(1, 0, At, B0); PG8_MMA(1, 1, At, B1); PG8_BAR; PG8_SCHED; \
        } while (0)
        { const int t = 0; PG8_BODY(PG8_NOWAIT); }
        for (int t = 2; t < nt; t += 2) { PG8_BODY(PG8_WAIT_V); }
        PG8_WAIT_V(0); PG8_BAR;
        if (wr == 0) PG8_BAR;
        E(acc, cur, wr, wc, fr, fq);
        if (!has_next) break;
#pragma unroll
        for (int a = 0; a < 2; ++a)
#pragma unroll
            for (int b = 0; b < 2; ++b)
#pragma unroll
                for (int m = 0; m < 4; ++m)
#pragma unroll
                    for (int n = 0; n < 2; ++n) acc[a][b][m][n] = (f32x4){0.f, 0.f, 0.f, 0.f};
        cur = nxt; cA = nA; cB = nB; ++ui;
        if (wr == 1) PG8_BAR;
    }
    PG8_WAIT_V(0);
    PG8_BAR;
#undef PG8_SA
#undef PG8_SB
#undef PG8_STAGE
#undef PG8_LDA
#undef PG8_LDB
#undef PG8_MMA
#undef PG8_WAIT_V
#undef PG8_WAIT_L
#undef PG8_BAR
#undef PG8_SCHED
#undef PG8_AOFF
#undef PG8_BODY
#undef PG8_NOWAIT
}
}

constexpr int NWAVES = 8, NTHR = 512;
constexpr int ATT_KSTR = 272, ATT_VSTR = 288, ATT_K_OFF = 0, ATT_V_OFF = 256 * ATT_KSTR, ATT_BYTES = ATT_V_OFF + 272 * ATT_VSTR;
constexpr int MISC_OFF = ATT_BYTES;
constexpr int LDS_BYTES = 148480;
static_assert(ATT_BYTES <= LDS_BYTES && pg8::STAGE_BYTES <= LDS_BYTES, "LDS map");

struct Params {
    const float* x; const float* w_in; const float* w_group; const float* pool_scale; const float* w_out; const float* w_qkv; const float* w_ao;
    const float* w_up; const float* w_dn; const float* ln_mix_g; const float* ln_mix_b; const float* ln_mlp_g; const float* ln_mlp_b;
    float* out; unsigned char* ws;
};

__device__ __forceinline__ float wave_sum(float v) {
#pragma unroll
    for (int o = 1; o < 64; o <<= 1) v += __shfl_xor(v, o);
    return v;
}

__device__ __forceinline__ void p0_transpose_item(const float* W, int K, int N, bf16_t* WT, int row_off, LAS float* scr, int item, int lane) {
    const int nblk = N / 32, kb = item / nblk, nb = item % nblk, k0 = 64 * kb, n0 = 32 * nb;
#pragma unroll 8
    for (int i = 0; i < 32; ++i) { const int kk = 2 * i + (lane >> 5); scr[kk * 33 + (lane & 31)] = W[(size_t)(k0 + kk) * N + n0 + (lane & 31)]; }
    asm volatile("s_waitcnt lgkmcnt(0)" ::: "memory");
    const int c = lane & 7;
#pragma unroll
    for (int j = 0; j < 4; ++j) { const int n = (lane >> 3) + 8 * j; const LAS float* s = scr + (8 * c) * 33 + n;
        u32x4 o; o.x = pk2(s[0 * 33], s[1 * 33]); o.y = pk2(s[2 * 33], s[3 * 33]); o.z = pk2(s[4 * 33], s[5 * 33]); o.w = pk2(s[6 * 33], s[7 * 33]);
        *(u32x4*)(WT + (size_t)(row_off + n0 + n) * K + k0 + 8 * c) = o; }
    asm volatile("s_waitcnt lgkmcnt(0)" ::: "memory");
}

__device__ __forceinline__ void phase_prologue(const Params& p, LAS unsigned char* lds, int wave_s) {
    const int tid = MYTID(wave_s), lane = tid & 63, wave = wave_s;
    LAS float* scr = (LAS float*)(lds + wave * 16384);
    const int gw = blockIdx.x * NWAVES + wave, NGW = gridDim.x * NWAVES;
    unsigned char* ws = p.ws;
    constexpr int I_IN = (DM / 64) * (DM / 32), I_G = (512 / 64) * (512 / 32), I_OUT = I_IN, I_QKV = (DM / 64) * (QKVW / 32), I_AO = (GWID / 64) * (DM / 32),
                  I_UP = (DM / 64) * (FF / 32), I_DN = (FF / 64) * (DM / 32);
    constexpr int NITEMS = I_IN + 4 * I_G + I_OUT + I_QKV + I_AO + 2 * I_UP + 2 * I_DN;
    for (int it = gw; it < NITEMS; it += NGW) {
        int r = it;
        if (r < I_IN) { p0_transpose_item(p.w_in, DM, DM, (bf16_t*)(ws + WS_WIN), 0, scr, r, lane); continue; } r -= I_IN;
        if (r < 4 * I_G) { const int g = r / I_G; p0_transpose_item(p.w_group + (size_t)g * 512 * 512, 512, 512, (bf16_t*)(ws + WS_WG), g * 512, scr, r % I_G, lane); continue; } r -= 4 * I_G;
        if (r < I_OUT) { p0_transpose_item(p.w_out, DM, DM, (bf16_t*)(ws + WS_WOUT), 0, scr, r, lane); continue; } r -= I_OUT;
        if (r < I_QKV) { p0_transpose_item(p.w_qkv, DM, QKVW, (bf16_t*)(ws + WS_WQKV), 0, scr, r, lane); continue; } r -= I_QKV;
        if (r < I_AO) { p0_transpose_item(p.w_ao, GWID, DM, (bf16_t*)(ws + WS_WAO), 0, scr, r, lane); continue; } r -= I_AO;
        if (r < 2 * I_UP) { const int l = r / I_UP; p0_transpose_item(p.w_up + (size_t)l * DM * FF, DM, FF, (bf16_t*)(ws + (l ? WS_WUP1 : WS_WUP0)), 0, scr, r % I_UP, lane); continue; } r -= 2 * I_UP;
        { const int l = r / I_DN; p0_transpose_item(p.w_dn + (size_t)l * FF * DM, FF, DM, (bf16_t*)(ws + (l ? WS_WDN1 : WS_WDN0)), 0, scr, r % I_DN, lane); }
    }
    const size_t n8 = (size_t)MTOK * DM / 8; bf16_t* xa = (bf16_t*)(ws + WS_XA);
    for (size_t i = (size_t)blockIdx.x * NTHR + tid; i < n8; i += (size_t)gridDim.x * NTHR) {
        const f32x4 a = *(const f32x4*)(p.x + i * 8), b = *(const f32x4*)(p.x + i * 8 + 4);
        u32x4 o; o.x = pk2(a.x, a.y); o.y = pk2(a.z, a.w); o.z = pk2(b.x, b.y); o.w = pk2(b.z, b.w);
        *(u32x4*)(xa + i * 8) = o;
    }
}

__device__ __forceinline__ void phase_pool(const bf16_t* U, bf16_t* P, int wave_s) {
    const int tid = MYTID(wave_s);
    constexpr int TB = 32, NITEMS = (MTOK / TB) * (DM / 8);
    for (int id = blockIdx.x * NTHR + tid; id < NITEMS; id += gridDim.x * NTHR) {
        const int c8 = id & 255, tb = id >> 8, t0 = tb * TB, pos0 = t0 & (SEQ - 1), g = c8 >> 6, w = 2 << g;
        const bf16_t* up = U + (size_t)t0 * DM + c8 * 8; bf16_t* pp = P + (size_t)t0 * DM + c8 * 8;
        float s[8];
#pragma unroll
        for (int j = 0; j < 8; ++j) s[j] = 0.f;
        for (int k = 1; k <= w; ++k) { if (pos0 - k >= 0) { const u32x4 v = *(const u32x4*)(up - (ptrdiff_t)k * DM);
            s[0] += bf_lo(v.x); s[1] += bf_hi(v.x); s[2] += bf_lo(v.y); s[3] += bf_hi(v.y); s[4] += bf_lo(v.z); s[5] += bf_hi(v.z); s[6] += bf_lo(v.w); s[7] += bf_hi(v.w); } }
        for (int t = 0; t < TB; ++t) {
            const int pos = pos0 + t;
            const u32x4 v = *(const u32x4*)(up + (size_t)t * DM);
            float c[8] = {bf_lo(v.x), bf_hi(v.x), bf_lo(v.y), bf_hi(v.y), bf_lo(v.z), bf_hi(v.z), bf_lo(v.w), bf_hi(v.w)};
#pragma unroll
            for (int j = 0; j < 8; ++j) s[j] += c[j];
            if (pos >= w) { const u32x4 o = *(const u32x4*)(up + (ptrdiff_t)(t - w) * DM);
                s[0] -= bf_lo(o.x); s[1] -= bf_hi(o.x); s[2] -= bf_lo(o.y); s[3] -= bf_hi(o.y); s[4] -= bf_lo(o.z); s[5] -= bf_hi(o.z); s[6] -= bf_lo(o.w); s[7] -= bf_hi(o.w); }
            const float inv = 1.f / (float)(pos + 1 < w ? pos + 1 : w);
            u32x4 r; r.x = pk2(s[0] * inv - c[0], s[1] * inv - c[1]); r.y = pk2(s[2] * inv - c[2], s[3] * inv - c[3]);
            r.z = pk2(s[4] * inv - c[4], s[5] * inv - c[5]); r.w = pk2(s[6] * inv - c[6], s[7] * inv - c[7]);
            *(u32x4*)(pp + (size_t)t * DM) = r;
        }
    }
}

template <bool F32OUT>
__device__ __forceinline__ void phase_ln(const bf16_t* R, const float* gam, const float* bet, bf16_t* XO, float* FO, int wave_s) {
    const int lane = lane_id_opaque(), wave = wave_s;
    const int gw = blockIdx.x * NWAVES + wave, NGW = gridDim.x * NWAVES;
    for (int m0 = gw; m0 < MTOK; m0 += 2 * NGW) {
        const int m1 = m0 + NGW; const bool two = m1 < MTOK; const int m1c = two ? m1 : m0;
        u32x4 wa[4], wb[4];
#pragma unroll
        for (int j = 0; j < 4; ++j) { wa[j] = *((const u32x4*)(R + (size_t)m0 * DM) + lane + 64 * j); wb[j] = *((const u32x4*)(R + (size_t)m1c * DM) + lane + 64 * j); }
#pragma unroll
        for (int rr = 0; rr < 2; ++rr) {
            if (rr == 1 && !two) break;
            const int m = rr ? m1 : m0;
            float v[4][8]; float s = 0.f;
#pragma unroll
            for (int j = 0; j < 4; ++j) { const u32x4 w = rr ? wb[j] : wa[j];
                v[j][0] = bf_lo(w.x); v[j][1] = bf_hi(w.x); v[j][2] = bf_lo(w.y); v[j][3] = bf_hi(w.y); v[j][4] = bf_lo(w.z); v[j][5] = bf_hi(w.z); v[j][6] = bf_lo(w.w); v[j][7] = bf_hi(w.w);
#pragma unroll
                for (int e = 0; e < 8; ++e) s += v[j][e]; }
            const float mean = wave_sum(s) * (1.f / DM); float s2 = 0.f;
#pragma unroll
            for (int j = 0; j < 4; ++j)
#pragma unroll
                for (int e = 0; e < 8; ++e) { v[j][e] -= mean; s2 += v[j][e] * v[j][e]; }
            const float rstd = 1.f / sqrtf(wave_sum(s2) * (1.f / DM) + LN_EPS);
#pragma unroll
            for (int j = 0; j < 4; ++j) {
                const int c0 = (lane + 64 * j) * 8;
                const f32x4 g0 = *(const f32x4*)(gam + c0), g1 = *(const f32x4*)(gam + c0 + 4), b0 = *(const f32x4*)(bet + c0), b1 = *(const f32x4*)(bet + c0 + 4);
                const f32x4 y0 = (f32x4){v[j][0], v[j][1], v[j][2], v[j][3]} * rstd * g0 + b0, y1 = (f32x4){v[j][4], v[j][5], v[j][6], v[j][7]} * rstd * g1 + b1;
                if (F32OUT) { *(f32x4*)(FO + (size_t)m * DM + c0) = y0; *(f32x4*)(FO + (size_t)m * DM + c0 + 4) = y1; }
                else { u32x4 o; o.x = pk2(y0.x, y0.y); o.y = pk2(y0.z, y0.w); o.z = pk2(y1.x, y1.y); o.w = pk2(y1.z, y1.w); *((u32x4*)(XO + (size_t)m * DM) + lane + 64 * j) = o; }
            }
        }
    }
}

__device__ __forceinline__ s16x4 vtr(const LAS unsigned char* p) { return __builtin_bit_cast(s16x4, __builtin_amdgcn_ds_read_tr16_b64_v4i16((LAS s16x4*)p)); }

struct AttnId { int g, b, r, qb, j, ldprev; };
__device__ __forceinline__ AttnId attn_decode(int pass, int c, int i) {
    AttnId a; a.ldprev = 0;
    if (pass == 0) {
        if (i < 8) { a.g = 0; a.j = c & 7; a.b = (c >> 3) & 15; const int half = c >> 7; a.r = 0; a.qb = half * 8 + i; a.ldprev = (half == 1 && i == 0) ? 1 : 0; }
        else { const int ch = 2 * c + ((i - 8) >> 2); a.g = 1; a.j = ch & 7; a.r = (ch >> 3) & 3; a.b = ch >> 5; a.qb = (i - 8) & 3; }
    } else { const int id = 8 * c + i; a.g = 2; a.j = id & 7; a.r = (id >> 3) & 15; a.b = id >> 7; a.qb = 0; }
    return a;
}
__device__ __forceinline__ void attn_fetch(const bf16_t* qkv, const AttnId& a, int blk, u32x4 (&kv)[4], u32x4 (&vv)[4], int tid) {
    const int dsh = 2 * a.g;
    const size_t row0 = (size_t)a.b * SEQ + (size_t)a.r * (SEQ >> dsh) + (size_t)blk * 128;
    const int chunk = tid & 15, rb = tid >> 4;
    const bf16_t* kbase = qkv + ((size_t)((3 + a.g) * 8 + a.j) * MTOK + row0) * HD + chunk * 8;
    const bf16_t* vbase = kbase + (size_t)24 * MTOK * HD;
#pragma unroll
    for (int it = 0; it < 4; ++it) { const size_t ro = (size_t)(it * 32 + rb) * HD; kv[it] = *(const u32x4*)(kbase + ro); vv[it] = *(const u32x4*)(vbase + ro); }
}
__device__ __forceinline__ void attn_fetch_q(const bf16_t* qkv, const AttnId& a, bf16x8 (&qf)[4], int w, int fr, int fq) {
    const int dsh = 2 * a.g;
    const size_t row = (size_t)a.b * SEQ + (size_t)a.r * (SEQ >> dsh) + (size_t)(a.qb * 128 + 16 * w + fr);
    const bf16_t* qb = qkv + ((size_t)(a.g * 8 + a.j) * MTOK + row) * HD + 8 * fq;
#pragma unroll
    for (int kk = 0; kk < 4; ++kk) qf[kk] = *(const bf16x8*)(qb + 32 * kk);
}
__device__ __forceinline__ void attn_put(LAS unsigned char* lds, int half, const u32x4 (&kv)[4], const u32x4 (&vv)[4], int tid) {
    const int chunk = tid & 15, rb = tid >> 4;
#pragma unroll
    for (int it = 0; it < 4; ++it) { const int row = half * 128 + it * 32 + rb;
        *(LAS u32x4*)(lds + ATT_K_OFF + row * ATT_KSTR + chunk * 16) = kv[it]; *(LAS u32x4*)(lds + ATT_V_OFF + row * ATT_VSTR + chunk * 16) = vv[it]; }
}
__device__ __forceinline__ int attn_trow(int T, int ch) { return T >= 16 ? 256 : ((((T >> 3) ^ 1) ^ ch) << 7) + ((T & 7) << 4); }

__device__ __forceinline__ void attn_scores(LAS unsigned char* lds, int ch, bool has_prev, const bf16x8 (&qf)[4], f32x4 (&s)[9], int w, int fr, int fq) {
    LAS unsigned char* Kl = lds + ATT_K_OFF;
#pragma unroll
    for (int tt = 0; tt < 9; ++tt) { s[tt] = (f32x4){0.f, 0.f, 0.f, 0.f}; const int rowb = attn_trow(w + tt, ch);
        if (!has_prev && w + tt < 8) continue;
#pragma unroll
        for (int kk = 0; kk < 4; ++kk) { const bf16x8 av = *(const LAS bf16x8*)(Kl + (rowb + fr) * ATT_KSTR + (32 * kk + 8 * fq) * 2);
            s[tt] = __builtin_amdgcn_mfma_f32_16x16x32_bf16(av, qf[kk], s[tt], 0, 0, 0); } }
}
__device__ __forceinline__ void attn_finish(LAS unsigned char* lds, int ch, const AttnId& a, f32x4 (&s)[9], bf16_t* obuf, float* lsebuf, bf16_t* merged, int w, int fr, int fq) {
    const int g = a.g, j = a.j, qb = a.qb;
    const int dsh = (g == 0) ? 0 : (g == 1 ? 2 : 4), d = 1 << dsh;
    const size_t qrow = (size_t)a.b * SEQ + (size_t)((qb * 128 + 16 * w + fr) << dsh) + a.r;
    LAS unsigned char* Vl = lds + ATT_V_OFF;
    constexpr float LOG2E = 1.4426950408889634f;
    const float sc = 0.08838834764831845f * LOG2E;
    const float slope = exp2f(-8.0f * (float)(g * NSLOT + j + 1) / 24.0f);
    const float sl = slope * (float)d * LOG2E;
    float mx = -INFINITY;
    const float fb = (float)(128 + fr - 4 * fq);
#pragma unroll
    for (int tt = 0; tt < 9; ++tt) {
        const bool tile_ok = (qb > 0) || (w + tt >= 8);
#pragma unroll
        for (int jj = 0; jj < 4; ++jj) {
            const float dist = fb - (float)(16 * tt + jj);
            bool valid = tile_ok;
            if (tt == 0) valid = valid && (dist <= 128.f);
            if (tt == 8) valid = valid && (dist >= 0.f);
            const float v = valid ? (s[tt][jj] * sc - sl * dist) : -INFINITY;
            s[tt][jj] = v; mx = fmaxf(mx, v);
        }
    }
    mx = fmaxf(mx, __shfl_xor(mx, 16)); mx = fmaxf(mx, __shfl_xor(mx, 32));
    float sum = 0.f;
#pragma unroll
    for (int tt = 0; tt < 9; ++tt)
#pragma unroll
        for (int jj = 0; jj < 4; ++jj) { const float e = __builtin_amdgcn_exp2f(s[tt][jj] - mx); s[tt][jj] = e; sum += e; }
    sum += __shfl_xor(sum, 16); sum += __shfl_xor(sum, 32);
    bf16x8 pf[5];
#pragma unroll
    for (int c = 0; c < 5; ++c) {
        u32x4 pw; pw.x = pk2(s[2 * c][0], s[2 * c][1]); pw.y = pk2(s[2 * c][2], s[2 * c][3]);
        if (c < 4) { pw.z = pk2(s[2 * c + 1][0], s[2 * c + 1][1]); pw.w = pk2(s[2 * c + 1][2], s[2 * c + 1][3]); } else { pw.z = 0u; pw.w = 0u; }
        pf[c] = __builtin_bit_cast(bf16x8, pw);
    }
    u32x4 m0[4]; float l0 = 0.f, l1 = 0.f;
    const bf16_t* o0p = obuf + qrow * GWID + j * HD + 32 * fq;
    if (g == 2) { l0 = lsebuf[qrow * NSLOT + j]; l1 = lsebuf[((size_t)MTOK + qrow) * NSLOT + j];
#pragma unroll
        for (int dp = 0; dp < 4; ++dp) m0[dp] = *(const u32x4*)(o0p + 8 * dp); }
    else {
#pragma unroll
        for (int dp = 0; dp < 4; ++dp) m0[dp] = (u32x4){0u, 0u, 0u, 0u}; }
    f32x4 o[8];
#pragma unroll
    for (int dt = 0; dt < 8; ++dt) o[dt] = (f32x4){0.f, 0.f, 0.f, 0.f};
    const int lofs = (4 * fq + (fr >> 2)) * ATT_VSTR + (4 * (fr & 3)) * 2;
#pragma unroll
    for (int c = 0; c < 5; ++c) {
        __builtin_amdgcn_sched_barrier(0);
        if (qb == 0 && w + 2 * c + 1 < 8) continue;
        const LAS unsigned char* v0 = Vl + attn_trow(w + 2 * c, ch) * ATT_VSTR + lofs; const LAS unsigned char* v1 = Vl + attn_trow(w + 2 * c + 1, ch) * ATT_VSTR + lofs;
#pragma unroll
        for (int dt = 0; dt < 8; ++dt) {
            const s16x4 lo = vtr(v0 + dt * 32), hi = vtr(v1 + dt * 32);
            const bf16x8 av = {lo[0], lo[1], lo[2], lo[3], hi[0], hi[1], hi[2], hi[3]};
            o[dt] = __builtin_amdgcn_mfma_f32_16x16x32_bf16(av, pf[c], o[dt], 0, 0, 0);
        }
    }
    const float inv = 1.f / sum;
    const float lse = (mx + log2f(sum)) * 0.6931471805599453f;
    if (g < 2) {
        bf16_t* orow = obuf + ((size_t)g * MTOK + qrow) * GWID + j * HD + 32 * fq;
#pragma unroll
        for (int dp = 0; dp < 4; ++dp) { u32x4 ow; ow.x = pk2(o[2 * dp][0] * inv, o[2 * dp][1] * inv); ow.y = pk2(o[2 * dp][2] * inv, o[2 * dp][3] * inv);
            ow.z = pk2(o[2 * dp + 1][0] * inv, o[2 * dp + 1][1] * inv); ow.w = pk2(o[2 * dp + 1][2] * inv, o[2 * dp + 1][3] * inv); *(u32x4*)(orow + 8 * dp) = ow; }
        if (fq == 0) lsebuf[((size_t)g * MTOK + qrow) * NSLOT + j] = lse;
    } else {
        const float lm = fmaxf(lse, fmaxf(l0, l1));
        float e0 = __expf(l0 - lm), e1 = __expf(l1 - lm), e2 = __expf(lse - lm); const float wi = 1.f / (e0 + e1 + e2); e0 *= wi; e1 *= wi; e2 *= wi * inv;
        bf16_t* mrow = merged + qrow * GWID + j * HD + 4 * fq;
#pragma unroll
        for (int dp = 0; dp < 4; ++dp) { const u32x4 a0 = m0[dp], a1 = *(const u32x4*)(o0p + (size_t)MTOK * GWID + 8 * dp);
            u32x2 ow; ow.x = pk2(e0 * bf_lo(a0.x) + e1 * bf_lo(a1.x) + e2 * o[2 * dp][0], e0 * bf_hi(a0.x) + e1 * bf_hi(a1.x) + e2 * o[2 * dp][1]);
            ow.y = pk2(e0 * bf_lo(a0.y) + e1 * bf_lo(a1.y) + e2 * o[2 * dp][2], e0 * bf_hi(a0.y) + e1 * bf_hi(a1.y) + e2 * o[2 * dp][3]);
            *(u32x2*)(mrow + 32 * dp) = ow;
            ow.x = pk2(e0 * bf_lo(a0.z) + e1 * bf_lo(a1.z) + e2 * o[2 * dp + 1][0], e0 * bf_hi(a0.z) + e1 * bf_hi(a1.z) + e2 * o[2 * dp + 1][1]);
            ow.y = pk2(e0 * bf_lo(a0.w) + e1 * bf_lo(a1.w) + e2 * o[2 * dp + 1][2], e0 * bf_hi(a0.w) + e1 * bf_hi(a1.w) + e2 * o[2 * dp + 1][3]);
            *(u32x2*)(mrow + 32 * dp + 16) = ow; }
    }
}

#define ATT_LBAR() do { asm volatile("s_waitcnt lgkmcnt(0)" ::: "memory"); __builtin_amdgcn_s_barrier(); asm volatile("" ::: "memory"); } while (0)
__device__ __forceinline__ void phase_attn(LAS unsigned char* lds, const bf16_t* qkv, bf16_t* obuf, float* lsebuf, bf16_t* merged, int pass, int wave_s) {
    const int tid = MYTID(wave_s), lane = tid & 63, w = wave_s, fr = lane & 15, fq = lane >> 4;
    const int c = blockIdx.x, n = pass == 0 ? 16 : 8;
    for (int i = tid; i < ATT_BYTES / 16; i += NTHR) ((LAS u32x4*)lds)[i] = (u32x4){0u, 0u, 0u, 0u};
    ATT_LBAR();
    u32x4 kv[4], vv[4]; bf16x8 qn[4];
    AttnId cur = attn_decode(pass, c, 0);
    attn_fetch(qkv, cur, cur.qb, kv, vv, tid); attn_fetch_q(qkv, cur, qn, w, fr, fq);
    for (int i = 0; i < n; ++i) {
        const int ch = cur.qb & 1;
        attn_put(lds, ch, kv, vv, tid);
        if (cur.ldprev) { attn_fetch(qkv, cur, cur.qb - 1, kv, vv, tid); attn_put(lds, ch ^ 1, kv, vv, tid); }
        ATT_LBAR();
        f32x4 sacc[9];
        attn_scores(lds, ch, cur.qb > 0, qn, sacc, w, fr, fq);
        __builtin_amdgcn_sched_barrier(0);
        AttnId nxt = cur;
        if (i + 1 < n) { nxt = attn_decode(pass, c, i + 1); attn_fetch(qkv, nxt, nxt.qb, kv, vv, tid); attn_fetch_q(qkv, nxt, qn, w, fr, fq); }
        attn_finish(lds, ch, cur, sacc, obuf, lsebuf, merged, w, fr, fq);
        ATT_LBAR();
        cur = nxt;
    }
}

#define XB_TMO      128
#define XB_XCNT(j)  (256  + 64 * (j))
#define XB_XSUB(j)  (1280 + 64 * (j))
#define XB_XGEN(j)  (2304 + 64 * (j))
#define XB_TOP      3328
#define XB_TOPGEN   3392
#define XCD_BAR_WORDS 3456
#define XB_SPIN_CAP (1u << 22)
__device__ __forceinline__ unsigned xb_ld(unsigned* p)              { return __hip_atomic_load(p, __ATOMIC_RELAXED, __HIP_MEMORY_SCOPE_AGENT); }
__device__ __forceinline__ unsigned xb_add(unsigned* p, unsigned v) { return __hip_atomic_fetch_add(p, v, __ATOMIC_RELAXED, __HIP_MEMORY_SCOPE_AGENT); }
__device__ __forceinline__ unsigned xb_xcc_id() { return (unsigned)__builtin_amdgcn_s_getreg((3 << 11) | 20) & 0xFu; }
#define XB_SPIN(cond, bar) do { unsigned _sp = 0; while (cond) { __builtin_amdgcn_s_sleep(1); \
    if ((++_sp & 255u) == 0u) { if (xb_ld(&(bar)[XB_TMO])) break; if (_sp > XB_SPIN_CAP) { atomicAdd(&(bar)[XB_TMO], 1u); break; } } } } while (0)
struct XcdBarrier { unsigned* bar; unsigned x; volatile LAS unsigned* st; };
__device__ __forceinline__ XcdBarrier xcd_barrier_post(unsigned* bar, volatile LAS unsigned* st, int wave_s) {
    XcdBarrier b; b.bar = bar; b.x = xb_xcc_id(); b.st = st;
    if (MYTID(wave_s) == 0) (void)xb_add(&bar[XB_XCNT(b.x)], 1u);
    return b;
}
__device__ __forceinline__ void xcd_barrier_complete(unsigned* bar, unsigned x, unsigned& nloc, unsigned& nx) {
    const unsigned G = gridDim.x * gridDim.y * gridDim.z;
    unsigned sum, cnt, mine, sp = 0u;
    for (;;) {
        sum = 0u; cnt = 0u; mine = 0u;
#pragma unroll
        for (unsigned j = 0; j < 16; ++j) { const unsigned c = xb_ld(&bar[XB_XCNT(j)]); sum += c; cnt += (c > 0u) ? 1u : 0u; mine = (j == x) ? c : mine; }
        if (sum == G) break;
        __builtin_amdgcn_s_sleep(1);
        if ((++sp & 255u) == 0u) { if (xb_ld(&bar[XB_TMO])) break; if (sp > XB_SPIN_CAP) { atomicAdd(&bar[XB_TMO], 1u); break; } }
    }
    nloc = mine > 0u ? mine : 1u; nx = cnt > 0u ? cnt : 1u;
}
__device__ __forceinline__ void xcd_barrier(const XcdBarrier& b, int wave_s) {
    asm volatile("s_waitcnt vmcnt(0)" ::: "memory");
    __syncthreads();
    if (MYTID(wave_s) == 0) {
        unsigned* bar = b.bar;
        __builtin_amdgcn_s_waitcnt(0);
        unsigned nloc = b.st[0], nx = b.st[1];
        if (nloc == 0u) { xcd_barrier_complete(bar, b.x, nloc, nx); b.st[0] = nloc; b.st[1] = nx; }
        const unsigned old = xb_add(&bar[XB_XSUB(b.x)], 1u);
        const unsigned gen = old / nloc;
        if (old + 1u == (gen + 1u) * nloc) {
            __builtin_amdgcn_fence(__ATOMIC_RELEASE, "agent");
            asm volatile("s_waitcnt vmcnt(0)" ::: "memory");
            const unsigned og = xb_add(&bar[XB_TOP], 1u);
            const unsigned tg = og / nx;
            if (og + 1u == (tg + 1u) * nx) xb_add(&bar[XB_TOPGEN], 1u);
            else XB_SPIN(xb_ld(&bar[XB_TOPGEN]) == tg, bar);
            __builtin_amdgcn_fence(__ATOMIC_ACQUIRE, "agent");
            xb_add(&bar[XB_XGEN(b.x)], 1u);
            asm volatile("s_waitcnt vmcnt(0)" ::: "memory");
        } else {
            XB_SPIN(xb_ld(&bar[XB_XGEN(b.x)]) == gen, bar);
            __builtin_amdgcn_fence(__ATOMIC_ACQUIRE, "agent");
            asm volatile("s_waitcnt vmcnt(0)" ::: "memory");
        }
    }
    __syncthreads();
}

__global__ void __launch_bounds__(NTHR, 2) fwd_megakernel(Params p) {
    extern __shared__ __attribute__((aligned(16))) unsigned char lds_raw[];
    LAS unsigned char* lds = (LAS unsigned char*)lds_raw;
    cg::grid_group grid = cg::this_grid();
    unsigned char* ws = p.ws;
    bf16_t* XA = (bf16_t*)(ws + WS_XA); bf16_t* XB = (bf16_t*)(ws + WS_XB);
    bf16_t* BIG = (bf16_t*)(ws + WS_BIG);
    bf16_t* U = BIG; bf16_t* PB = BIG + (size_t)MTOK * DM; bf16_t* Y = BIG + 2 * (size_t)MTOK * DM;
    bf16_t* R = (bf16_t*)p.out;
    volatile LAS unsigned* MISC = (volatile LAS unsigned*)(lds + MISC_OFF);
    unsigned* barw = (unsigned*)ws;
    const int G = gridDim.x, c = blockIdx.x;
    constexpr int NOG = 1 << 30;

    const int wave_s = __builtin_amdgcn_readfirstlane((int)threadIdx.x >> 6);
    { const int t0 = MYTID(wave_s); if (blockIdx.x == 0) for (int i = t0; i < XCD_BAR_WORDS; i += NTHR) barw[i] = 0u;
      if (t0 < 2) MISC[t0] = 0u; }
    phase_prologue(p, lds, wave_s);
    grid.sync();
    const XcdBarrier xbar = xcd_barrier_post(barw, MISC, wave_s);
    {
        pg8::Gemm g{XA, (const bf16_t*)(ws + WS_WIN), MTOK, DM, DM, DM, NOG, 0}; pg8::StaticOrder S; S.init(MTOK, DM, G, c);
        pg8::EpiBf16<0, false> E{U, DM, nullptr};
        pg8::gemm_phase(lds, g, S, E, wave_s);
    }
    xcd_barrier(xbar, wave_s);
    phase_pool(U, PB, wave_s);
    xcd_barrier(xbar, wave_s);
    {
        pg8::Gemm g{PB, (const bf16_t*)(ws + WS_WG), MTOK, DM, 512, DM, 2, 512}; pg8::StaticOrder S; S.init(MTOK, DM, G, c);
        pg8::EpiBf16<0, true> E{Y, DM, p.pool_scale};
        pg8::gemm_phase(lds, g, S, E, wave_s);
    }
    xcd_barrier(xbar, wave_s);
    {
        pg8::Gemm g{Y, (const bf16_t*)(ws + WS_WOUT), MTOK, DM, DM, DM, NOG, 0}; pg8::StaticOrder S; S.init(MTOK, DM, G, c);
        pg8::EpiRes E{XA, R, DM, ALPHA};
        pg8::gemm_phase(lds, g, S, E, wave_s);
    }
    xcd_barrier(xbar, wave_s);
    phase_ln<false>(R, p.ln_mix_g, p.ln_mix_b, XB, nullptr, wave_s);
    xcd_barrier(xbar, wave_s);
    {
        pg8::Gemm g{XB, (const bf16_t*)(ws + WS_WUP0), MTOK, FF, DM, DM, NOG, 0}; pg8::StaticOrder S; S.init(MTOK, FF, G, c);
        pg8::EpiBf16<1, false> E{BIG, FF, nullptr};
        pg8::gemm_phase(lds, g, S, E, wave_s);
    }
    xcd_barrier(xbar, wave_s);
    {
        pg8::Gemm g{BIG, (const bf16_t*)(ws + WS_WDN0), MTOK, DM, FF, FF, NOG, 0}; pg8::StaticOrder S; S.init(MTOK, DM, G, c);
        pg8::EpiRes E{XB, R, DM, ALPHA};
        pg8::gemm_phase(lds, g, S, E, wave_s);
    }
    xcd_barrier(xbar, wave_s);
    phase_ln<false>(R, p.ln_mlp_g, p.ln_mlp_b, XA, nullptr, wave_s);
    xcd_barrier(xbar, wave_s);
    {
        pg8::Gemm g{XA, (const bf16_t*)(ws + WS_WQKV), MTOK, QKVW, DM, DM, NOG, 0}; pg8::StaticOrder S; S.init(MTOK, QKVW, G, c);
        pg8::EpiQKV E{BIG};
        pg8::gemm_phase(lds, g, S, E, wave_s);
    }
    xcd_barrier(xbar, wave_s);
    phase_attn(lds, BIG, (bf16_t*)p.out, (float*)(ws + WS_LSE), XB, 0, wave_s);
    xcd_barrier(xbar, wave_s);
    phase_attn(lds, BIG, (bf16_t*)p.out, (float*)(ws + WS_LSE), XB, 1, wave_s);
    xcd_barrier(xbar, wave_s);
    {
        pg8::Gemm g{XB, (const bf16_t*)(ws + WS_WAO), MTOK, DM, GWID, GWID, NOG, 0}; pg8::StaticOrder S; S.init(MTOK, DM, G, c);
        pg8::EpiRes E{XA, R, DM, ALPHA};
        pg8::gemm_phase(lds, g, S, E, wave_s);
    }
    xcd_barrier(xbar, wave_s);
    phase_ln<false>(R, p.ln_mix_g + DM, p.ln_mix_b + DM, XB, nullptr, wave_s);
    xcd_barrier(xbar, wave_s);
    {
        pg8::Gemm g{XB, (const bf16_t*)(ws + WS_WUP1), MTOK, FF, DM, DM, NOG, 0}; pg8::StaticOrder S; S.init(MTOK, FF, G, c);
        pg8::EpiBf16<1, false> E{BIG, FF, nullptr};
        pg8::gemm_phase(lds, g, S, E, wave_s);
    }
    xcd_barrier(xbar, wave_s);
    {
        pg8::Gemm g{BIG, (const bf16_t*)(ws + WS_WDN1), MTOK, DM, FF, FF, NOG, 0}; pg8::StaticOrder S; S.init(MTOK, DM, G, c);
        pg8::EpiRes E{XB, XA, DM, ALPHA};
        pg8::gemm_phase(lds, g, S, E, wave_s);
    }
    xcd_barrier(xbar, wave_s);
    phase_ln<true>(XA, p.ln_mlp_g + DM, p.ln_mlp_b + DM, nullptr, p.out, wave_s);
}

extern "C" void kernel_launch(void* const* d_in, const int* in_sizes, int n_in, void* d_out, int out_size, void* d_ws, size_t ws_size, hipStream_t stream) {
    static int grid = 0;
    if (grid == 0) {
        if (n_in != 13 || in_sizes[0] != MTOK * DM || out_size != MTOK * DM || ws_size < WS_END) {
            fprintf(stderr, "kernel_launch: unexpected shapes: n_in %d in0 %d out %d ws %zu (need %zu); nothing launched\n", n_in, n_in > 0 ? in_sizes[0] : -1, out_size, ws_size, (size_t)WS_END); grid = -1; return; }
        int dev = 0, cus = 0, per_cu = 0;
        hipGetDevice(&dev);
        hipDeviceGetAttribute(&cus, hipDeviceAttributeMultiprocessorCount, dev);
        if (hipFuncSetAttribute((const void*)fwd_megakernel, hipFuncAttributeMaxDynamicSharedMemorySize, LDS_BYTES) != hipSuccess) { fprintf(stderr, "kernel_launch: hipFuncSetAttribute failed\n"); grid = -1; return; }
        if (hipOccupancyMaxActiveBlocksPerMultiprocessor(&per_cu, (const void*)fwd_megakernel, NTHR, LDS_BYTES) != hipSuccess || per_cu < 1) { fprintf(stderr, "kernel_launch: occupancy query gave %d\n", per_cu); per_cu = 1; }
        (void)hipGetLastError();
        grid = cus * per_cu;
        if (grid != 256) { fprintf(stderr, "kernel_launch: this kernel needs exactly 256 co-resident workgroups, got %d\n", grid); if (grid > 256) grid = 256; }
        fprintf(stderr, "kernel_launch: grid %d (cus %d x %d)\n", grid, cus, per_cu);
    }
    if (grid < 0) return;
    Params p{};
    p.x = (const float*)d_in[0]; p.w_in = (const float*)d_in[1]; p.w_group = (const float*)d_in[2]; p.pool_scale = (const float*)d_in[3]; p.w_out = (const float*)d_in[4];
    p.w_qkv = (const float*)d_in[5]; p.w_ao = (const float*)d_in[6]; p.w_up = (const float*)d_in[7]; p.w_dn = (const float*)d_in[8];
    p.ln_mix_g = (const float*)d_in[9]; p.ln_mix_b = (const float*)d_in[10]; p.ln_mlp_g = (const float*)d_in[11]; p.ln_mlp_b = (const float*)d_in[12];
    p.out = (float*)d_out; p.ws = (unsigned char*)d_ws;
    void* args[] = {&p};
    hipError_t e = hipLaunchCooperativeKernel((const void*)fwd_megakernel, dim3(grid), dim3(NTHR), args, LDS_BYTES, stream);
    if (e != hipSuccess) fprintf(stderr, "kernel_launch: cooperative launch failed: %s (grid %d)\n", hipGetErrorString(e), grid);
}
```

```cpp
#include <hip/hip_runtime.h>
#include <hip/hip_cooperative_groups.h>
#include <cstdio>
#include <cstdint>
namespace cg = cooperative_groups;

#define LAS __attribute__((address_space(3)))
typedef unsigned short bf16_t;
typedef short bf16x8 __attribute__((ext_vector_type(8)));
typedef short s16x4 __attribute__((ext_vector_type(4)));
typedef float f32x4 __attribute__((ext_vector_type(4)));
typedef float f32x2 __attribute__((ext_vector_type(2)));
typedef unsigned u32x4 __attribute__((ext_vector_type(4)));
typedef unsigned u32x2 __attribute__((ext_vector_type(2)));

constexpr int DM = 2048, BATCH = 16, SEQ = 2048, MTOK = BATCH * SEQ, FF = 8192, QKVW = 9216, GWID = 1024, HD = 128, NSLOT = 8;
constexpr float LN_EPS = 1e-5f;
constexpr float ALPHA = 1.4142135623730951f;
constexpr size_t MiB = 1u << 20;
constexpr size_t WS_WIN = 1 * MiB, WS_WG = 9 * MiB, WS_WOUT = 11 * MiB, WS_WQKV = 19 * MiB, WS_WAO = 55 * MiB, WS_WUP0 = 59 * MiB, WS_WUP1 = 91 * MiB,
                 WS_WDN0 = 123 * MiB, WS_WDN1 = 155 * MiB, WS_LSE = 188 * MiB, WS_XA = 192 * MiB, WS_XB = 320 * MiB, WS_BIG = 448 * MiB, WS_END = 1024 * MiB;

__device__ __forceinline__ unsigned f2bf(float f) { unsigned u = __builtin_bit_cast(unsigned, f); return (u + 0x7fffu + ((u >> 16) & 1u)) >> 16; }
typedef __bf16 bf16x2_t __attribute__((ext_vector_type(2)));
__device__ __forceinline__ unsigned pk2(float lo, float hi) { const f32x2 v = {lo, hi}; const bf16x2_t b = __builtin_convertvector(v, bf16x2_t); return __builtin_bit_cast(unsigned, b); }
__device__ __forceinline__ float bf_lo(unsigned w) { return __builtin_bit_cast(float, w << 16); }
__device__ __forceinline__ float bf_hi(unsigned w) { return __builtin_bit_cast(float, w & 0xffff0000u); }

__device__ __forceinline__ int lane_id_opaque() { int l; asm volatile("v_mbcnt_lo_u32_b32 %0, -1, 0\n\tv_mbcnt_hi_u32_b32 %0, -1, %0" : "=v"(l)); return l; }
#define MYTID(wave_s) ((wave_s) * 64 + lane_id_opaque())
namespace pg8 {
constexpr int BM = 256, BK = 64, HALF = 128, HTB = HALF * BK * 2, STAGE_BYTES = 8 * HTB, NXCD = 8, WGM = 8;
__host__ __device__ __forceinline__ int lds_byte(int r, int c) { const int st = (r >> 4) * 2 + (c >> 5), rr = r & 15, cc = c & 31, ob = rr * 64 + cc * 2; return st * 1024 + (ob ^ (((ob >> 9) & 1) << 5)); }
__host__ __device__ __forceinline__ void stage_rc(int b, int& R, int& C) { const int st = b / 1024, sb = b % 1024, swz = sb ^ (((sb >> 9) & 1) << 5); R = (st >> 1) * 16 + swz / 64; C = (st & 1) * 32 + (swz % 64) / 2; }
__host__ __device__ __forceinline__ int perm32(int rho) { const int n = rho >> 4, i = rho & 15; return 8 * (i >> 2) + 4 * n + (i & 3); }

struct Unit { int pm, pn; };
struct Gemm { const bf16_t* A; const bf16_t* Bt; int M, N, K, lda, agdiv, agk; int blocked; };

struct StaticOrder {
    int nM, nN, nwg, G, c, wgm;
    __host__ __device__ void init(int M, int N, int G_, int c_) { nM = M / BM; nN = N / BM; nwg = nM * nN; G = G_; c = c_; wgm = 4; }
    __host__ __device__ bool next(int i, Unit& u) const {
        const long L = (long)i * G + c; if (L >= nwg) return false;
        int wgid = (int)L; { const int q = nwg / NXCD, r = nwg % NXCD, xcd = wgid % NXCD, off = wgid / NXCD; wgid = (xcd < r ? xcd * (q + 1) : r * (q + 1) + (xcd - r) * q) + off; }
        const int nig = wgm * nN, gid = wgid / nig, fm = gid * wgm, gsz = (nM - fm) < wgm ? (nM - fm) : wgm;
        u.pm = fm + ((wgid % nig) % gsz); u.pn = (wgid % nig) / gsz; return true;
    }
};

__device__ __forceinline__ unsigned cvt_pk_bf16(float lo, float hi) { unsigned r; asm volatile("v_cvt_pk_bf16_f32 %0, %1, %2" : "=v"(r) : "v"(lo), "v"(hi)); return r; }

template <int ACT, bool SCALE> struct EpiBf16 {
    bf16_t* O; int ldc; const float* colscale;
    __device__ __forceinline__ void operator()(const f32x4 (&acc)[2][2][4][2], const Unit& u, int wr, int wc, int fr, int fq) const {
        const int row0 = u.pm * BM + wr * 64 + fr; const int col0 = u.pn * BM + wc * 32 + 8 * fq;
        f32x4 cs[2][2];
#pragma unroll
        for (int bj = 0; bj < 2; ++bj)
#pragma unroll
            for (int n = 0; n < 2; ++n) cs[bj][n] = SCALE ? *(const f32x4*)(colscale + col0 + bj * HALF + 4 * n) : (f32x4){1.f, 1.f, 1.f, 1.f};
#pragma unroll
        for (int ai = 0; ai < 2; ++ai)
#pragma unroll
            for (int m = 0; m < 4; ++m) { bf16_t* rowp = O + (size_t)(row0 + ai * HALF + m * 16) * ldc + col0;
#pragma unroll
                for (int bj = 0; bj < 2; ++bj) { f32x4 v0 = acc[ai][bj][m][0], v1 = acc[ai][bj][m][1];
                    if (SCALE) { v0 = v0 * cs[bj][0]; v1 = v1 * cs[bj][1]; }
                    if (ACT == 1) {
#pragma unroll
                        for (int j = 0; j < 4; ++j) { const float a = fmaxf(v0[j], 0.f), b = fmaxf(v1[j], 0.f); v0[j] = a * a; v1[j] = b * b; } }
                    u32x4 w; w.x = cvt_pk_bf16(v0[0], v0[1]); w.y = cvt_pk_bf16(v0[2], v0[3]); w.z = cvt_pk_bf16(v1[0], v1[1]); w.w = cvt_pk_bf16(v1[2], v1[3]);
                    *(u32x4*)(rowp + bj * HALF) = w; } }
    }
};
struct EpiRes {
    const bf16_t* X; bf16_t* R; int ldc; float alpha;
    __device__ __forceinline__ void operator()(const f32x4 (&acc)[2][2][4][2], const Unit& u, int wr, int wc, int fr, int fq) const {
        const int row0 = u.pm * BM + wr * 64 + fr; const int col0 = u.pn * BM + wc * 32 + 8 * fq;
#pragma unroll
        for (int ai = 0; ai < 2; ++ai)
#pragma unroll
            for (int m = 0; m < 4; ++m) { const size_t off = (size_t)(row0 + ai * HALF + m * 16) * ldc + col0;
#pragma unroll
                for (int bj = 0; bj < 2; ++bj) { const u32x4 xw = *(const u32x4*)(X + off + bj * HALF);
                    const f32x4 x0 = {bf_lo(xw.x), bf_hi(xw.x), bf_lo(xw.y), bf_hi(xw.y)}, x1 = {bf_lo(xw.z), bf_hi(xw.z), bf_lo(xw.w), bf_hi(xw.w)};
                    const f32x4 v0 = x0 * alpha + acc[ai][bj][m][0], v1 = x1 * alpha + acc[ai][bj][m][1];
                    u32x4 w; w.x = cvt_pk_bf16(v0[0], v0[1]); w.y = cvt_pk_bf16(v0[2], v0[3]); w.z = cvt_pk_bf16(v1[0], v1[1]); w.w = cvt_pk_bf16(v1[2], v1[3]);
                    *(u32x4*)(R + off + bj * HALF) = w; } }
    }
};

struct EpiQKV {
    bf16_t* O;
    __device__ __forceinline__ void operator()(const f32x4 (&acc)[2][2][4][2], const Unit& u, int wr, int wc, int fr, int fq) const {
        const int which = u.pn / 12, g = (u.pn % 12) >> 2, jp = u.pn & 3, dsh = 2 * g;
        const int m0 = u.pm * BM, b = m0 >> 11, tb = (m0 & 2047) + wr * 64 + fr;
        bf16_t* base = O + ((size_t)((which * 3 + g) * 8 + 2 * jp) * MTOK + (size_t)b * 2048) * 128 + wc * 32 + 8 * fq;
#pragma unroll
        for (int ai = 0; ai < 2; ++ai)
#pragma unroll
            for (int m = 0; m < 4; ++m) { const int t = tb + ai * HALF + m * 16; const int tp = ((t & ((1 << dsh) - 1)) << (11 - dsh)) + (t >> dsh);
                bf16_t* rowp = base + (size_t)tp * 128;
#pragma unroll
                for (int bj = 0; bj < 2; ++bj) { const f32x4 v0 = acc[ai][bj][m][0], v1 = acc[ai][bj][m][1];
                    u32x4 w; w.x = cvt_pk_bf16(v0[0], v0[1]); w.y = cvt_pk_bf16(v0[2], v0[3]); w.z = cvt_pk_bf16(v1[0], v1[1]); w.w = cvt_pk_bf16(v1[2], v1[3]);
                    *(u32x4*)(rowp + (size_t)bj * MTOK * 128) = w; } }
    }
};

struct EpiSqReluBlk {
    bf16_t* O; int ktiles;
    __device__ __forceinline__ void operator()(const f32x4 (&acc)[2][2][4][2], const Unit& u, int wr, int wc, int fr, int fq) const {
        const unsigned lane_off = (unsigned)(fr * BK + 8 * fq);
#pragma unroll
        for (int bj = 0; bj < 2; ++bj) { const int kt = u.pn * 4 + bj * 2 + (wc >> 1);
            bf16_t* tb = O + (((size_t)u.pm * ktiles + kt) * BM + wr * 64) * BK + (wc & 1) * 32;
#pragma unroll
            for (int ai = 0; ai < 2; ++ai)
#pragma unroll
                for (int m = 0; m < 4; ++m) { f32x4 v0 = acc[ai][bj][m][0], v1 = acc[ai][bj][m][1];
#pragma unroll
                    for (int j = 0; j < 4; ++j) { const float a = fmaxf(v0[j], 0.f), b = fmaxf(v1[j], 0.f); v0[j] = a * a; v1[j] = b * b; }
                    u32x4 w; w.x = cvt_pk_bf16(v0[0], v0[1]); w.y = cvt_pk_bf16(v0[2], v0[3]); w.z = cvt_pk_bf16(v1[0], v1[1]); w.w = cvt_pk_bf16(v1[2], v1[3]);
                    bf16_t* ub = tb + (ai * HALF + m * 16) * BK;
                    *(u32x4*)(ub + lane_off) = w; } }
    }
};

__device__ __forceinline__ void dma16(const void* sbase, unsigned voff, unsigned lds_dst) {
    unsigned keep;
    asm volatile("s_mov_b32 %0, m0\n\ts_mov_b32 m0, %3\n\ts_nop 0\n\tglobal_load_lds_dwordx4 %2, %1\n\ts_mov_b32 m0, %0" : "=&s"(keep) : "s"(sbase), "v"(voff), "s"(lds_dst) : "memory");
}
template <bool BLK = false, class Epi, class Sched>
__device__ __forceinline__ void gemm_phase(LAS unsigned char* lds, const Gemm g, const Sched& S, const Epi& E, int wave_s) {
    const int tid = MYTID(wave_s), wid = wave_s, lane = tid & 63, wr = wid >> 2, wc = wid & 3, fr = lane & 15, fq = lane >> 4;
    const int K = g.K, nt = K / BK, lda = BLK ? BK : g.lda, ldb = BLK ? BK : K;
    unsigned voffA[2], voffB[2];
#pragma unroll
    for (int i = 0; i < 2; ++i) { int R, C; stage_rc(tid * 16 + i * 8192, R, C); const int Rb = (R & ~31) + perm32(R & 31);
        voffA[i] = (unsigned)(R * lda + C) * 2u; voffB[i] = (unsigned)(Rb * ldb + C) * 2u; }
    const size_t kstep = BLK ? (size_t)BM * BK * 2 : (size_t)(BK * 2);
    const size_t hstepA = (size_t)HALF * lda * 2, hstepB = (size_t)HALF * ldb * 2;
    const size_t tstepA = BLK ? (size_t)nt * BM * BK * 2 : 2 * hstepA, tstepB = BLK ? (size_t)nt * BM * BK * 2 : 2 * hstepB;
    const unsigned ldsw = (unsigned)wid * 1024u;
    const unsigned ldsb = (unsigned)__builtin_amdgcn_readfirstlane((int)((unsigned)(uintptr_t)lds + ldsw));
    const int aoff = lds_byte(wr * 64 + fr, fq * 8), boff = lds_byte(wc * 32 + fr, fq * 8);
#define PG8_SA(b, h) (((b) * 2 + (h)) * HTB)
#define PG8_SB(b, h) ((4 + (b) * 2 + (h)) * HTB)
#define PG8_STAGE(bufoff, gbase, voff) do { _Pragma("unroll") for (int _i = 0; _i < 2; ++_i) \
        dma16((const void*)(gbase), (voff)[_i], ldsb + (unsigned)((bufoff) + _i * 8192)); } while (0)
#define PG8_LDA(dst, b, h) do { _Pragma("unroll") for (int m = 0; m < 4; ++m) _Pragma("unroll") for (int k = 0; k < 2; ++k) dst[m][k] = *(const LAS bf16x8*)(lds + PG8_SA(b, h) + aoff + m * 2048 + k * 1024); } while (0)
#define PG8_LDB(dst, b, h) do { _Pragma("unroll") for (int n = 0; n < 2; ++n) _Pragma("unroll") for (int k = 0; k < 2; ++k) dst[n][k] = *(const LAS bf16x8*)(lds + PG8_SB(b, h) + boff + n * 2048 + k * 1024); } while (0)
#define PG8_MMA(ai, bj, At, Bt) do { __builtin_amdgcn_s_setprio(1); _Pragma("unroll") for (int m = 0; m < 4; ++m) _Pragma("unroll") for (int n = 0; n < 2; ++n) _Pragma("unroll") for (int k = 0; k < 2; ++k) \
        acc[ai][bj][m][n] = __builtin_amdgcn_mfma_f32_16x16x32_bf16(Bt[n][k], At[m][k], acc[ai][bj][m][n], 0, 0, 0); __builtin_amdgcn_s_setprio(0); } while (0)
#define PG8_WAIT_V(n) asm volatile("s_waitcnt vmcnt(" #n ")" ::: "memory")
#define PG8_WAIT_L(n) asm volatile("s_waitcnt lgkmcnt(" #n ")" ::: "memory")
#define PG8_BAR __builtin_amdgcn_s_barrier()
#define PG8_SCHED __builtin_amdgcn_sched_barrier(0)
#define PG8_AOFF(u) ((size_t)(((u).pn / g.agdiv) * g.agk) * 2)
    Unit cur, nxt; int ui = 0;
    if (!S.next(0, cur)) return;
    f32x4 acc[2][2][4][2];
#pragma unroll
    for (int a = 0; a < 2; ++a)
#pragma unroll
        for (int b = 0; b < 2; ++b)
#pragma unroll
            for (int m = 0; m < 4; ++m)
#pragma unroll
                for (int n = 0; n < 2; ++n) acc[a][b][m][n] = (f32x4){0.f, 0.f, 0.f, 0.f};
    bf16x8 At[4][2], B0[2][2], B1[2][2];
    const char* cA = (const char*)g.A + (size_t)cur.pm * tstepA + PG8_AOFF(cur); const char* cB = (const char*)g.Bt + (size_t)cur.pn * tstepB;
    PG8_STAGE(PG8_SB(0, 0), cB, voffB); PG8_STAGE(PG8_SB(0, 1), cB + hstepB, voffB); PG8_STAGE(PG8_SA(0, 0), cA, voffA); PG8_STAGE(PG8_SA(0, 1), cA + hstepA, voffA);
    PG8_STAGE(PG8_SB(1, 0), cB + kstep, voffB); PG8_STAGE(PG8_SA(1, 0), cA + kstep, voffA); PG8_STAGE(PG8_SB(1, 1), cB + hstepB + kstep, voffB);
    if (wr == 1) PG8_BAR;
    PG8_WAIT_V(0); PG8_BAR; PG8_BAR;
    for (;;) {
        const bool has_next = S.next(ui + 1, nxt);
        const char* nA = has_next ? (const char*)g.A + (size_t)nxt.pm * tstepA + PG8_AOFF(nxt) : cA; const char* nB = has_next ? (const char*)g.Bt + (size_t)nxt.pn * tstepB : cB;
#define PG8_NOWAIT(n) do { } while (0)
#define PG8_BODY(WV) do { \
            const bool last = (t == nt - 2); \
            const char* a1 = cA + (size_t)(t + 1) * kstep; \
            const char* a2 = last ? nA : cA + (size_t)(t + 2) * kstep; const char* b2 = last ? nB : cB + (size_t)(t + 2) * kstep; \
            const char* a3 = a2 + kstep; const char* b3 = b2 + kstep; \
            PG8_LDB(B0, 0, 0); PG8_LDB(B1, 0, 1); PG8_SCHED; PG8_LDA(At, 0, 0); PG8_STAGE(PG8_SA(1, 1), a1 + hstepA, voffA); \
            WV(8); PG8_WAIT_L(0); PG8_BAR; PG8_MMA(0, 0, At, B0); PG8_MMA(0, 1, At, B1); PG8_BAR; PG8_SCHED; \
            PG8_LDA(At, 0, 1); PG8_STAGE(PG8_SB(0, 0), b2, voffB); PG8_STAGE(PG8_SB(0, 1), b2 + hstepB, voffB); PG8_STAGE(PG8_SA(0, 0), a2, voffA); \
            WV(8); PG8_WAIT_L(0); PG8_BAR; PG8_MMA(1, 0, At, B0); PG8_MMA(1, 1, At, B1); PG8_BAR; PG8_SCHED; \
            PG8_LDB(B0, 1, 0); PG8_LDB(B1, 1, 1); PG8_SCHED; PG8_LDA(At, 1, 0); PG8_STAGE(PG8_SA(0, 1), a2 + hstepA, voffA); \
            PG8_WAIT_V(8); PG8_WAIT_L(0); PG8_BAR; PG8_MMA(0, 0, At, B0); PG8_MMA(0, 1, At, B1); PG8_BAR; PG8_SCHED; \
            PG8_LDA(At, 1, 1); PG8_STAGE(PG8_SB(1, 0), b3, voffB); PG8_STAGE(PG8_SB(1, 1), b3 + hstepB, voffB); PG8_STAGE(PG8_SA(1, 0), a3, voffA); \
            PG8_WAIT_V(8); PG8_WAIT_L(0); PG8_BAR; PG8_MMA(1, 0, At, B0); PG8_MMA(1, 1, At, B1); PG8_BAR; PG8_SCHED; \
        } while (0)
        { const int t = 0; PG8_BODY(PG8_NOWAIT); }
        for (int t = 2; t < nt; t += 2) { PG8_BODY(PG8_WAIT_V); }
        PG8_WAIT_V(0); PG8_BAR;
        if (wr == 0) PG8_BAR;
        E(acc, cur, wr, wc, fr, fq);
        if (!has_next) break;
#pragma unroll
        for (int a = 0; a < 2; ++a)
#pragma unroll
            for (int b = 0; b < 2; ++b)
#pragma unroll
                for (int m = 0; m < 4; ++m)
#pragma unroll
                    for (int n = 0; n < 2; ++n) acc[a][b][m][n] = (f32x4){0.f, 0.f, 0.f, 0.f};
        cur = nxt; cA = nA; cB = nB; ++ui;
        if (wr == 1) PG8_BAR;
    }
    PG8_WAIT_V(0);
    PG8_BAR;
#undef PG8_SA
#undef PG8_SB
#undef PG8_STAGE
#undef PG8_LDA
#undef PG8_LDB
#undef PG8_MMA
#undef PG8_WAIT_V
#undef PG8_WAIT_L
#undef PG8_BAR
#undef PG8_SCHED
#undef PG8_AOFF
#undef PG8_BODY
#undef PG8_NOWAIT
}
}

constexpr int NWAVES = 8, NTHR = 512;
constexpr int ATT_KSTR = 272, ATT_VSTR = 288, ATT_K_OFF = 0, ATT_V_OFF = 256 * ATT_KSTR, ATT_BYTES = ATT_V_OFF + 272 * ATT_VSTR;
constexpr int MISC_OFF = ATT_BYTES;
constexpr int LDS_BYTES = 148480;
static_assert(ATT_BYTES <= LDS_BYTES && pg8::STAGE_BYTES <= LDS_BYTES, "LDS map");

struct Params {
    const float* x; const float* w_in; const float* w_group; const float* pool_scale; const float* w_out; const float* w_qkv; const float* w_ao;
    const float* w_up; const float* w_dn; const float* ln_mix_g; const float* ln_mix_b; const float* ln_mlp_g; const float* ln_mlp_b;
    float* out; unsigned char* ws;
};

__device__ __forceinline__ float wave_sum(float v) {
#pragma unroll
    for (int o = 1; o < 64; o <<= 1) v += __shfl_xor(v, o);
    return v;
}

__device__ __forceinline__ void p0_transpose_item(const float* W, int K, int N, bf16_t* WT, int row_off, LAS float* scr, int item, int lane, bool blocked = false) {
    const int nblk = N / 32, kb = item / nblk, nb = item % nblk, k0 = 64 * kb, n0 = 32 * nb;
#pragma unroll 8
    for (int i = 0; i < 32; ++i) { const int kk = 2 * i + (lane >> 5); scr[kk * 33 + (lane & 31)] = W[(size_t)(k0 + kk) * N + n0 + (lane & 31)]; }
    asm volatile("s_waitcnt lgkmcnt(0)" ::: "memory");
    const int c = lane & 7;
#pragma unroll
    for (int j = 0; j < 4; ++j) { const int n = (lane >> 3) + 8 * j; const LAS float* s = scr + (8 * c) * 33 + n;
        u32x4 o; o.x = pk2(s[0 * 33], s[1 * 33]); o.y = pk2(s[2 * 33], s[3 * 33]); o.z = pk2(s[4 * 33], s[5 * 33]); o.w = pk2(s[6 * 33], s[7 * 33]);
        const int nn = row_off + n0 + n;
        bf16_t* dst = blocked ? WT + ((size_t)(nn >> 8) * (K / 64) + (k0 >> 6)) * (256 * 64) + (size_t)(nn & 255) * 64 + 8 * c : WT + (size_t)nn * K + k0 + 8 * c;
        *(u32x4*)dst = o; }
    asm volatile("s_waitcnt lgkmcnt(0)" ::: "memory");
}

__device__ __forceinline__ void phase_prologue(const Params& p, LAS unsigned char* lds, int wave_s) {
    const int tid = MYTID(wave_s), lane = tid & 63, wave = wave_s;
    LAS float* scr = (LAS float*)(lds + wave * 16384);
    const int gw = blockIdx.x * NWAVES + wave, NGW = gridDim.x * NWAVES;
    unsigned char* ws = p.ws;
    constexpr int I_IN = (DM / 64) * (DM / 32), I_G = (512 / 64) * (512 / 32), I_OUT = I_IN, I_QKV = (DM / 64) * (QKVW / 32), I_AO = (GWID / 64) * (DM / 32),
                  I_UP = (DM / 64) * (FF / 32), I_DN = (FF / 64) * (DM / 32);
    constexpr int NITEMS = I_IN + 4 * I_G + I_OUT + I_QKV + I_AO + 2 * I_UP + 2 * I_DN;
    for (int it = gw; it < NITEMS; it += NGW) {
        int r = it;
        if (r < I_IN) { p0_transpose_item(p.w_in, DM, DM, (bf16_t*)(ws + WS_WIN), 0, scr, r, lane); continue; } r -= I_IN;
        if (r < 4 * I_G) { const int g = r / I_G; p0_transpose_item(p.w_group + (size_t)g * 512 * 512, 512, 512, (bf16_t*)(ws + WS_WG), g * 512, scr, r % I_G, lane); continue; } r -= 4 * I_G;
        if (r < I_OUT) { p0_transpose_item(p.w_out, DM, DM, (bf16_t*)(ws + WS_WOUT), 0, scr, r, lane); continue; } r -= I_OUT;
        if (r < I_QKV) { p0_transpose_item(p.w_qkv, DM, QKVW, (bf16_t*)(ws + WS_WQKV), 0, scr, r, lane); continue; } r -= I_QKV;
        if (r < I_AO) { p0_transpose_item(p.w_ao, GWID, DM, (bf16_t*)(ws + WS_WAO), 0, scr, r, lane); continue; } r -= I_AO;
        if (r < 2 * I_UP) { const int l = r / I_UP; p0_transpose_item(p.w_up + (size_t)l * DM * FF, DM, FF, (bf16_t*)(ws + (l ? WS_WUP1 : WS_WUP0)), 0, scr, r % I_UP, lane); continue; } r -= 2 * I_UP;
        { const int l = r / I_DN; p0_transpose_item(p.w_dn + (size_t)l * FF * DM, FF, DM, (bf16_t*)(ws + (l ? WS_WDN1 : WS_WDN0)), 0, scr, r % I_DN, lane, true); }
    }
    const size_t n8 = (size_t)MTOK * DM / 8; bf16_t* xa = (bf16_t*)(ws + WS_XA);
    for (size_t i = (size_t)blockIdx.x * NTHR + tid; i < n8; i += (size_t)gridDim.x * NTHR) {
        const f32x4 a = *(const f32x4*)(p.x + i * 8), b = *(const f32x4*)(p.x + i * 8 + 4);
        u32x4 o; o.x = pk2(a.x, a.y); o.y = pk2(a.z, a.w); o.z = pk2(b.x, b.y); o.w = pk2(b.z, b.w);
        *(u32x4*)(xa + i * 8) = o;
    }
}

__device__ __forceinline__ void phase_pool(const bf16_t* U, bf16_t* P, int wave_s) {
    const int tid = MYTID(wave_s);
    constexpr int TB = 32, NITEMS = (MTOK / TB) * (DM / 8);
    for (int id = blockIdx.x * NTHR + tid; id < NITEMS; id += gridDim.x * NTHR) {
        const int c8 = id & 255, tb = id >> 8, t0 = tb * TB, pos0 = t0 & (SEQ - 1), g = c8 >> 6, w = 2 << g;
        const bf16_t* up = U + (size_t)t0 * DM + c8 * 8; bf16_t* pp = P + (size_t)t0 * DM + c8 * 8;
        float s[8];
#pragma unroll
        for (int j = 0; j < 8; ++j) s[j] = 0.f;
        for (int k = 1; k <= w; ++k) { if (pos0 - k >= 0) { const u32x4 v = *(const u32x4*)(up - (ptrdiff_t)k * DM);
            s[0] += bf_lo(v.x); s[1] += bf_hi(v.x); s[2] += bf_lo(v.y); s[3] += bf_hi(v.y); s[4] += bf_lo(v.z); s[5] += bf_hi(v.z); s[6] += bf_lo(v.w); s[7] += bf_hi(v.w); } }
        for (int t = 0; t < TB; ++t) {
            const int pos = pos0 + t;
            const u32x4 v = *(const u32x4*)(up + (size_t)t * DM);
            float c[8] = {bf_lo(v.x), bf_hi(v.x), bf_lo(v.y), bf_hi(v.y), bf_lo(v.z), bf_hi(v.z), bf_lo(v.w), bf_hi(v.w)};
#pragma unroll
            for (int j = 0; j < 8; ++j) s[j] += c[j];
            if (pos >= w) { const u32x4 o = *(const u32x4*)(up + (ptrdiff_t)(t - w) * DM);
                s[0] -= bf_lo(o.x); s[1] -= bf_hi(o.x); s[2] -= bf_lo(o.y); s[3] -= bf_hi(o.y); s[4] -= bf_lo(o.z); s[5] -= bf_hi(o.z); s[6] -= bf_lo(o.w); s[7] -= bf_hi(o.w); }
            const float inv = 1.f / (float)(pos + 1 < w ? pos + 1 : w);
            u32x4 r; r.x = pk2(s[0] * inv - c[0], s[1] * inv - c[1]); r.y = pk2(s[2] * inv - c[2], s[3] * inv - c[3]);
            r.z = pk2(s[4] * inv - c[4], s[5] * inv - c[5]); r.w = pk2(s[6] * inv - c[6], s[7] * inv - c[7]);
            *(u32x4*)(pp + (size_t)t * DM) = r;
        }
    }
}

template <bool F32OUT>
__device__ __forceinline__ void phase_ln(const bf16_t* R, const float* gam, const float* bet, bf16_t* XO, float* FO, int wave_s) {
    const int lane = lane_id_opaque(), wave = wave_s;
    const int gw = blockIdx.x * NWAVES + wave, NGW = gridDim.x * NWAVES;
    for (int m0 = gw; m0 < MTOK; m0 += 2 * NGW) {
        const int m1 = m0 + NGW; const bool two = m1 < MTOK; const int m1c = two ? m1 : m0;
        u32x4 wa[4], wb[4];
#pragma unroll
        for (int j = 0; j < 4; ++j) { wa[j] = *((const u32x4*)(R + (size_t)m0 * DM) + lane + 64 * j); wb[j] = *((const u32x4*)(R + (size_t)m1c * DM) + lane + 64 * j); }
#pragma unroll
        for (int rr = 0; rr < 2; ++rr) {
            if (rr == 1 && !two) break;
            const int m = rr ? m1 : m0;
            float v[4][8]; float s = 0.f;
#pragma unroll
            for (int j = 0; j < 4; ++j) { const u32x4 w = rr ? wb[j] : wa[j];
                v[j][0] = bf_lo(w.x); v[j][1] = bf_hi(w.x); v[j][2] = bf_lo(w.y); v[j][3] = bf_hi(w.y); v[j][4] = bf_lo(w.z); v[j][5] = bf_hi(w.z); v[j][6] = bf_lo(w.w); v[j][7] = bf_hi(w.w);
#pragma unroll
                for (int e = 0; e < 8; ++e) s += v[j][e]; }
            const float mean = wave_sum(s) * (1.f / DM); float s2 = 0.f;
#pragma unroll
            for (int j = 0; j < 4; ++j)
#pragma unroll
                for (int e = 0; e < 8; ++e) { v[j][e] -= mean; s2 += v[j][e] * v[j][e]; }
            const float rstd = 1.f / sqrtf(wave_sum(s2) * (1.f / DM) + LN_EPS);
#pragma unroll
            for (int j = 0; j < 4; ++j) {
                const int c0 = (lane + 64 * j) * 8;
                const f32x4 g0 = *(const f32x4*)(gam + c0), g1 = *(const f32x4*)(gam + c0 + 4), b0 = *(const f32x4*)(bet + c0), b1 = *(const f32x4*)(bet + c0 + 4);
                const f32x4 y0 = (f32x4){v[j][0], v[j][1], v[j][2], v[j][3]} * rstd * g0 + b0, y1 = (f32x4){v[j][4], v[j][5], v[j][6], v[j][7]} * rstd * g1 + b1;
                if (F32OUT) { *(f32x4*)(FO + (size_t)m * DM + c0) = y0; *(f32x4*)(FO + (size_t)m * DM + c0 + 4) = y1; }
                else { u32x4 o; o.x = pk2(y0.x, y0.y); o.y = pk2(y0.z, y0.w); o.z = pk2(y1.x, y1.y); o.w = pk2(y1.z, y1.w); *((u32x4*)(XO + (size_t)m * DM) + lane + 64 * j) = o; }
            }
        }
    }
}

__device__ __forceinline__ s16x4 vtr(const LAS unsigned char* p) { return __builtin_bit_cast(s16x4, __builtin_amdgcn_ds_read_tr16_b64_v4i16((LAS s16x4*)p)); }

struct AttnId { int g, b, r, qb, j, ldprev; };
__device__ __forceinline__ AttnId attn_decode(int pass, int c, int i) {
    AttnId a; a.ldprev = 0;
    if (pass == 0) {
        if (i < 8) { a.g = 0; a.j = c & 7; a.b = (c >> 3) & 15; const int half = c >> 7; a.r = 0; a.qb = half * 8 + i; a.ldprev = (half == 1 && i == 0) ? 1 : 0; }
        else { const int ch = 2 * c + ((i - 8) >> 2); a.g = 1; a.j = ch & 7; a.r = (ch >> 3) & 3; a.b = ch >> 5; a.qb = (i - 8) & 3; }
    } else { const int id = 8 * c + i; a.g = 2; a.j = id & 7; a.r = (id >> 3) & 15; a.b = id >> 7; a.qb = 0; }
    return a;
}
__device__ __forceinline__ void attn_fetch(const bf16_t* qkv, const AttnId& a, int blk, u32x4 (&kv)[4], u32x4 (&vv)[4], int tid) {
    const int dsh = 2 * a.g;
    const size_t row0 = (size_t)a.b * SEQ + (size_t)a.r * (SEQ >> dsh) + (size_t)blk * 128;
    const int chunk = tid & 15, rb = tid >> 4;
    const bf16_t* kbase = qkv + ((size_t)((3 + a.g) * 8 + a.j) * MTOK + row0) * HD + chunk * 8;
    const bf16_t* vbase = kbase + (size_t)24 * MTOK * HD;
#pragma unroll
    for (int it = 0; it < 4; ++it) { const size_t ro = (size_t)(it * 32 + rb) * HD; kv[it] = *(const u32x4*)(kbase + ro); vv[it] = *(const u32x4*)(vbase + ro); }
}
__device__ __forceinline__ void attn_fetch_q(const bf16_t* qkv, const AttnId& a, bf16x8 (&qf)[4], int w, int fr, int fq) {
    const int dsh = 2 * a.g;
    const size_t row = (size_t)a.b * SEQ + (size_t)a.r * (SEQ >> dsh) + (size_t)(a.qb * 128 + 16 * w + fr);
    const bf16_t* qb = qkv + ((size_t)(a.g * 8 + a.j) * MTOK + row) * HD + 8 * fq;
#pragma unroll
    for (int kk = 0; kk < 4; ++kk) qf[kk] = *(const bf16x8*)(qb + 32 * kk);
}
__device__ __forceinline__ void attn_put(LAS unsigned char* lds, int half, const u32x4 (&kv)[4], const u32x4 (&vv)[4], int tid) {
    const int chunk = tid & 15, rb = tid >> 4;
#pragma unroll
    for (int it = 0; it < 4; ++it) { const int row = half * 128 + it * 32 + rb;
        *(LAS u32x4*)(lds + ATT_K_OFF + row * ATT_KSTR + chunk * 16) = kv[it]; *(LAS u32x4*)(lds + ATT_V_OFF + row * ATT_VSTR + chunk * 16) = vv[it]; }
}
__device__ __forceinline__ int attn_trow(int T, int ch) { return T >= 16 ? 256 : ((((T >> 3) ^ 1) ^ ch) << 7) + ((T & 7) << 4); }

__device__ __forceinline__ void attn_scores(LAS unsigned char* lds, int ch, bool has_prev, const bf16x8 (&qf)[4], f32x4 (&s)[9], int w, int fr, int fq) {
    LAS unsigned char* Kl = lds + ATT_K_OFF;
#pragma unroll
    for (int tt = 0; tt < 9; ++tt) { s[tt] = (f32x4){0.f, 0.f, 0.f, 0.f}; const int rowb = attn_trow(w + tt, ch);
        if (!has_prev && w + tt < 8) continue;
#pragma unroll
        for (int kk = 0; kk < 4; ++kk) { const bf16x8 av = *(const LAS bf16x8*)(Kl + (rowb + fr) * ATT_KSTR + (32 * kk + 8 * fq) * 2);
            s[tt] = __builtin_amdgcn_mfma_f32_16x16x32_bf16(av, qf[kk], s[tt], 0, 0, 0); } }
}
__device__ __forceinline__ void attn_finish(LAS unsigned char* lds, int ch, const AttnId& a, f32x4 (&s)[9], bf16_t* obuf, float* lsebuf, bf16_t* merged, int w, int fr, int fq) {
    const int g = a.g, j = a.j, qb = a.qb;
    const int dsh = (g == 0) ? 0 : (g == 1 ? 2 : 4), d = 1 << dsh;
    const size_t qrow = (size_t)a.b * SEQ + (size_t)((qb * 128 + 16 * w + fr) << dsh) + a.r;
    LAS unsigned char* Vl = lds + ATT_V_OFF;
    constexpr float LOG2E = 1.4426950408889634f;
    const float sc = 0.08838834764831845f * LOG2E;
    const float slope = exp2f(-8.0f * (float)(g * NSLOT + j + 1) / 24.0f);
    const float sl = slope * (float)d * LOG2E;
    float mx = -INFINITY;
    const float fb = (float)(128 + fr - 4 * fq);
#pragma unroll
    for (int tt = 0; tt < 9; ++tt) {
        const bool tile_ok = (qb > 0) || (w + tt >= 8);
#pragma unroll
        for (int jj = 0; jj < 4; ++jj) {
            const float dist = fb - (float)(16 * tt + jj);
            bool valid = tile_ok;
            if (tt == 0) valid = valid && (dist <= 128.f);
            if (tt == 8) valid = valid && (dist >= 0.f);
            const float v = valid ? (s[tt][jj] * sc - sl * dist) : -INFINITY;
            s[tt][jj] = v; mx = fmaxf(mx, v);
        }
    }
    mx = fmaxf(mx, __shfl_xor(mx, 16)); mx = fmaxf(mx, __shfl_xor(mx, 32));
    float sum = 0.f;
#pragma unroll
    for (int tt = 0; tt < 9; ++tt)
#pragma unroll
        for (int jj = 0; jj < 4; ++jj) { const float e = __builtin_amdgcn_exp2f(s[tt][jj] - mx); s[tt][jj] = e; sum += e; }
    sum += __shfl_xor(sum, 16); sum += __shfl_xor(sum, 32);
    bf16x8 pf[5];
#pragma unroll
    for (int c = 0; c < 5; ++c) {
        u32x4 pw; pw.x = pk2(s[2 * c][0], s[2 * c][1]); pw.y = pk2(s[2 * c][2], s[2 * c][3]);
        if (c < 4) { pw.z = pk2(s[2 * c + 1][0], s[2 * c + 1][1]); pw.w = pk2(s[2 * c + 1][2], s[2 * c + 1][3]); } else { pw.z = 0u; pw.w = 0u; }
        pf[c] = __builtin_bit_cast(bf16x8, pw);
    }
    u32x4 m0[4]; float l0 = 0.f, l1 = 0.f;
    const bf16_t* o0p = obuf + qrow * GWID + j * HD + 32 * fq;
    if (g == 2) { l0 = lsebuf[qrow * NSLOT + j]; l1 = lsebuf[((size_t)MTOK + qrow) * NSLOT + j];
#pragma unroll
        for (int dp = 0; dp < 4; ++dp) m0[dp] = *(const u32x4*)(o0p + 8 * dp); }
    else {
#pragma unroll
        for (int dp = 0; dp < 4; ++dp) m0[dp] = (u32x4){0u, 0u, 0u, 0u}; }
    f32x4 o[8];
#pragma unroll
    for (int dt = 0; dt < 8; ++dt) o[dt] = (f32x4){0.f, 0.f, 0.f, 0.f};
    const int lofs = (4 * fq + (fr >> 2)) * ATT_VSTR + (4 * (fr & 3)) * 2;
#pragma unroll
    for (int c = 0; c < 5; ++c) {
        __builtin_amdgcn_sched_barrier(0);
        if (qb == 0 && w + 2 * c + 1 < 8) continue;
        const LAS unsigned char* v0 = Vl + attn_trow(w + 2 * c, ch) * ATT_VSTR + lofs; const LAS unsigned char* v1 = Vl + attn_trow(w + 2 * c + 1, ch) * ATT_VSTR + lofs;
#pragma unroll
        for (int dt = 0; dt < 8; ++dt) {
            const s16x4 lo = vtr(v0 + dt * 32), hi = vtr(v1 + dt * 32);
            const bf16x8 av = {lo[0], lo[1], lo[2], lo[3], hi[0], hi[1], hi[2], hi[3]};
            o[dt] = __builtin_amdgcn_mfma_f32_16x16x32_bf16(av, pf[c], o[dt], 0, 0, 0);
        }
    }
    const float inv = 1.f / sum;
    const float lse = (mx + log2f(sum)) * 0.6931471805599453f;
    if (g < 2) {
        bf16_t* orow = obuf + ((size_t)g * MTOK + qrow) * GWID + j * HD + 32 * fq;
#pragma unroll
        for (int dp = 0; dp < 4; ++dp) { u32x4 ow; ow.x = pk2(o[2 * dp][0] * inv, o[2 * dp][1] * inv); ow.y = pk2(o[2 * dp][2] * inv, o[2 * dp][3] * inv);
            ow.z = pk2(o[2 * dp + 1][0] * inv, o[2 * dp + 1][1] * inv); ow.w = pk2(o[2 * dp + 1][2] * inv, o[2 * dp + 1][3] * inv); *(u32x4*)(orow + 8 * dp) = ow; }
        if (fq == 0) lsebuf[((size_t)g * MTOK + qrow) * NSLOT + j] = lse;
    } else {
        const float lm = fmaxf(lse, fmaxf(l0, l1));
        float e0 = __expf(l0 - lm), e1 = __expf(l1 - lm), e2 = __expf(lse - lm); const float wi = 1.f / (e0 + e1 + e2); e0 *= wi; e1 *= wi; e2 *= wi * inv;
        bf16_t* mrow = merged + qrow * GWID + j * HD + 4 * fq;
#pragma unroll
        for (int dp = 0; dp < 4; ++dp) { const u32x4 a0 = m0[dp], a1 = *(const u32x4*)(o0p + (size_t)MTOK * GWID + 8 * dp);
            u32x2 ow; ow.x = pk2(e0 * bf_lo(a0.x) + e1 * bf_lo(a1.x) + e2 * o[2 * dp][0], e0 * bf_hi(a0.x) + e1 * bf_hi(a1.x) + e2 * o[2 * dp][1]);
            ow.y = pk2(e0 * bf_lo(a0.y) + e1 * bf_lo(a1.y) + e2 * o[2 * dp][2], e0 * bf_hi(a0.y) + e1 * bf_hi(a1.y) + e2 * o[2 * dp][3]);
            *(u32x2*)(mrow + 32 * dp) = ow;
            ow.x = pk2(e0 * bf_lo(a0.z) + e1 * bf_lo(a1.z) + e2 * o[2 * dp + 1][0], e0 * bf_hi(a0.z) + e1 * bf_hi(a1.z) + e2 * o[2 * dp + 1][1]);
            ow.y = pk2(e0 * bf_lo(a0.w) + e1 * bf_lo(a1.w) + e2 * o[2 * dp + 1][2], e0 * bf_hi(a0.w) + e1 * bf_hi(a1.w) + e2 * o[2 * dp + 1][3]);
            *(u32x2*)(mrow + 32 * dp + 16) = ow; }
    }
}

#define ATT_LBAR() do { asm volatile("s_waitcnt lgkmcnt(0)" ::: "memory"); __builtin_amdgcn_s_barrier(); asm volatile("" ::: "memory"); } while (0)
__device__ __forceinline__ void phase_attn(LAS unsigned char* lds, const bf16_t* qkv, bf16_t* obuf, float* lsebuf, bf16_t* merged, int pass, int wave_s) {
    const int tid = MYTID(wave_s), lane = tid & 63, w = wave_s, fr = lane & 15, fq = lane >> 4;
    const int c = blockIdx.x, n = pass == 0 ? 16 : 8;
    for (int i = tid; i < ATT_BYTES / 16; i += NTHR) ((LAS u32x4*)lds)[i] = (u32x4){0u, 0u, 0u, 0u};
    ATT_LBAR();
    u32x4 kv[4], vv[4]; bf16x8 qn[4];
    AttnId cur = attn_decode(pass, c, 0);
    attn_fetch(qkv, cur, cur.qb, kv, vv, tid); attn_fetch_q(qkv, cur, qn, w, fr, fq);
    for (int i = 0; i < n; ++i) {
        const int ch = cur.qb & 1;
        attn_put(lds, ch, kv, vv, tid);
        if (cur.ldprev) { attn_fetch(qkv, cur, cur.qb - 1, kv, vv, tid); attn_put(lds, ch ^ 1, kv, vv, tid); }
        ATT_LBAR();
        f32x4 sacc[9];
        attn_scores(lds, ch, cur.qb > 0, qn, sacc, w, fr, fq);
        __builtin_amdgcn_sched_barrier(0);
        AttnId nxt = cur;
        if (i + 1 < n) { nxt = attn_decode(pass, c, i + 1); attn_fetch(qkv, nxt, nxt.qb, kv, vv, tid); attn_fetch_q(qkv, nxt, qn, w, fr, fq); }
        attn_finish(lds, ch, cur, sacc, obuf, lsebuf, merged, w, fr, fq);
        ATT_LBAR();
        cur = nxt;
    }
}

#define XB_TMO      128
#define XB_XCNT(j)  (256  + 64 * (j))
#define XB_XSUB(j)  (1280 + 64 * (j))
#define XB_XGEN(j)  (2304 + 64 * (j))
#define XB_TOP      3328
#define XB_TOPGEN   3392
#define XCD_BAR_WORDS 3456
#define XB_SPIN_CAP (1u << 22)
__device__ __forceinline__ unsigned xb_ld(unsigned* p)              { return __hip_atomic_load(p, __ATOMIC_RELAXED, __HIP_MEMORY_SCOPE_AGENT); }
__device__ __forceinline__ unsigned xb_add(unsigned* p, unsigned v) { return __hip_atomic_fetch_add(p, v, __ATOMIC_RELAXED, __HIP_MEMORY_SCOPE_AGENT); }
__device__ __forceinline__ unsigned xb_xcc_id() { return (unsigned)__builtin_amdgcn_s_getreg((3 << 11) | 20) & 0xFu; }
#define XB_SPIN(cond, bar) do { unsigned _sp = 0; while (cond) { __builtin_amdgcn_s_sleep(1); \
    if ((++_sp & 255u) == 0u) { if (xb_ld(&(bar)[XB_TMO])) break; if (_sp > XB_SPIN_CAP) { atomicAdd(&(bar)[XB_TMO], 1u); break; } } } } while (0)
struct XcdBarrier { unsigned* bar; unsigned x; volatile LAS unsigned* st; };
__device__ __forceinline__ XcdBarrier xcd_barrier_post(unsigned* bar, volatile LAS unsigned* st, int wave_s) {
    XcdBarrier b; b.bar = bar; b.x = xb_xcc_id(); b.st = st;
    if (MYTID(wave_s) == 0) (void)xb_add(&bar[XB_XCNT(b.x)], 1u);
    return b;
}
__device__ __forceinline__ void xcd_barrier_complete(unsigned* bar, unsigned x, unsigned& nloc, unsigned& nx) {
    const unsigned G = gridDim.x * gridDim.y * gridDim.z;
    unsigned sum, cnt, mine, sp = 0u;
    for (;;) {
        sum = 0u; cnt = 0u; mine = 0u;
#pragma unroll
        for (unsigned j = 0; j < 16; ++j) { const unsigned c = xb_ld(&bar[XB_XCNT(j)]); sum += c; cnt += (c > 0u) ? 1u : 0u; mine = (j == x) ? c : mine; }
        if (sum == G) break;
        __builtin_amdgcn_s_sleep(1);
        if ((++sp & 255u) == 0u) { if (xb_ld(&bar[XB_TMO])) break; if (sp > XB_SPIN_CAP) { atomicAdd(&bar[XB_TMO], 1u); break; } }
    }
    nloc = mine > 0u ? mine : 1u; nx = cnt > 0u ? cnt : 1u;
}
__device__ __forceinline__ void xcd_barrier(const XcdBarrier& b, int wave_s) {
    asm volatile("s_waitcnt vmcnt(0)" ::: "memory");
    __syncthreads();
    if (MYTID(wave_s) == 0) {
        unsigned* bar = b.bar;
        __builtin_amdgcn_s_waitcnt(0);
        unsigned nloc = b.st[0], nx = b.st[1];
        if (nloc == 0u) { xcd_barrier_complete(bar, b.x, nloc, nx); b.st[0] = nloc; b.st[1] = nx; }
        const unsigned old = xb_add(&bar[XB_XSUB(b.x)], 1u);
        const unsigned gen = old / nloc;
        if (old + 1u == (gen + 1u) * nloc) {
            __builtin_amdgcn_fence(__ATOMIC_RELEASE, "agent");
            asm volatile("s_waitcnt vmcnt(0)" ::: "memory");
            const unsigned og = xb_add(&bar[XB_TOP], 1u);
            const unsigned tg = og / nx;
            if (og + 1u == (tg + 1u) * nx) xb_add(&bar[XB_TOPGEN], 1u);
            else XB_SPIN(xb_ld(&bar[XB_TOPGEN]) == tg, bar);
            __builtin_amdgcn_fence(__ATOMIC_ACQUIRE, "agent");
            xb_add(&bar[XB_XGEN(b.x)], 1u);
            asm volatile("s_waitcnt vmcnt(0)" ::: "memory");
        } else {
            XB_SPIN(xb_ld(&bar[XB_XGEN(b.x)]) == gen, bar);
            __builtin_amdgcn_fence(__ATOMIC_ACQUIRE, "agent");
            asm volatile("s_waitcnt vmcnt(0)" ::: "memory");
        }
    }
    __syncthreads();
}

__global__ void __launch_bounds__(NTHR, 2) fwd_megakernel(Params p) {
    extern __shared__ __attribute__((aligned(16))) unsigned char lds_raw[];
    LAS unsigned char* lds = (LAS unsigned char*)lds_raw;
    cg::grid_group grid = cg::this_grid();
    unsigned char* ws = p.ws;
    bf16_t* XA = (bf16_t*)(ws + WS_XA); bf16_t* XB = (bf16_t*)(ws + WS_XB);
    bf16_t* BIG = (bf16_t*)(ws + WS_BIG);
    bf16_t* U = BIG; bf16_t* PB = BIG + (size_t)MTOK * DM; bf16_t* Y = BIG + 2 * (size_t)MTOK * DM;
    bf16_t* R = (bf16_t*)p.out;
    volatile LAS unsigned* MISC = (volatile LAS unsigned*)(lds + MISC_OFF);
    unsigned* barw = (unsigned*)ws;
    const int G = gridDim.x, c = blockIdx.x;
    constexpr int NOG = 1 << 30;

    const int wave_s = __builtin_amdgcn_readfirstlane((int)threadIdx.x >> 6);
    { const int t0 = MYTID(wave_s); if (blockIdx.x == 0) for (int i = t0; i < XCD_BAR_WORDS; i += NTHR) barw[i] = 0u;
      if (t0 < 2) MISC[t0] = 0u; }
    phase_prologue(p, lds, wave_s);
    grid.sync();
    const XcdBarrier xbar = xcd_barrier_post(barw, MISC, wave_s);
    {
        pg8::Gemm g{XA, (const bf16_t*)(ws + WS_WIN), MTOK, DM, DM, DM, NOG, 0, 0}; pg8::StaticOrder S; S.init(MTOK, DM, G, c);
        pg8::EpiBf16<0, false> E{U, DM, nullptr};
        pg8::gemm_phase(lds, g, S, E, wave_s);
    }
    xcd_barrier(xbar, wave_s);
    phase_pool(U, PB, wave_s);
    xcd_barrier(xbar, wave_s);
    {
        pg8::Gemm g{PB, (const bf16_t*)(ws + WS_WG), MTOK, DM, 512, DM, 2, 512, 0}; pg8::StaticOrder S; S.init(MTOK, DM, G, c);
        pg8::EpiBf16<0, true> E{Y, DM, p.pool_scale};
        pg8::gemm_phase(lds, g, S, E, wave_s);
    }
    xcd_barrier(xbar, wave_s);
    {
        pg8::Gemm g{Y, (const bf16_t*)(ws + WS_WOUT), MTOK, DM, DM, DM, NOG, 0, 0}; pg8::StaticOrder S; S.init(MTOK, DM, G, c);
        pg8::EpiRes E{XA, R, DM, ALPHA};
        pg8::gemm_phase(lds, g, S, E, wave_s);
    }
    xcd_barrier(xbar, wave_s);
    phase_ln<false>(R, p.ln_mix_g, p.ln_mix_b, XB, nullptr, wave_s);
    xcd_barrier(xbar, wave_s);
    {
        pg8::Gemm g{XB, (const bf16_t*)(ws + WS_WUP0), MTOK, FF, DM, DM, NOG, 0, 0}; pg8::StaticOrder S; S.init(MTOK, FF, G, c);
        pg8::EpiSqReluBlk E{BIG, FF / 64};
        pg8::gemm_phase(lds, g, S, E, wave_s);
    }
    xcd_barrier(xbar, wave_s);
    {
        pg8::Gemm g{BIG, (const bf16_t*)(ws + WS_WDN0), MTOK, DM, FF, FF, NOG, 0, 1}; pg8::StaticOrder S; S.init(MTOK, DM, G, c);
        pg8::EpiRes E{XB, R, DM, ALPHA};
        pg8::gemm_phase<true>(lds, g, S, E, wave_s);
    }
    xcd_barrier(xbar, wave_s);
    phase_ln<false>(R, p.ln_mlp_g, p.ln_mlp_b, XA, nullptr, wave_s);
    xcd_barrier(xbar, wave_s);
    {
        pg8::Gemm g{XA, (const bf16_t*)(ws + WS_WQKV), MTOK, QKVW, DM, DM, NOG, 0, 0}; pg8::StaticOrder S; S.init(MTOK, QKVW, G, c);
        pg8::EpiQKV E{BIG};
        pg8::gemm_phase(lds, g, S, E, wave_s);
    }
    xcd_barrier(xbar, wave_s);
    phase_attn(lds, BIG, (bf16_t*)p.out, (float*)(ws + WS_LSE), XB, 0, wave_s);
    xcd_barrier(xbar, wave_s);
    phase_attn(lds, BIG, (bf16_t*)p.out, (float*)(ws + WS_LSE), XB, 1, wave_s);
    xcd_barrier(xbar, wave_s);
    {
        pg8::Gemm g{XB, (const bf16_t*)(ws + WS_WAO), MTOK, DM, GWID, GWID, NOG, 0, 0}; pg8::StaticOrder S; S.init(MTOK, DM, G, c);
        pg8::EpiRes E{XA, R, DM, ALPHA};
        pg8::gemm_phase(lds, g, S, E, wave_s);
    }
    xcd_barrier(xbar, wave_s);
    phase_ln<false>(R, p.ln_mix_g + DM, p.ln_mix_b + DM, XB, nullptr, wave_s);
    xcd_barrier(xbar, wave_s);
    {
        pg8::Gemm g{XB, (const bf16_t*)(ws + WS_WUP1), MTOK, FF, DM, DM, NOG, 0, 0}; pg8::StaticOrder S; S.init(MTOK, FF, G, c);
        pg8::EpiSqReluBlk E{BIG, FF / 64};
        pg8::gemm_phase(lds, g, S, E, wave_s);
    }
    xcd_barrier(xbar, wave_s);
    {
        pg8::Gemm g{BIG, (const bf16_t*)(ws + WS_WDN1), MTOK, DM, FF, FF, NOG, 0, 1}; pg8::StaticOrder S; S.init(MTOK, DM, G, c);
        pg8::EpiRes E{XB, XA, DM, ALPHA};
        pg8::gemm_phase<true>(lds, g, S, E, wave_s);
    }
    xcd_barrier(xbar, wave_s);
    phase_ln<true>(XA, p.ln_mlp_g + DM, p.ln_mlp_b + DM, nullptr, p.out, wave_s);
}

extern "C" void kernel_launch(void* const* d_in, const int* in_sizes, int n_in, void* d_out, int out_size, void* d_ws, size_t ws_size, hipStream_t stream) {
    static int grid = 0;
    if (grid == 0) {
        if (n_in != 13 || in_sizes[0] != MTOK * DM || out_size != MTOK * DM || ws_size < WS_END) {
            fprintf(stderr, "kernel_launch: unexpected shapes: n_in %d in0 %d out %d ws %zu (need %zu); nothing launched\n", n_in, n_in > 0 ? in_sizes[0] : -1, out_size, ws_size, (size_t)WS_END); grid = -1; return; }
        int dev = 0, cus = 0, per_cu = 0;
        hipGetDevice(&dev);
        hipDeviceGetAttribute(&cus, hipDeviceAttributeMultiprocessorCount, dev);
        if (hipFuncSetAttribute((const void*)fwd_megakernel, hipFuncAttributeMaxDynamicSharedMemorySize, LDS_BYTES) != hipSuccess) { fprintf(stderr, "kernel_launch: hipFuncSetAttribute failed\n"); grid = -1; return; }
        if (hipOccupancyMaxActiveBlocksPerMultiprocessor(&per_cu, (const void*)fwd_megakernel, NTHR, LDS_BYTES) != hipSuccess || per_cu < 1) { fprintf(stderr, "kernel_launch: occupancy query gave %d\n", per_cu); per_cu = 1; }
        (void)hipGetLastError();
        grid = cus * per_cu;
        if (grid != 256) { fprintf(stderr, "kernel_launch: this kernel needs exactly 256 co-resident workgroups, got %d\n", grid); if (grid > 256) grid = 256; }
        fprintf(stderr, "kernel_launch: grid %d (cus %d x %d)\n", grid, cus, per_cu);
    }
    if (grid < 0) return;
    Params p{};
    p.x = (const float*)d_in[0]; p.w_in = (const float*)d_in[1]; p.w_group = (const float*)d_in[2]; p.pool_scale = (const float*)d_in[3]; p.w_out = (const float*)d_in[4];
    p.w_qkv = (const float*)d_in[5]; p.w_ao = (const float*)d_in[6]; p.w_up = (const float*)d_in[7]; p.w_dn = (const float*)d_in[8];
    p.ln_mix_g = (const float*)d_in[9]; p.ln_mix_b = (const float*)d_in[10]; p.ln_mlp_g = (const float*)d_in[11]; p.ln_mlp_b = (const float*)d_in[12];
    p.out = (float*)d_out; p.ws = (unsigned char*)d_ws;
    void* args[] = {&p};
    hipError_t e = hipLaunchCooperativeKernel((const void*)fwd_megakernel, dim3(grid), dim3(NTHR), args, LDS_BYTES, stream);
    if (e != hipSuccess) fprintf(stderr, "kernel_launch: cooperative launch failed: %s (grid %d)\n", hipGetErrorString(e), grid);
}
```

```cpp
#include <hip/hip_runtime.h>
#include <hip/hip_cooperative_groups.h>
#include <cstdio>
#include <cstdint>
namespace cg = cooperative_groups;

#define LAS __attribute__((address_space(3)))
typedef unsigned short bf16_t;
typedef short bf16x8 __attribute__((ext_vector_type(8)));
typedef short s16x4 __attribute__((ext_vector_type(4)));
typedef float f32x4 __attribute__((ext_vector_type(4)));
typedef float f32x2 __attribute__((ext_vector_type(2)));
typedef unsigned u32x4 __attribute__((ext_vector_type(4)));
typedef unsigned u32x2 __attribute__((ext_vector_type(2)));

constexpr int DM = 2048, BATCH = 16, SEQ = 2048, MTOK = BATCH * SEQ, FF = 8192, QKVW = 9216, GWID = 1024, HD = 128, NSLOT = 8;
constexpr float LN_EPS = 1e-5f;
constexpr float ALPHA = 1.4142135623730951f;
constexpr size_t MiB = 1u << 20;
constexpr size_t WS_WIN = 1 * MiB, WS_WG = 9 * MiB, WS_WOUT = 11 * MiB, WS_WQKV = 19 * MiB, WS_WAO = 55 * MiB, WS_WUP0 = 59 * MiB, WS_WUP1 = 91 * MiB,
                 WS_WDN0 = 123 * MiB, WS_WDN1 = 155 * MiB, WS_LSE = 188 * MiB, WS_XA = 192 * MiB, WS_XB = 320 * MiB, WS_BIG = 448 * MiB, WS_END = 1024 * MiB;

__device__ __forceinline__ unsigned f2bf(float f) { unsigned u = __builtin_bit_cast(unsigned, f); return (u + 0x7fffu + ((u >> 16) & 1u)) >> 16; }
typedef __bf16 bf16x2_t __attribute__((ext_vector_type(2)));
__device__ __forceinline__ unsigned pk2(float lo, float hi) { const f32x2 v = {lo, hi}; const bf16x2_t b = __builtin_convertvector(v, bf16x2_t); return __builtin_bit_cast(unsigned, b); }
__device__ __forceinline__ float bf_lo(unsigned w) { return __builtin_bit_cast(float, w << 16); }
__device__ __forceinline__ float bf_hi(unsigned w) { return __builtin_bit_cast(float, w & 0xffff0000u); }

__device__ __forceinline__ int lane_id_opaque() { int l; asm volatile("v_mbcnt_lo_u32_b32 %0, -1, 0\n\tv_mbcnt_hi_u32_b32 %0, -1, %0" : "=v"(l)); return l; }
#define MYTID(wave_s) ((wave_s) * 64 + lane_id_opaque())
namespace pg8 {
constexpr int BM = 256, BK = 64, HALF = 128, HTB = HALF * BK * 2, STAGE_BYTES = 8 * HTB, NXCD = 8, WGM = 8;
__host__ __device__ __forceinline__ int lds_byte(int r, int c) { const int st = (r >> 4) * 2 + (c >> 5), rr = r & 15, cc = c & 31, ob = rr * 64 + cc * 2; return st * 1024 + (ob ^ (((ob >> 9) & 1) << 5)); }
__host__ __device__ __forceinline__ void stage_rc(int b, int& R, int& C) { const int st = b / 1024, sb = b % 1024, swz = sb ^ (((sb >> 9) & 1) << 5); R = (st >> 1) * 16 + swz / 64; C = (st & 1) * 32 + (swz % 64) / 2; }
__host__ __device__ __forceinline__ int perm32(int rho) { const int n = rho >> 4, i = rho & 15; return 8 * (i >> 2) + 4 * n + (i & 3); }

struct Unit { int pm, pn; };
struct Gemm { const bf16_t* A; const bf16_t* Bt; int M, N, K, lda, agdiv, agk; int blocked; };

struct StaticOrder {
    int nM, nN, nwg, G, c, wgm;
    __host__ __device__ void init(int M, int N, int G_, int c_) { nM = M / BM; nN = N / BM; nwg = nM * nN; G = G_; c = c_; wgm = 4; }
    __host__ __device__ bool next(int i, Unit& u) const {
        const long L = (long)i * G + c; if (L >= nwg) return false;
        int wgid = (int)L; { const int q = nwg / NXCD, r = nwg % NXCD, xcd = wgid % NXCD, off = wgid / NXCD; wgid = (xcd < r ? xcd * (q + 1) : r * (q + 1) + (xcd - r) * q) + off; }
        const int nig = wgm * nN, gid = wgid / nig, fm = gid * wgm, gsz = (nM - fm) < wgm ? (nM - fm) : wgm;
        u.pm = fm + ((wgid % nig) % gsz); u.pn = (wgid % nig) / gsz; return true;
    }
};

__device__ __forceinline__ unsigned cvt_pk_bf16(float lo, float hi) { unsigned r; asm volatile("v_cvt_pk_bf16_f32 %0, %1, %2" : "=v"(r) : "v"(lo), "v"(hi)); return r; }

template <int ACT, bool SCALE> struct EpiBf16 {
    bf16_t* O; int ldc; const float* colscale;
    __device__ __forceinline__ void operator()(const f32x4 (&acc)[2][2][4][2], const Unit& u, int wr, int wc, int fr, int fq) const {
        const int row0 = u.pm * BM + wr * 64 + fr; const int col0 = u.pn * BM + wc * 32 + 8 * fq;
        f32x4 cs[2][2];
#pragma unroll
        for (int bj = 0; bj < 2; ++bj)
#pragma unroll
            for (int n = 0; n < 2; ++n) cs[bj][n] = SCALE ? *(const f32x4*)(colscale + col0 + bj * HALF + 4 * n) : (f32x4){1.f, 1.f, 1.f, 1.f};
#pragma unroll
        for (int ai = 0; ai < 2; ++ai)
#pragma unroll
            for (int m = 0; m < 4; ++m) { bf16_t* rowp = O + (size_t)(row0 + ai * HALF + m * 16) * ldc + col0;
#pragma unroll
                for (int bj = 0; bj < 2; ++bj) { f32x4 v0 = acc[ai][bj][m][0], v1 = acc[ai][bj][m][1];
                    if (SCALE) { v0 = v0 * cs[bj][0]; v1 = v1 * cs[bj][1]; }
                    if (ACT == 1) {
#pragma unroll
                        for (int j = 0; j < 4; ++j) { const float a = fmaxf(v0[j], 0.f), b = fmaxf(v1[j], 0.f); v0[j] = a * a; v1[j] = b * b; } }
                    u32x4 w; w.x = cvt_pk_bf16(v0[0], v0[1]); w.y = cvt_pk_bf16(v0[2], v0[3]); w.z = cvt_pk_bf16(v1[0], v1[1]); w.w = cvt_pk_bf16(v1[2], v1[3]);
                    *(u32x4*)(rowp + bj * HALF) = w; } }
    }
};
struct EpiRes {
    const bf16_t* X; bf16_t* R; int ldc; float alpha;
    __device__ __forceinline__ void operator()(const f32x4 (&acc)[2][2][4][2], const Unit& u, int wr, int wc, int fr, int fq) const {
        const int row0 = u.pm * BM + wr * 64 + fr; const int col0 = u.pn * BM + wc * 32 + 8 * fq;
#pragma unroll
        for (int ai = 0; ai < 2; ++ai)
#pragma unroll
            for (int m = 0; m < 4; ++m) { const size_t off = (size_t)(row0 + ai * HALF + m * 16) * ldc + col0;
#pragma unroll
                for (int bj = 0; bj < 2; ++bj) { const u32x4 xw = *(const u32x4*)(X + off + bj * HALF);
                    const f32x4 x0 = {bf_lo(xw.x), bf_hi(xw.x), bf_lo(xw.y), bf_hi(xw.y)}, x1 = {bf_lo(xw.z), bf_hi(xw.z), bf_lo(xw.w), bf_hi(xw.w)};
                    const f32x4 v0 = x0 * alpha + acc[ai][bj][m][0], v1 = x1 * alpha + acc[ai][bj][m][1];
                    u32x4 w; w.x = cvt_pk_bf16(v0[0], v0[1]); w.y = cvt_pk_bf16(v0[2], v0[3]); w.z = cvt_pk_bf16(v1[0], v1[1]); w.w = cvt_pk_bf16(v1[2], v1[3]);
                    *(u32x4*)(R + off + bj * HALF) = w; } }
    }
};

struct EpiQKV {
    bf16_t* O;
    __device__ __forceinline__ void operator()(const f32x4 (&acc)[2][2][4][2], const Unit& u, int wr, int wc, int fr, int fq) const {
        const int which = u.pn / 12, g = (u.pn % 12) >> 2, jp = u.pn & 3, dsh = 2 * g;
        const int m0 = u.pm * BM, b = m0 >> 11, tb = (m0 & 2047) + wr * 64 + fr;
        bf16_t* base = O + ((size_t)((which * 3 + g) * 8 + 2 * jp) * MTOK + (size_t)b * 2048) * 128 + wc * 32 + 8 * fq;
#pragma unroll
        for (int ai = 0; ai < 2; ++ai)
#pragma unroll
            for (int m = 0; m < 4; ++m) { const int t = tb + ai * HALF + m * 16; const int tp = ((t & ((1 << dsh) - 1)) << (11 - dsh)) + (t >> dsh);
                bf16_t* rowp = base + (size_t)tp * 128;
#pragma unroll
                for (int bj = 0; bj < 2; ++bj) { const f32x4 v0 = acc[ai][bj][m][0], v1 = acc[ai][bj][m][1];
                    u32x4 w; w.x = cvt_pk_bf16(v0[0], v0[1]); w.y = cvt_pk_bf16(v0[2], v0[3]); w.z = cvt_pk_bf16(v1[0], v1[1]); w.w = cvt_pk_bf16(v1[2], v1[3]);
                    *(u32x4*)(rowp + (size_t)bj * MTOK * 128) = w; } }
    }
};

struct EpiSqReluBlk {
    bf16_t* O; int ktiles;
    __device__ __forceinline__ void operator()(const f32x4 (&acc)[2][2][4][2], const Unit& u, int wr, int wc, int fr, int fq) const {
        const unsigned lane_off = (unsigned)(fr * BK + 8 * fq);
#pragma unroll
        for (int bj = 0; bj < 2; ++bj) { const int kt = u.pn * 4 + bj * 2 + (wc >> 1);
            bf16_t* tb = O + (((size_t)u.pm * ktiles + kt) * BM + wr * 64) * BK + (wc & 1) * 32;
#pragma unroll
            for (int ai = 0; ai < 2; ++ai)
#pragma unroll
                for (int m = 0; m < 4; ++m) { f32x4 v0 = acc[ai][bj][m][0], v1 = acc[ai][bj][m][1];
#pragma unroll
                    for (int j = 0; j < 4; ++j) { const float a = fmaxf(v0[j], 0.f), b = fmaxf(v1[j], 0.f); v0[j] = a * a; v1[j] = b * b; }
                    u32x4 w; w.x = cvt_pk_bf16(v0[0], v0[1]); w.y = cvt_pk_bf16(v0[2], v0[3]); w.z = cvt_pk_bf16(v1[0], v1[1]); w.w = cvt_pk_bf16(v1[2], v1[3]);
                    bf16_t* ub = tb + (ai * HALF + m * 16) * BK;
                    *(u32x4*)(ub + lane_off) = w; } }
    }
};

__device__ __forceinline__ void dma16(const void* sbase, unsigned voff, unsigned lds_dst) {
    unsigned keep;
    asm volatile("s_mov_b32 %0, m0\n\ts_mov_b32 m0, %3\n\ts_nop 0\n\tglobal_load_lds_dwordx4 %2, %1\n\ts_mov_b32 m0, %0" : "=&s"(keep) : "s"(sbase), "v"(voff), "s"(lds_dst) : "memory");
}
template <bool BLK = false, class Epi, class Sched>
__device__ __forceinline__ void gemm_phase(LAS unsigned char* lds, const Gemm g, const Sched& S, const Epi& E, int wave_s) {
    const int tid = MYTID(wave_s), wid = wave_s, lane = tid & 63, wr = wid >> 2, wc = wid & 3, fr = lane & 15, fq = lane >> 4;
    const int K = g.K, nt = K / BK, lda = BLK ? BK : g.lda, ldb = BLK ? BK : K;
    unsigned voffA[2], voffB[2];
#pragma unroll
    for (int i = 0; i < 2; ++i) { int R, C; stage_rc(tid * 16 + i * 8192, R, C); const int Rb = (R & ~31) + perm32(R & 31);
        voffA[i] = (unsigned)(R * lda + C) * 2u; voffB[i] = (unsigned)(Rb * ldb + C) * 2u; }
    const size_t kstep = BLK ? (size_t)BM * BK * 2 : (size_t)(BK * 2);
    const size_t hstepA = (size_t)HALF * lda * 2, hstepB = (size_t)HALF * ldb * 2;
    const size_t tstepA = BLK ? (size_t)nt * BM * BK * 2 : 2 * hstepA, tstepB = BLK ? (size_t)nt * BM * BK * 2 : 2 * hstepB;
    const unsigned ldsw = (unsigned)wid * 1024u;
    const unsigned ldsb = (unsigned)__builtin_amdgcn_readfirstlane((int)((unsigned)(uintptr_t)lds + ldsw));
    const int aoff = lds_byte(wr * 64 + fr, fq * 8), boff = lds_byte(wc * 32 + fr, fq * 8);
#define PG8_SA(b, h) (((b) * 2 + (h)) * HTB)
#define PG8_SB(b, h) ((4 + (b) * 2 + (h)) * HTB)
#define PG8_STAGE(bufoff, gbase, voff) do { _Pragma("unroll") for (int _i = 0; _i < 2; ++_i) \
        dma16((const void*)(gbase), (voff)[_i], ldsb + (unsigned)((bufoff) + _i * 8192)); } while (0)
#define PG8_LDA(dst, b, h) do { _Pragma("unroll") for (int m = 0; m < 4; ++m) _Pragma("unroll") for (int k = 0; k < 2; ++k) dst[m][k] = *(const LAS bf16x8*)(lds + PG8_SA(b, h) + aoff + m * 2048 + k * 1024); } while (0)
#define PG8_LDB(dst, b, h) do { _Pragma("unroll") for (int n = 0; n < 2; ++n) _Pragma("unroll") for (int k = 0; k < 2; ++k) dst[n][k] = *(const LAS bf16x8*)(lds + PG8_SB(b, h) + boff + n * 2048 + k * 1024); } while (0)
#define PG8_MMA(ai, bj, At, Bt) do { __builtin_amdgcn_s_setprio(1); _Pragma("unroll") for (int m = 0; m < 4; ++m) _Pragma("unroll") for (int n = 0; n < 2; ++n) _Pragma("unroll") for (int k = 0; k < 2; ++k) \
        acc[ai][bj][m][n] = __builtin_amdgcn_mfma_f32_16x16x32_bf16(Bt[n][k], At[m][k], acc[ai][bj][m][n], 0, 0, 0); __builtin_amdgcn_s_setprio(0); } while (0)
#define PG8_WAIT_V(n) asm volatile("s_waitcnt vmcnt(" #n ")" ::: "memory")
#define PG8_WAIT_L(n) asm volatile("s_waitcnt lgkmcnt(" #n ")" ::: "memory")
#define PG8_BAR __builtin_amdgcn_s_barrier()
#define PG8_SCHED __builtin_amdgcn_sched_barrier(0)
#define PG8_AOFF(u) ((size_t)(((u).pn / g.agdiv) * g.agk) * 2)
    Unit cur, nxt; int ui = 0;
    if (!S.next(0, cur)) return;
    f32x4 acc[2][2][4][2];
#pragma unroll
    for (int a = 0; a < 2; ++a)
#pragma unroll
        for (int b = 0; b < 2; ++b)
#pragma unroll
            for (int m = 0; m < 4; ++m)
#pragma unroll
                for (int n = 0; n < 2; ++n) acc[a][b][m][n] = (f32x4){0.f, 0.f, 0.f, 0.f};
    bf16x8 At[4][2], B0[2][2], B1[2][2];
    const char* cA = (const char*)g.A + (size_t)cur.pm * tstepA + PG8_AOFF(cur); const char* cB = (const char*)g.Bt + (size_t)cur.pn * tstepB;
    PG8_STAGE(PG8_SB(0, 0), cB, voffB); PG8_STAGE(PG8_SB(0, 1), cB + hstepB, voffB); PG8_STAGE(PG8_SA(0, 0), cA, voffA); PG8_STAGE(PG8_SA(0, 1), cA + hstepA, voffA);
    PG8_STAGE(PG8_SB(1, 0), cB + kstep, voffB); PG8_STAGE(PG8_SA(1, 0), cA + kstep, voffA); PG8_STAGE(PG8_SB(1, 1), cB + hstepB + kstep, voffB);
    if (wr == 1) PG8_BAR;
    PG8_WAIT_V(0); PG8_BAR; PG8_BAR;
    for (;;) {
        const bool has_next = S.next(ui + 1, nxt);
        const char* nA = has_next ? (const char*)g.A + (size_t)nxt.pm * tstepA + PG8_AOFF(nxt) : cA; const char* nB = has_next ? (const char*)g.Bt + (size_t)nxt.pn * tstepB : cB;
#define PG8_NOWAIT(n) do { } while (0)
#define PG8_BODY(WV) do { \
            const bool last = (t == nt - 2); \
            const char* a1 = cA + (size_t)(t + 1) * kstep; \
            const char* a2 = last ? nA : cA + (size_t)(t + 2) * kstep; const char* b2 = last ? nB : cB + (size_t)(t + 2) * kstep; \
            const char* a3 = a2 + kstep; const char* b3 = b2 + kstep; \
            PG8_LDB(B0, 0, 0); PG8_LDB(B1, 0, 1); PG8_SCHED; PG8_LDA(At, 0, 0); PG8_STAGE(PG8_SA(1, 1), a1 + hstepA, voffA); \
            WV(8); PG8_WAIT_L(0); PG8_BAR; PG8_MMA(0, 0, At, B0); PG8_MMA(0, 1, At, B1); PG8_BAR; PG8_SCHED; \
            PG8_LDA(At, 0, 1); PG8_STAGE(PG8_SB(0, 0), b2, voffB); PG8_STAGE(PG8_SB(0, 1), b2 + hstepB, voffB); PG8_STAGE(PG8_SA(0, 0), a2, voffA); \
            WV(8); PG8_WAIT_L(0); PG8_BAR; PG8_MMA(1, 0, At, B0); PG8_MMA(1, 1, At, B1); PG8_BAR; PG8_SCHED; \
            PG8_LDB(B0, 1, 0); PG8_LDB(B1, 1, 1); PG8_SCHED; PG8_LDA(At, 1, 0); PG8_STAGE(PG8_SA(0, 1), a2 + hstepA, voffA); \
            PG8_WAIT_V(8); PG8_WAIT_L(0); PG8_BAR; PG8_MMA(0, 0, At, B0); PG8_MMA(0, 1, At, B1); PG8_BAR; PG8_SCHED; \
            PG8_LDA(At, 1, 1); PG8_STAGE(PG8_SB(1, 0), b3, voffB); PG8_STAGE(PG8_SB(1, 1), b3 + hstepB, voffB); PG8_STAGE(PG8_SA(1, 0), a3, voffA); \
            PG8_WAIT_V(8); PG8_WAIT_L(0); PG8_BAR; PG8_MMA(1, 0, At, B0); PG8_MMA(1, 1, At, B1); PG8_BAR; PG8_SCHED; \
        } while (0)
        { const int t = 0; PG8_BODY(PG8_NOWAIT); }
        for (int t = 2; t < nt; t += 2) { PG8_BODY(PG8_WAIT_V); }
        PG8_WAIT_V(0); PG8_BAR;
        if (wr == 0) PG8_BAR;
        E(acc, cur, wr, wc, fr, fq);
        if (!has_next) break;
#pragma unroll
        for (int a = 0; a < 2; ++a)
#pragma unroll
            for (int b = 0; b < 2; ++b)
#pragma unroll
                for (int m = 0; m < 4; ++m)
#pragma unroll
                    for (int n = 0; n < 2; ++n) acc[a][b][m][n] = (f32x4){0.f, 0.f, 0.f, 0.f};
        cur = nxt; cA = nA; cB = nB; ++ui;
        if (wr == 1) PG8_BAR;
    }
    PG8_WAIT_V(0);
    PG8_BAR;
#undef PG8_SA
#undef PG8_SB
#undef PG8_STAGE
#undef PG8_LDA
#undef PG8_LDB
#undef PG8_MMA
#undef PG8_WAIT_V
#undef PG8_WAIT_L
#undef PG8_BAR
#undef PG8_SCHED
#undef PG8_AOFF
#undef PG8_BODY
#undef PG8_NOWAIT
}
}

constexpr int NWAVES = 8, NTHR = 512;
constexpr int ATT_KSTR = 272, ATT_VSTR = 288, ATT_K_OFF = 0, ATT_V_OFF = 256 * ATT_KSTR, ATT_BYTES = ATT_V_OFF + 272 * ATT_VSTR;
constexpr int MISC_OFF = ATT_BYTES;
constexpr int LDS_BYTES = 148480;
static_assert(ATT_BYTES <= LDS_BYTES && pg8::STAGE_BYTES <= LDS_BYTES, "LDS map");

struct Params {
    const float* x; const float* w_in; const float* w_group; const float* pool_scale; const float* w_out; const float* w_qkv; const float* w_ao;
    const float* w_up; const float* w_dn; const float* ln_mix_g; const float* ln_mix_b; const float* ln_mlp_g; const float* ln_mlp_b;
    float* out; unsigned char* ws;
};

__device__ __forceinline__ float wave_sum(float v) {
#pragma unroll
    for (int o = 1; o < 64; o <<= 1) v += __shfl_xor(v, o);
    return v;
}

__device__ __forceinline__ void p0_transpose_item(const float* W, int K, int N, bf16_t* WT, int row_off, LAS float* scr, int item, int lane, bool blocked = false) {
    const int nblk = N / 32, kb = item / nblk, nb = item % nblk, k0 = 64 * kb, n0 = 32 * nb;
#pragma unroll 8
    for (int i = 0; i < 32; ++i) { const int kk = 2 * i + (lane >> 5); scr[kk * 33 + (lane & 31)] = W[(size_t)(k0 + kk) * N + n0 + (lane & 31)]; }
    asm volatile("s_waitcnt lgkmcnt(0)" ::: "memory");
    const int c = lane & 7;
#pragma unroll
    for (int j = 0; j < 4; ++j) { const int n = (lane >> 3) + 8 * j; const LAS float* s = scr + (8 * c) * 33 + n;
        u32x4 o; o.x = pk2(s[0 * 33], s[1 * 33]); o.y = pk2(s[2 * 33], s[3 * 33]); o.z = pk2(s[4 * 33], s[5 * 33]); o.w = pk2(s[6 * 33], s[7 * 33]);
        const int nn = row_off + n0 + n;
        bf16_t* dst = blocked ? WT + ((size_t)(nn >> 8) * (K / 64) + (k0 >> 6)) * (256 * 64) + (size_t)(nn & 255) * 64 + 8 * c : WT + (size_t)nn * K + k0 + 8 * c;
        *(u32x4*)dst = o; }
    asm volatile("s_waitcnt lgkmcnt(0)" ::: "memory");
}

__device__ __forceinline__ void phase_prologue(const Params& p, LAS unsigned char* lds, int wave_s) {
    const int tid = MYTID(wave_s), lane = tid & 63, wave = wave_s;
    LAS float* scr = (LAS float*)(lds + wave * 16384);
    const int gw = blockIdx.x * NWAVES + wave, NGW = gridDim.x * NWAVES;
    unsigned char* ws = p.ws;
    constexpr int I_IN = (DM / 64) * (DM / 32), I_G = (512 / 64) * (512 / 32), I_OUT = I_IN, I_QKV = (DM / 64) * (QKVW / 32), I_AO = (GWID / 64) * (DM / 32),
                  I_UP = (DM / 64) * (FF / 32), I_DN = (FF / 64) * (DM / 32);
    constexpr int NITEMS = I_IN + 4 * I_G + I_OUT + I_QKV + I_AO + 2 * I_UP + 2 * I_DN;
    for (int it = gw; it < NITEMS; it += NGW) {
        int r = it;
        if (r < I_IN) { p0_transpose_item(p.w_in, DM, DM, (bf16_t*)(ws + WS_WIN), 0, scr, r, lane); continue; } r -= I_IN;
        if (r < 4 * I_G) { const int g = r / I_G; p0_transpose_item(p.w_group + (size_t)g * 512 * 512, 512, 512, (bf16_t*)(ws + WS_WG), g * 512, scr, r % I_G, lane); continue; } r -= 4 * I_G;
        if (r < I_OUT) { p0_transpose_item(p.w_out, DM, DM, (bf16_t*)(ws + WS_WOUT), 0, scr, r, lane); continue; } r -= I_OUT;
        if (r < I_QKV) { p0_transpose_item(p.w_qkv, DM, QKVW, (bf16_t*)(ws + WS_WQKV), 0, scr, r, lane); continue; } r -= I_QKV;
        if (r < I_AO) { p0_transpose_item(p.w_ao, GWID, DM, (bf16_t*)(ws + WS_WAO), 0, scr, r, lane); continue; } r -= I_AO;
        if (r < 2 * I_UP) { const int l = r / I_UP; p0_transpose_item(p.w_up + (size_t)l * DM * FF, DM, FF, (bf16_t*)(ws + (l ? WS_WUP1 : WS_WUP0)), 0, scr, r % I_UP, lane); continue; } r -= 2 * I_UP;
        { const int l = r / I_DN; p0_transpose_item(p.w_dn + (size_t)l * FF * DM, FF, DM, (bf16_t*)(ws + (l ? WS_WDN1 : WS_WDN0)), 0, scr, r % I_DN, lane, true); }
    }
    const size_t n8 = (size_t)MTOK * DM / 8; bf16_t* xa = (bf16_t*)(ws + WS_XA);
    for (size_t i = (size_t)blockIdx.x * NTHR + tid; i < n8; i += (size_t)gridDim.x * NTHR) {
        const f32x4 a = *(const f32x4*)(p.x + i * 8), b = *(const f32x4*)(p.x + i * 8 + 4);
        u32x4 o; o.x = pk2(a.x, a.y); o.y = pk2(a.z, a.w); o.z = pk2(b.x, b.y); o.w = pk2(b.z, b.w);
        *(u32x4*)(xa + i * 8) = o;
    }
}

__device__ __forceinline__ void phase_pool(const bf16_t* U, bf16_t* P, int wave_s) {
    const int tid = MYTID(wave_s);
    constexpr int TB = 32, NITEMS = (MTOK / TB) * (DM / 8);
    for (int id = blockIdx.x * NTHR + tid; id < NITEMS; id += gridDim.x * NTHR) {
        const int c8 = id & 255, tb = id >> 8, t0 = tb * TB, pos0 = t0 & (SEQ - 1), g = c8 >> 6, w = 2 << g;
        const bf16_t* up = U + (size_t)t0 * DM + c8 * 8; bf16_t* pp = P + (size_t)t0 * DM + c8 * 8;
        float s[8];
#pragma unroll
        for (int j = 0; j < 8; ++j) s[j] = 0.f;
        for (int k = 1; k <= w; ++k) { if (pos0 - k >= 0) { const u32x4 v = *(const u32x4*)(up - (ptrdiff_t)k * DM);
            s[0] += bf_lo(v.x); s[1] += bf_hi(v.x); s[2] += bf_lo(v.y); s[3] += bf_hi(v.y); s[4] += bf_lo(v.z); s[5] += bf_hi(v.z); s[6] += bf_lo(v.w); s[7] += bf_hi(v.w); } }
        for (int t = 0; t < TB; ++t) {
            const int pos = pos0 + t;
            const u32x4 v = *(const u32x4*)(up + (size_t)t * DM);
            float c[8] = {bf_lo(v.x), bf_hi(v.x), bf_lo(v.y), bf_hi(v.y), bf_lo(v.z), bf_hi(v.z), bf_lo(v.w), bf_hi(v.w)};
#pragma unroll
            for (int j = 0; j < 8; ++j) s[j] += c[j];
            if (pos >= w) { const u32x4 o = *(const u32x4*)(up + (ptrdiff_t)(t - w) * DM);
                s[0] -= bf_lo(o.x); s[1] -= bf_hi(o.x); s[2] -= bf_lo(o.y); s[3] -= bf_hi(o.y); s[4] -= bf_lo(o.z); s[5] -= bf_hi(o.z); s[6] -= bf_lo(o.w); s[7] -= bf_hi(o.w); }
            const float inv = 1.f / (float)(pos + 1 < w ? pos + 1 : w);
            u32x4 r; r.x = pk2(s[0] * inv - c[0], s[1] * inv - c[1]); r.y = pk2(s[2] * inv - c[2], s[3] * inv - c[3]);
            r.z = pk2(s[4] * inv - c[4], s[5] * inv - c[5]); r.w = pk2(s[6] * inv - c[6], s[7] * inv - c[7]);
            *(u32x4*)(pp + (size_t)t * DM) = r;
        }
    }
}

template <bool F32OUT>
__device__ __forceinline__ void phase_ln(const bf16_t* R, const float* gam, const float* bet, bf16_t* XO, float* FO, int wave_s) {
    const int lane = lane_id_opaque(), wave = wave_s;
    const int gw = blockIdx.x * NWAVES + wave, NGW = gridDim.x * NWAVES;
    for (int m0 = gw; m0 < MTOK; m0 += 2 * NGW) {
        const int m1 = m0 + NGW; const bool two = m1 < MTOK; const int m1c = two ? m1 : m0;
        u32x4 wa[4], wb[4];
#pragma unroll
        for (int j = 0; j < 4; ++j) { wa[j] = *((const u32x4*)(R + (size_t)m0 * DM) + lane + 64 * j); wb[j] = *((const u32x4*)(R + (size_t)m1c * DM) + lane + 64 * j); }
#pragma unroll
        for (int rr = 0; rr < 2; ++rr) {
            if (rr == 1 && !two) break;
            const int m = rr ? m1 : m0;
            float v[4][8]; float s = 0.f;
#pragma unroll
            for (int j = 0; j < 4; ++j) { const u32x4 w = rr ? wb[j] : wa[j];
                v[j][0] = bf_lo(w.x); v[j][1] = bf_hi(w.x); v[j][2] = bf_lo(w.y); v[j][3] = bf_hi(w.y); v[j][4] = bf_lo(w.z); v[j][5] = bf_hi(w.z); v[j][6] = bf_lo(w.w); v[j][7] = bf_hi(w.w);
#pragma unroll
                for (int e = 0; e < 8; ++e) s += v[j][e]; }
            const float mean = wave_sum(s) * (1.f / DM); float s2 = 0.f;
#pragma unroll
            for (int j = 0; j < 4; ++j)
#pragma unroll
                for (int e = 0; e < 8; ++e) { v[j][e] -= mean; s2 += v[j][e] * v[j][e]; }
            const float rstd = 1.f / sqrtf(wave_sum(s2) * (1.f / DM) + LN_EPS);
#pragma unroll
            for (int j = 0; j < 4; ++j) {
                const int c0 = (lane + 64 * j) * 8;
                const f32x4 g0 = *(const f32x4*)(gam + c0), g1 = *(const f32x4*)(gam + c0 + 4), b0 = *(const f32x4*)(bet + c0), b1 = *(const f32x4*)(bet + c0 + 4);
                const f32x4 y0 = (f32x4){v[j][0], v[j][1], v[j][2], v[j][3]} * rstd * g0 + b0, y1 = (f32x4){v[j][4], v[j][5], v[j][6], v[j][7]} * rstd * g1 + b1;
                if (F32OUT) { *(f32x4*)(FO + (size_t)m * DM + c0) = y0; *(f32x4*)(FO + (size_t)m * DM + c0 + 4) = y1; }
                else { u32x4 o; o.x = pk2(y0.x, y0.y); o.y = pk2(y0.z, y0.w); o.z = pk2(y1.x, y1.y); o.w = pk2(y1.z, y1.w); *((u32x4*)(XO + (size_t)m * DM) + lane + 64 * j) = o; }
            }
        }
    }
}

__device__ __forceinline__ s16x4 vtr(const LAS unsigned char* p) { return __builtin_bit_cast(s16x4, __builtin_amdgcn_ds_read_tr16_b64_v4i16((LAS s16x4*)p)); }

struct AttnId { int g, b, r, qb, j, ldprev; };
__device__ __forceinline__ AttnId attn_decode(int pass, int c, int i) {
    AttnId a; a.ldprev = 0;
    if (pass == 0) {
        if (i < 8) { a.g = 0; a.j = c & 7; a.b = (c >> 3) & 15; const int half = c >> 7; a.r = 0; a.qb = half * 8 + i; a.ldprev = (half == 1 && i == 0) ? 1 : 0; }
        else { const int ch = 2 * c + ((i - 8) >> 2); a.g = 1; a.j = ch & 7; a.r = (ch >> 3) & 3; a.b = ch >> 5; a.qb = (i - 8) & 3; }
    } else { const int id = 8 * c + i; a.g = 2; a.j = id & 7; a.r = (id >> 3) & 15; a.b = id >> 7; a.qb = 0; }
    return a;
}
__device__ __forceinline__ void attn_fetch(const bf16_t* qkv, const AttnId& a, int blk, u32x4 (&kv)[4], u32x4 (&vv)[4], int tid) {
    const int dsh = 2 * a.g;
    const size_t row0 = (size_t)a.b * SEQ + (size_t)a.r * (SEQ >> dsh) + (size_t)blk * 128;
    const int chunk = tid & 15, rb = tid >> 4;
    const bf16_t* kbase = qkv + ((size_t)((3 + a.g) * 8 + a.j) * MTOK + row0) * HD + chunk * 8;
    const bf16_t* vbase = kbase + (size_t)24 * MTOK * HD;
#pragma unroll
    for (int it = 0; it < 4; ++it) { const size_t ro = (size_t)(it * 32 + rb) * HD; kv[it] = *(const u32x4*)(kbase + ro); vv[it] = *(const u32x4*)(vbase + ro); }
}
__device__ __forceinline__ void attn_fetch_q(const bf16_t* qkv, const AttnId& a, bf16x8 (&qf)[4], int w, int fr, int fq) {
    const int dsh = 2 * a.g;
    const size_t row = (size_t)a.b * SEQ + (size_t)a.r * (SEQ >> dsh) + (size_t)(a.qb * 128 + 16 * w + fr);
    const bf16_t* qb = qkv + ((size_t)(a.g * 8 + a.j) * MTOK + row) * HD + 8 * fq;
#pragma unroll
    for (int kk = 0; kk < 4; ++kk) qf[kk] = *(const bf16x8*)(qb + 32 * kk);
}
__device__ __forceinline__ void attn_put(LAS unsigned char* lds, int half, const u32x4 (&kv)[4], const u32x4 (&vv)[4], int tid) {
    const int chunk = tid & 15, rb = tid >> 4;
#pragma unroll
    for (int it = 0; it < 4; ++it) { const int row = half * 128 + it * 32 + rb;
        *(LAS u32x4*)(lds + ATT_K_OFF + row * ATT_KSTR + chunk * 16) = kv[it]; *(LAS u32x4*)(lds + ATT_V_OFF + row * ATT_VSTR + chunk * 16) = vv[it]; }
}
__device__ __forceinline__ int attn_trow(int T, int ch) { return T >= 16 ? 256 : ((((T >> 3) ^ 1) ^ ch) << 7) + ((T & 7) << 4); }

__device__ __forceinline__ void attn_scores(LAS unsigned char* lds, int ch, bool has_prev, const bf16x8 (&qf)[4], f32x4 (&s)[9], int w, int fr, int fq) {
    LAS unsigned char* Kl = lds + ATT_K_OFF;
#pragma unroll
    for (int tt = 0; tt < 9; ++tt) { s[tt] = (f32x4){0.f, 0.f, 0.f, 0.f}; const int rowb = attn_trow(w + tt, ch);
        if (!has_prev && w + tt < 8) continue;
#pragma unroll
        for (int kk = 0; kk < 4; ++kk) { const bf16x8 av = *(const LAS bf16x8*)(Kl + (rowb + fr) * ATT_KSTR + (32 * kk + 8 * fq) * 2);
            s[tt] = __builtin_amdgcn_mfma_f32_16x16x32_bf16(av, qf[kk], s[tt], 0, 0, 0); } }
}
__device__ __forceinline__ void attn_finish(LAS unsigned char* lds, int ch, const AttnId& a, f32x4 (&s)[9], bf16_t* obuf, float* lsebuf, bf16_t* merged, int w, int fr, int fq) {
    const int g = a.g, j = a.j, qb = a.qb;
    const int dsh = (g == 0) ? 0 : (g == 1 ? 2 : 4), d = 1 << dsh;
    const size_t qrow = (size_t)a.b * SEQ + (size_t)((qb * 128 + 16 * w + fr) << dsh) + a.r;
    LAS unsigned char* Vl = lds + ATT_V_OFF;
    constexpr float LOG2E = 1.4426950408889634f;
    const float sc = 0.08838834764831845f * LOG2E;
    const float slope = exp2f(-8.0f * (float)(g * NSLOT + j + 1) / 24.0f);
    const float sl = slope * (float)d * LOG2E;
    float mx = -INFINITY;
    const float fb = (float)(128 + fr - 4 * fq);
#pragma unroll
    for (int tt = 0; tt < 9; ++tt) {
        const bool tile_ok = (qb > 0) || (w + tt >= 8);
#pragma unroll
        for (int jj = 0; jj < 4; ++jj) {
            const float dist = fb - (float)(16 * tt + jj);
            bool valid = tile_ok;
            if (tt == 0) valid = valid && (dist <= 128.f);
            if (tt == 8) valid = valid && (dist >= 0.f);
            const float v = valid ? (s[tt][jj] * sc - sl * dist) : -INFINITY;
            s[tt][jj] = v; mx = fmaxf(mx, v);
        }
    }
    mx = fmaxf(mx, __shfl_xor(mx, 16)); mx = fmaxf(mx, __shfl_xor(mx, 32));
    float sum = 0.f;
#pragma unroll
    for (int tt = 0; tt < 9; ++tt)
#pragma unroll
        for (int jj = 0; jj < 4; ++jj) { const float e = __builtin_amdgcn_exp2f(s[tt][jj] - mx); s[tt][jj] = e; sum += e; }
    sum += __shfl_xor(sum, 16); sum += __shfl_xor(sum, 32);
    bf16x8 pf[5];
#pragma unroll
    for (int c = 0; c < 5; ++c) {
        u32x4 pw; pw.x = pk2(s[2 * c][0], s[2 * c][1]); pw.y = pk2(s[2 * c][2], s[2 * c][3]);
        if (c < 4) { pw.z = pk2(s[2 * c + 1][0], s[2 * c + 1][1]); pw.w = pk2(s[2 * c + 1][2], s[2 * c + 1][3]); } else { pw.z = 0u; pw.w = 0u; }
        pf[c] = __builtin_bit_cast(bf16x8, pw);
    }
    u32x4 m0[4]; float l0 = 0.f, l1 = 0.f;
    const bf16_t* o0p = obuf + qrow * GWID + j * HD + 32 * fq;
    if (g == 2) { l0 = lsebuf[qrow * NSLOT + j]; l1 = lsebuf[((size_t)MTOK + qrow) * NSLOT + j];
#pragma unroll
        for (int dp = 0; dp < 4; ++dp) m0[dp] = *(const u32x4*)(o0p + 8 * dp); }
    else {
#pragma unroll
        for (int dp = 0; dp < 4; ++dp) m0[dp] = (u32x4){0u, 0u, 0u, 0u}; }
    f32x4 o[8];
#pragma unroll
    for (int dt = 0; dt < 8; ++dt) o[dt] = (f32x4){0.f, 0.f, 0.f, 0.f};
    const int lofs = (4 * fq + (fr >> 2)) * ATT_VSTR + (4 * (fr & 3)) * 2;
#pragma unroll
    for (int c = 0; c < 5; ++c) {
        __builtin_amdgcn_sched_barrier(0);
        if (qb == 0 && w + 2 * c + 1 < 8) continue;
        const LAS unsigned char* v0 = Vl + attn_trow(w + 2 * c, ch) * ATT_VSTR + lofs; const LAS unsigned char* v1 = Vl + attn_trow(w + 2 * c + 1, ch) * ATT_VSTR + lofs;
#pragma unroll
        for (int dt = 0; dt < 8; ++dt) {
            const s16x4 lo = vtr(v0 + dt * 32), hi = vtr(v1 + dt * 32);
            const bf16x8 av = {lo[0], lo[1], lo[2], lo[3], hi[0], hi[1], hi[2], hi[3]};
            o[dt] = __builtin_amdgcn_mfma_f32_16x16x32_bf16(av, pf[c], o[dt], 0, 0, 0);
        }
    }
    const float inv = 1.f / sum;
    const float lse = (mx + log2f(sum)) * 0.6931471805599453f;
    if (g < 2) {
        bf16_t* orow = obuf + ((size_t)g * MTOK + qrow) * GWID + j * HD + 32 * fq;
#pragma unroll
        for (int dp = 0; dp < 4; ++dp) { u32x4 ow; ow.x = pk2(o[2 * dp][0] * inv, o[2 * dp][1] * inv); ow.y = pk2(o[2 * dp][2] * inv, o[2 * dp][3] * inv);
            ow.z = pk2(o[2 * dp + 1][0] * inv, o[2 * dp + 1][1] * inv); ow.w = pk2(o[2 * dp + 1][2] * inv, o[2 * dp + 1][3] * inv); *(u32x4*)(orow + 8 * dp) = ow; }
        if (fq == 0) lsebuf[((size_t)g * MTOK + qrow) * NSLOT + j] = lse;
    } else {
        const float lm = fmaxf(lse, fmaxf(l0, l1));
        float e0 = __expf(l0 - lm), e1 = __expf(l1 - lm), e2 = __expf(lse - lm); const float wi = 1.f / (e0 + e1 + e2); e0 *= wi; e1 *= wi; e2 *= wi * inv;
        bf16_t* mrow = merged + qrow * GWID + j * HD + 4 * fq;
#pragma unroll
        for (int dp = 0; dp < 4; ++dp) { const u32x4 a0 = m0[dp], a1 = *(const u32x4*)(o0p + (size_t)MTOK * GWID + 8 * dp);
            u32x2 ow; ow.x = pk2(e0 * bf_lo(a0.x) + e1 * bf_lo(a1.x) + e2 * o[2 * dp][0], e0 * bf_hi(a0.x) + e1 * bf_hi(a1.x) + e2 * o[2 * dp][1]);
            ow.y = pk2(e0 * bf_lo(a0.y) + e1 * bf_lo(a1.y) + e2 * o[2 * dp][2], e0 * bf_hi(a0.y) + e1 * bf_hi(a1.y) + e2 * o[2 * dp][3]);
            *(u32x2*)(mrow + 32 * dp) = ow;
            ow.x = pk2(e0 * bf_lo(a0.z) + e1 * bf_lo(a1.z) + e2 * o[2 * dp + 1][0], e0 * bf_hi(a0.z) + e1 * bf_hi(a1.z) + e2 * o[2 * dp + 1][1]);
            ow.y = pk2(e0 * bf_lo(a0.w) + e1 * bf_lo(a1.w) + e2 * o[2 * dp + 1][2], e0 * bf_hi(a0.w) + e1 * bf_hi(a1.w) + e2 * o[2 * dp + 1][3]);
            *(u32x2*)(mrow + 32 * dp + 16) = ow; }
    }
}

#define ATT_LBAR() do { asm volatile("s_waitcnt lgkmcnt(0)" ::: "memory"); __builtin_amdgcn_s_barrier(); asm volatile("" ::: "memory"); } while (0)
__device__ __forceinline__ void phase_attn(LAS unsigned char* lds, const bf16_t* qkv, bf16_t* obuf, float* lsebuf, bf16_t* merged, int pass, int wave_s) {
    const int tid = MYTID(wave_s), lane = tid & 63, w = wave_s, fr = lane & 15, fq = lane >> 4;
    const int c = blockIdx.x, n = pass == 0 ? 16 : 8;
    for (int i = tid; i < ATT_BYTES / 16; i += NTHR) ((LAS u32x4*)lds)[i] = (u32x4){0u, 0u, 0u, 0u};
    ATT_LBAR();
    if (pass == 1) {
        const int wB = 7 - w;
        for (int i = 0; i < 4; ++i) {
            const AttnId ua = attn_decode(1, c, 2 * i), ub = attn_decode(1, c, 2 * i + 1);
            bf16x8 qA[4], qB[4];
            { u32x4 kvA[4], vvA[4], kvB[4], vvB[4];
              attn_fetch(qkv, ua, 0, kvA, vvA, tid); attn_fetch(qkv, ub, 0, kvB, vvB, tid); attn_fetch_q(qkv, ua, qA, w, fr, fq); attn_fetch_q(qkv, ub, qB, wB, fr, fq);
              attn_put(lds, 0, kvA, vvA, tid); attn_put(lds, 1, kvB, vvB, tid); }
            ATT_LBAR();
            f32x4 sacc[9];
            attn_scores(lds, 0, false, qA, sacc, w, fr, fq);
            attn_finish(lds, 0, ua, sacc, obuf, lsebuf, merged, w, fr, fq);
            __builtin_amdgcn_sched_barrier(0);
            attn_scores(lds, 1, false, qB, sacc, wB, fr, fq);
            attn_finish(lds, 1, ub, sacc, obuf, lsebuf, merged, wB, fr, fq);
            ATT_LBAR();
        }
        return;
    }
    u32x4 kv[4], vv[4]; bf16x8 qn[4];
    AttnId cur = attn_decode(pass, c, 0);
    attn_fetch(qkv, cur, cur.qb, kv, vv, tid); attn_fetch_q(qkv, cur, qn, w, fr, fq);
    for (int i = 0; i < n; ++i) {
        const int ch = cur.qb & 1;
        attn_put(lds, ch, kv, vv, tid);
        if (cur.ldprev) { attn_fetch(qkv, cur, cur.qb - 1, kv, vv, tid); attn_put(lds, ch ^ 1, kv, vv, tid); }
        ATT_LBAR();
        f32x4 sacc[9];
        attn_scores(lds, ch, cur.qb > 0, qn, sacc, w, fr, fq);
        __builtin_amdgcn_sched_barrier(0);
        AttnId nxt = cur;
        if (i + 1 < n) { nxt = attn_decode(pass, c, i + 1); attn_fetch(qkv, nxt, nxt.qb, kv, vv, tid); attn_fetch_q(qkv, nxt, qn, w, fr, fq); }
        attn_finish(lds, ch, cur, sacc, obuf, lsebuf, merged, w, fr, fq);
        ATT_LBAR();
        cur = nxt;
    }
}

#define XB_TMO      128
#define XB_XCNT(j)  (256  + 64 * (j))
#define XB_XSUB(j)  (1280 + 64 * (j))
#define XB_XGEN(j)  (2304 + 64 * (j))
#define XB_TOP      3328
#define XB_TOPGEN   3392
#define XCD_BAR_WORDS 3456
#define XB_SPIN_CAP (1u << 22)
__device__ __forceinline__ unsigned xb_ld(unsigned* p)              { return __hip_atomic_load(p, __ATOMIC_RELAXED, __HIP_MEMORY_SCOPE_AGENT); }
__device__ __forceinline__ unsigned xb_add(unsigned* p, unsigned v) { return __hip_atomic_fetch_add(p, v, __ATOMIC_RELAXED, __HIP_MEMORY_SCOPE_AGENT); }
__device__ __forceinline__ unsigned xb_xcc_id() { return (unsigned)__builtin_amdgcn_s_getreg((3 << 11) | 20) & 0xFu; }
#define XB_SPIN(cond, bar) do { unsigned _sp = 0; while (cond) { __builtin_amdgcn_s_sleep(1); \
    if ((++_sp & 255u) == 0u) { if (xb_ld(&(bar)[XB_TMO])) break; if (_sp > XB_SPIN_CAP) { atomicAdd(&(bar)[XB_TMO], 1u); break; } } } } while (0)
struct XcdBarrier { unsigned* bar; unsigned x; volatile LAS unsigned* st; };
__device__ __forceinline__ XcdBarrier xcd_barrier_post(unsigned* bar, volatile LAS unsigned* st, int wave_s) {
    XcdBarrier b; b.bar = bar; b.x = xb_xcc_id(); b.st = st;
    if (MYTID(wave_s) == 0) (void)xb_add(&bar[XB_XCNT(b.x)], 1u);
    return b;
}
__device__ __forceinline__ void xcd_barrier_complete(unsigned* bar, unsigned x, unsigned& nloc, unsigned& nx) {
    const unsigned G = gridDim.x * gridDim.y * gridDim.z;
    unsigned sum, cnt, mine, sp = 0u;
    for (;;) {
        sum = 0u; cnt = 0u; mine = 0u;
#pragma unroll
        for (unsigned j = 0; j < 16; ++j) { const unsigned c = xb_ld(&bar[XB_XCNT(j)]); sum += c; cnt += (c > 0u) ? 1u : 0u; mine = (j == x) ? c : mine; }
        if (sum == G) break;
        __builtin_amdgcn_s_sleep(1);
        if ((++sp & 255u) == 0u) { if (xb_ld(&bar[XB_TMO])) break; if (sp > XB_SPIN_CAP) { atomicAdd(&bar[XB_TMO], 1u); break; } }
    }
    nloc = mine > 0u ? mine : 1u; nx = cnt > 0u ? cnt : 1u;
}
__device__ __forceinline__ void xcd_barrier(const XcdBarrier& b, int wave_s) {
    asm volatile("s_waitcnt vmcnt(0)" ::: "memory");
    __syncthreads();
    if (MYTID(wave_s) == 0) {
        unsigned* bar = b.bar;
        __builtin_amdgcn_s_waitcnt(0);
        unsigned nloc = b.st[0], nx = b.st[1];
        if (nloc == 0u) { xcd_barrier_complete(bar, b.x, nloc, nx); b.st[0] = nloc; b.st[1] = nx; }
        const unsigned old = xb_add(&bar[XB_XSUB(b.x)], 1u);
        const unsigned gen = old / nloc;
        if (old + 1u == (gen + 1u) * nloc) {
            __builtin_amdgcn_fence(__ATOMIC_RELEASE, "agent");
            asm volatile("s_waitcnt vmcnt(0)" ::: "memory");
            const unsigned og = xb_add(&bar[XB_TOP], 1u);
            const unsigned tg = og / nx;
            if (og + 1u == (tg + 1u) * nx) xb_add(&bar[XB_TOPGEN], 1u);
            else XB_SPIN(xb_ld(&bar[XB_TOPGEN]) == tg, bar);
            __builtin_amdgcn_fence(__ATOMIC_ACQUIRE, "agent");
            xb_add(&bar[XB_XGEN(b.x)], 1u);
            asm volatile("s_waitcnt vmcnt(0)" ::: "memory");
        } else {
            XB_SPIN(xb_ld(&bar[XB_XGEN(b.x)]) == gen, bar);
            __builtin_amdgcn_fence(__ATOMIC_ACQUIRE, "agent");
            asm volatile("s_waitcnt vmcnt(0)" ::: "memory");
        }
    }
    __syncthreads();
}

__global__ void __launch_bounds__(NTHR, 2) fwd_megakernel(Params p) {
    extern __shared__ __attribute__((aligned(16))) unsigned char lds_raw[];
    LAS unsigned char* lds = (LAS unsigned char*)lds_raw;
    cg::grid_group grid = cg::this_grid();
    unsigned char* ws = p.ws;
    bf16_t* XA = (bf16_t*)(ws + WS_XA); bf16_t* XB = (bf16_t*)(ws + WS_XB);
    bf16_t* BIG = (bf16_t*)(ws + WS_BIG);
    bf16_t* U = BIG; bf16_t* PB = BIG + (size_t)MTOK * DM; bf16_t* Y = BIG + 2 * (size_t)MTOK * DM;
    bf16_t* R = (bf16_t*)p.out;
    volatile LAS unsigned* MISC = (volatile LAS unsigned*)(lds + MISC_OFF);
    unsigned* barw = (unsigned*)ws;
    const int G = gridDim.x, c = blockIdx.x;
    constexpr int NOG = 1 << 30;

    const int wave_s = __builtin_amdgcn_readfirstlane((int)threadIdx.x >> 6);
    { const int t0 = MYTID(wave_s); if (blockIdx.x == 0) for (int i = t0; i < XCD_BAR_WORDS; i += NTHR) barw[i] = 0u;
      if (t0 < 2) MISC[t0] = 0u; }
    phase_prologue(p, lds, wave_s);
    grid.sync();
    const XcdBarrier xbar = xcd_barrier_post(barw, MISC, wave_s);
    {
        pg8::Gemm g{XA, (const bf16_t*)(ws + WS_WIN), MTOK, DM, DM, DM, NOG, 0, 0}; pg8::StaticOrder S; S.init(MTOK, DM, G, c);
        pg8::EpiBf16<0, false> E{U, DM, nullptr};
        pg8::gemm_phase(lds, g, S, E, wave_s);
    }
    xcd_barrier(xbar, wave_s);
    phase_pool(U, PB, wave_s);
    xcd_barrier(xbar, wave_s);
    {
        pg8::Gemm g{PB, (const bf16_t*)(ws + WS_WG), MTOK, DM, 512, DM, 2, 512, 0}; pg8::StaticOrder S; S.init(MTOK, DM, G, c);
        pg8::EpiBf16<0, true> E{Y, DM, p.pool_scale};
        pg8::gemm_phase(lds, g, S, E, wave_s);
    }
    xcd_barrier(xbar, wave_s);
    {
        pg8::Gemm g{Y, (const bf16_t*)(ws + WS_WOUT), MTOK, DM, DM, DM, NOG, 0, 0}; pg8::StaticOrder S; S.init(MTOK, DM, G, c);
        pg8::EpiRes E{XA, R, DM, ALPHA};
        pg8::gemm_phase(lds, g, S, E, wave_s);
    }
    xcd_barrier(xbar, wave_s);
    phase_ln<false>(R, p.ln_mix_g, p.ln_mix_b, XB, nullptr, wave_s);
    xcd_barrier(xbar, wave_s);
    {
        pg8::Gemm g{XB, (const bf16_t*)(ws + WS_WUP0), MTOK, FF, DM, DM, NOG, 0, 0}; pg8::StaticOrder S; S.init(MTOK, FF, G, c);
        pg8::EpiSqReluBlk E{BIG, FF / 64};
        pg8::gemm_phase(lds, g, S, E, wave_s);
    }
    xcd_barrier(xbar, wave_s);
    {
        pg8::Gemm g{BIG, (const bf16_t*)(ws + WS_WDN0), MTOK, DM, FF, FF, NOG, 0, 1}; pg8::StaticOrder S; S.init(MTOK, DM, G, c);
        pg8::EpiRes E{XB, R, DM, ALPHA};
        pg8::gemm_phase<true>(lds, g, S, E, wave_s);
    }
    xcd_barrier(xbar, wave_s);
    phase_ln<false>(R, p.ln_mlp_g, p.ln_mlp_b, XA, nullptr, wave_s);
    xcd_barrier(xbar, wave_s);
    {
        pg8::Gemm g{XA, (const bf16_t*)(ws + WS_WQKV), MTOK, QKVW, DM, DM, NOG, 0, 0}; pg8::StaticOrder S; S.init(MTOK, QKVW, G, c);
        pg8::EpiQKV E{BIG};
        pg8::gemm_phase(lds, g, S, E, wave_s);
    }
    xcd_barrier(xbar, wave_s);
    phase_attn(lds, BIG, (bf16_t*)p.out, (float*)(ws + WS_LSE), XB, 0, wave_s);
    xcd_barrier(xbar, wave_s);
    phase_attn(lds, BIG, (bf16_t*)p.out, (float*)(ws + WS_LSE), XB, 1, wave_s);
    xcd_barrier(xbar, wave_s);
    {
        pg8::Gemm g{XB, (const bf16_t*)(ws + WS_WAO), MTOK, DM, GWID, GWID, NOG, 0, 0}; pg8::StaticOrder S; S.init(MTOK, DM, G, c);
        pg8::EpiRes E{XA, R, DM, ALPHA};
        pg8::gemm_phase(lds, g, S, E, wave_s);
    }
    xcd_barrier(xbar, wave_s);
    phase_ln<false>(R, p.ln_mix_g + DM, p.ln_mix_b + DM, XB, nullptr, wave_s);
    xcd_barrier(xbar, wave_s);
    {
        pg8::Gemm g{XB, (const bf16_t*)(ws + WS_WUP1), MTOK, FF, DM, DM, NOG, 0, 0}; pg8::StaticOrder S; S.init(MTOK, FF, G, c);
        pg8::EpiSqReluBlk E{BIG, FF / 64};
        pg8::gemm_phase(lds, g, S, E, wave_s);
    }
    xcd_barrier(xbar, wave_s);
    {
        pg8::Gemm g{BIG, (const bf16_t*)(ws + WS_WDN1), MTOK, DM, FF, FF, NOG, 0, 1}; pg8::StaticOrder S; S.init(MTOK, DM, G, c);
        pg8::EpiRes E{XB, XA, DM, ALPHA};
        pg8::gemm_phase<true>(lds, g, S, E, wave_s);
    }
    xcd_barrier(xbar, wave_s);
    phase_ln<true>(XA, p.ln_mlp_g + DM, p.ln_mlp_b + DM, nullptr, p.out, wave_s);
}

extern "C" void kernel_launch(void* const* d_in, const int* in_sizes, int n_in, void* d_out, int out_size, void* d_ws, size_t ws_size, hipStream_t stream) {
    static int grid = 0;
    if (grid == 0) {
        if (n_in != 13 || in_sizes[0] != MTOK * DM || out_size != MTOK * DM || ws_size < WS_END) {
            fprintf(stderr, "kernel_launch: unexpected shapes: n_in %d in0 %d out %d ws %zu (need %zu); nothing launched\n", n_in, n_in > 0 ? in_sizes[0] : -1, out_size, ws_size, (size_t)WS_END); grid = -1; return; }
        int dev = 0, cus = 0, per_cu = 0;
        hipGetDevice(&dev);
        hipDeviceGetAttribute(&cus, hipDeviceAttributeMultiprocessorCount, dev);
        if (hipFuncSetAttribute((const void*)fwd_megakernel, hipFuncAttributeMaxDynamicSharedMemorySize, LDS_BYTES) != hipSuccess) { fprintf(stderr, "kernel_launch: hipFuncSetAttribute failed\n"); grid = -1; return; }
        if (hipOccupancyMaxActiveBlocksPerMultiprocessor(&per_cu, (const void*)fwd_megakernel, NTHR, LDS_BYTES) != hipSuccess || per_cu < 1) { fprintf(stderr, "kernel_launch: occupancy query gave %d\n", per_cu); per_cu = 1; }
        (void)hipGetLastError();
        grid = cus * per_cu;
        if (grid != 256) { fprintf(stderr, "kernel_launch: this kernel needs exactly 256 co-resident workgroups, got %d\n", grid); if (grid > 256) grid = 256; }
        fprintf(stderr, "kernel_launch: grid %d (cus %d x %d)\n", grid, cus, per_cu);
    }
    if (grid < 0) return;
    Params p{};
    p.x = (const float*)d_in[0]; p.w_in = (const float*)d_in[1]; p.w_group = (const float*)d_in[2]; p.pool_scale = (const float*)d_in[3]; p.w_out = (const float*)d_in[4];
    p.w_qkv = (const float*)d_in[5]; p.w_ao = (const float*)d_in[6]; p.w_up = (const float*)d_in[7]; p.w_dn = (const float*)d_in[8];
    p.ln_mix_g = (const float*)d_in[9]; p.ln_mix_b = (const float*)d_in[10]; p.ln_mlp_g = (const float*)d_in[11]; p.ln_mlp_b = (const float*)d_in[12];
    p.out = (float*)d_out; p.ws = (unsigned char*)d_ws;
    void* args[] = {&p};
    hipError_t e = hipLaunchCooperativeKernel((const void*)fwd_megakernel, dim3(grid), dim3(NTHR), args, LDS_BYTES, stream);
    if (e != hipSuccess) fprintf(stderr, "kernel_launch: cooperative launch failed: %s (grid %d)\n", hipGetErrorString(e), grid);
}
```
